# Optimizing an MI355X kernel written in HIP

```python
import math
import jax, jax.numpy as jnp
from jax import lax
import numpy as np

D_MODEL = 1024
BATCH = 8
SEQ = 8192
DEPTH = 1

CHUNK = 64
LN_EPS = 1e-5
DEEPNORM_ALPHA = (2.0 * DEPTH) ** 0.25
DEEPNORM_BETA = (8.0 * DEPTH) ** -0.25

ATT_HEADS = 8
ATT_HEAD_DIM = 64
ATT_WIDTH = ATT_HEADS * ATT_HEAD_DIM
ATT_LEFT_CHUNKS = 8
ATT_BAND = (ATT_LEFT_CHUNKS + 1) * CHUNK
MAX_REL = 128
N_REL = 2 * MAX_REL + 1

MLSTM_HEADS = 4
MLSTM_HEAD_DIM = 128
MLSTM_WIDTH = MLSTM_HEADS * MLSTM_HEAD_DIM
CONV_WIDTH = 4

IN_PROJ_WIDTH = 3 * ATT_WIDTH + 4 * MLSTM_WIDTH + 2 * MLSTM_HEADS
IN_SPLITS = (ATT_WIDTH, 2 * ATT_WIDTH, 3 * ATT_WIDTH,
             3 * ATT_WIDTH + 2 * MLSTM_WIDTH,
             3 * ATT_WIDTH + 3 * MLSTM_WIDTH,
             3 * ATT_WIDTH + 4 * MLSTM_WIDTH,
             3 * ATT_WIDTH + 4 * MLSTM_WIDTH + MLSTM_HEADS)

MEM_TOKENS = 256
XATT_HEADS = 4
XATT_HEAD_DIM = D_MODEL // XATT_HEADS

PEER_HEADS = 8
N_KEYS = 128
N_EXPERTS = N_KEYS * N_KEYS
PEER_TOPK = 16
PEER_KEY_DIM = 256
PEER_HALF = PEER_KEY_DIM // 2
PEER_TOKEN_BLOCK = 128

kernel_name = "hybrid_chunkattn_mlstm_peer_deepnorm"


def layer_norm(x, g, b):
    xf = x.astype(jnp.float32)
    mu = jnp.mean(xf, -1, keepdims=True)
    var = jnp.mean(jnp.square(xf - mu), -1, keepdims=True)
    return ((xf - mu) * lax.rsqrt(var + LN_EPS) * g.astype(jnp.float32) + b.astype(jnp.float32)).astype(x.dtype)


def headwise_norm(x, g):
    xf = x.astype(jnp.float32)
    mu = jnp.mean(xf, -1, keepdims=True)
    var = jnp.mean(jnp.square(xf - mu), -1, keepdims=True)
    return ((xf - mu) * lax.rsqrt(var + LN_EPS) * g.astype(jnp.float32)).astype(x.dtype)


def causal_depthwise_conv(x, w, b):
    c = x.shape[-1]
    y = lax.conv_general_dilated(x, w[:, None, :].astype(x.dtype), window_strides=(1,),
                                 padding=((CONV_WIDTH - 1, 0),),
                                 dimension_numbers=('NWC', 'WIO', 'NWC'),
                                 feature_group_count=c)
    return y + b.astype(x.dtype)


def chunked_rel_attention(q, k, v, rel_bias):
    B, S, H, Dh = q.shape
    n_chunks = S // CHUNK
    pad = ATT_LEFT_CHUNKS * CHUNK
    kp = jnp.pad(k, ((0, 0), (pad, 0), (0, 0), (0, 0)))
    vp = jnp.pad(v, ((0, 0), (pad, 0), (0, 0), (0, 0)))
    q_off = jnp.arange(CHUNK)[:, None]
    k_off = jnp.arange(ATT_BAND)[None, :] - pad
    rel = jnp.clip(k_off - q_off, -MAX_REL, MAX_REL) + MAX_REL
    bias = rel_bias[:, rel].astype(jnp.float32)
    scale = Dh ** -0.5

    def one_chunk(c):
        start = c * CHUNK
        qc = lax.dynamic_slice_in_dim(q, start, CHUNK, axis=1)
        kc = lax.dynamic_slice_in_dim(kp, start, ATT_BAND, axis=1)
        vc = lax.dynamic_slice_in_dim(vp, start, ATT_BAND, axis=1)
        s = jnp.einsum('bqhd,bkhd->bhqk', qc, kc, preferred_element_type=jnp.float32) * scale + bias
        valid = (start - pad + jnp.arange(ATT_BAND)) >= 0
        s = jnp.where(valid, s, -jnp.inf)
        p = jax.nn.softmax(s, axis=-1)
        return jnp.einsum('bhqk,bkhd->bqhd', p.astype(vc.dtype), vc)

    out = lax.map(one_chunk, jnp.arange(n_chunks))
    return jnp.moveaxis(out, 0, 1).reshape(B, S, H * Dh)


def mlstm_chunkwise(q, k, v, i_pre, f_pre):
    B, S, H, D = q.shape
    n_chunks = S // CHUNK
    f32 = jnp.float32

    def to_chunks(a):
        a = a.reshape(B, n_chunks, CHUNK, H, *a.shape[3:])
        return jnp.moveaxis(a, (1, 3), (0, 2))

    qs = to_chunks(q.astype(f32))
    ks = to_chunks(k.astype(f32) * (D ** -0.5))
    vs = to_chunks(v.astype(f32))
    log_i = to_chunks(i_pre.astype(f32))
    log_f = to_chunks(jax.nn.log_sigmoid(f_pre.astype(f32)))
    causal = jnp.tril(jnp.ones((CHUNK, CHUNK), dtype=bool))

    def step(carry, xs):
        C_prev, n_prev, m_prev = carry
        qc, kc, vc, ic, fc = xs
        b = jnp.cumsum(fc, axis=-1)
        log_d = b[..., :, None] - b[..., None, :] + ic[..., None, :]
        log_d = jnp.where(causal, log_d, -jnp.inf)
        inter = b + m_prev[..., None]
        m_t = jnp.maximum(inter, jnp.max(log_d, -1))
        d_mat = jnp.exp(log_d - m_t[..., None])
        w_inter = jnp.exp(inter - m_t)
        qk = jnp.einsum('bhtd,bhsd->bhts', qc, kc) * d_mat
        num = w_inter[..., None] * jnp.einsum('bhtd,bhde->bhte', qc, C_prev) + jnp.einsum('bhts,bhse->bhte', qk, vc)
        den = w_inter * jnp.einsum('bhtd,bhd->bht', qc, n_prev) + jnp.sum(qk, -1)
        h = num / jnp.maximum(jnp.abs(den), jnp.exp(-m_t))[..., None]
        b_last = b[..., -1]
        log_in = b_last[..., None] - b + ic
        m_new = jnp.maximum(b_last + m_prev, jnp.max(log_in, -1))
        w_prev = jnp.exp(b_last + m_prev - m_new)
        w_in = jnp.exp(log_in - m_new[..., None])
        C_new = w_prev[..., None, None] * C_prev + jnp.einsum('bhs,bhsd,bhse->bhde', w_in, kc, vc)
        n_new = w_prev[..., None] * n_prev + jnp.einsum('bhs,bhsd->bhd', w_in, kc)
        return (C_new, n_new, m_new), h

    init = (jnp.zeros((B, H, D, D), f32), jnp.zeros((B, H, D), f32), jnp.zeros((B, H), f32))
    _, h = lax.scan(step, init, (qs, ks, vs, log_i, log_f))
    h = jnp.moveaxis(h, (0, 2), (1, 3)).reshape(B, S, H, D)
    return h.astype(q.dtype)


def hybrid_mixer(h, w_in, conv_w, conv_b, i_bias, f_bias, norm_g, rel_bias, w_out):
    B, S, _ = h.shape
    proj = h @ w_in
    a_q, a_k, a_v, m_qk, m_v, m_o, m_i, m_f = jnp.split(proj, IN_SPLITS, axis=-1)
    hs = (B, S, ATT_HEADS, ATT_HEAD_DIM)
    att = chunked_rel_attention(a_q.reshape(hs), a_k.reshape(hs), a_v.reshape(hs), rel_bias)
    qk = jax.nn.silu(causal_depthwise_conv(m_qk, conv_w, conv_b))
    m_q, m_k = jnp.split(qk, 2, axis=-1)
    ms = (B, S, MLSTM_HEADS, MLSTM_HEAD_DIM)
    hm = mlstm_chunkwise(m_q.reshape(ms), m_k.reshape(ms), m_v.reshape(ms),
                         m_i + i_bias.astype(m_i.dtype), m_f + f_bias.astype(m_f.dtype))
    hm = headwise_norm(hm, norm_g.reshape(MLSTM_HEADS, MLSTM_HEAD_DIM)).reshape(B, S, MLSTM_WIDTH)
    hm = jax.nn.sigmoid(m_o) * hm
    return jnp.concatenate([att, hm], axis=-1) @ w_out


def memory_cross_attention(h, mem, w_q, w_kv, w_o):
    B, S, _ = h.shape
    M = mem.shape[1]
    q = (h @ w_q).reshape(B, S, XATT_HEADS, XATT_HEAD_DIM)
    k, v = jnp.split(mem @ w_kv, 2, axis=-1)
    k = k.reshape(B, M, XATT_HEADS, XATT_HEAD_DIM)
    v = v.reshape(B, M, XATT_HEADS, XATT_HEAD_DIM)
    s = jnp.einsum('bshd,bmhd->bhsm', q, k, preferred_element_type=jnp.float32) * (XATT_HEAD_DIM ** -0.5)
    p = jax.nn.softmax(s, axis=-1)
    o = jnp.einsum('bhsm,bmhd->bshd', p.astype(v.dtype), v).reshape(B, S, D_MODEL)
    return o @ w_o


def peer_ffn(x, w_query, sub_keys, expert_u, expert_v):
    B, S, D = x.shape
    xt = x.reshape(-1, PEER_TOKEN_BLOCK, D)

    def block(xb):
        T = xb.shape[0]
        q = (xb @ w_query).reshape(T, PEER_HEADS, 2, PEER_HALF)
        s = jnp.einsum('thpc,pnc->thpn', q, sub_keys, preferred_element_type=jnp.float32)
        top_s, top_i = lax.top_k(s, PEER_TOPK)
        cand = top_s[:, :, 0, :, None] + top_s[:, :, 1, None, :]
        best_s, best_j = lax.top_k(cand.reshape(T, PEER_HEADS, PEER_TOPK * PEER_TOPK), PEER_TOPK)
        i1 = jnp.take_along_axis(top_i[:, :, 0], best_j // PEER_TOPK, axis=-1)
        i2 = jnp.take_along_axis(top_i[:, :, 1], best_j % PEER_TOPK, axis=-1)
        idx = i1 * N_KEYS + i2
        g = jax.nn.softmax(best_s, axis=-1)
        u = expert_u[idx]
        a = jax.nn.gelu(jnp.einsum('thkd,td->thk', u, xb, preferred_element_type=jnp.float32), approximate=False)
        vv = expert_v[idx]
        out = jnp.einsum('thk,thkd->td', (g * a).astype(vv.dtype), vv)
        return out.astype(xb.dtype)

    return lax.map(block, xt).reshape(B, S, D)


def setup_inputs(seed: int = 0) -> dict:
    key = jax.random.key(seed)
    ks = jax.random.split(key, 26)

    def nrm(k, shape, scale):
        return jax.random.normal(k, shape, jnp.float32) * scale

    L, D = DEPTH, D_MODEL
    beta = DEEPNORM_BETA
    return {
        "x": nrm(ks[0], (BATCH, SEQ, D), 1.0),
        "mem": nrm(ks[1], (BATCH, MEM_TOKENS, D), 1.0),
        "ln_in_g": 1.0 + nrm(ks[2], (D,), 0.02),
        "ln_in_b": nrm(ks[3], (D,), 0.02),
        "w_in": nrm(ks[4], (L, D, IN_PROJ_WIDTH), D ** -0.5),
        "conv_w": nrm(ks[5], (L, CONV_WIDTH, 2 * MLSTM_WIDTH), CONV_WIDTH ** -0.5),
        "conv_b": nrm(ks[6], (L, 2 * MLSTM_WIDTH), 0.02),
        "mlstm_i_bias": nrm(ks[7], (L, MLSTM_HEADS), 0.1),
        "mlstm_f_bias": jnp.linspace(3.0, 6.0, MLSTM_HEADS, dtype=jnp.float32)[None, :] + nrm(ks[8], (L, MLSTM_HEADS), 0.1),
        "mlstm_norm_g": 1.0 + nrm(ks[9], (L, MLSTM_WIDTH), 0.02),
        "rel_bias": nrm(ks[10], (L, ATT_HEADS, N_REL), 0.5),
        "w_out": nrm(ks[11], (L, D, D), beta * D ** -0.5),
        "ln1_g": 1.0 + nrm(ks[12], (L, D), 0.02),
        "ln1_b": nrm(ks[13], (L, D), 0.02),
        "xattn_w_q": nrm(ks[14], (L, D, D), D ** -0.5),
        "xattn_w_kv": nrm(ks[15], (L, D, 2 * D), D ** -0.5),
        "xattn_w_o": nrm(ks[16], (L, D, D), beta * D ** -0.5),
        "ln2_g": 1.0 + nrm(ks[17], (L, D), 0.02),
        "ln2_b": nrm(ks[18], (L, D), 0.02),
        "peer_w_query": nrm(ks[19], (L, D, PEER_HEADS * PEER_KEY_DIM), D ** -0.5),
        "peer_sub_keys": nrm(ks[20], (L, 2, N_KEYS, PEER_HALF), PEER_HALF ** -0.5),
        "peer_u": nrm(ks[21], (L, N_EXPERTS, D), D ** -0.5),
        "peer_v": nrm(ks[22], (L, N_EXPERTS, D), beta * PEER_HEADS ** -0.5),
        "ln3_g": 1.0 + nrm(ks[23], (L, D), 0.02),
        "ln3_b": nrm(ks[24], (L, D), 0.02),
    }


def reference(x, mem, ln_in_g, ln_in_b, w_in, conv_w, conv_b, mlstm_i_bias, mlstm_f_bias,
              mlstm_norm_g, rel_bias, w_out, ln1_g, ln1_b, xattn_w_q, xattn_w_kv, xattn_w_o,
              ln2_g, ln2_b, peer_w_query, peer_sub_keys, peer_u, peer_v, ln3_g, ln3_b):
    a = DEEPNORM_ALPHA
    h = layer_norm(x, ln_in_g, ln_in_b)
    for l in range(DEPTH):
        y = hybrid_mixer(h, w_in[l], conv_w[l], conv_b[l], mlstm_i_bias[l], mlstm_f_bias[l],
                         mlstm_norm_g[l], rel_bias[l], w_out[l])
        h = layer_norm(a * h + y, ln1_g[l], ln1_b[l])
        y = memory_cross_attention(h, mem, xattn_w_q[l], xattn_w_kv[l], xattn_w_o[l])
        h = layer_norm(a * h + y, ln2_g[l], ln2_b[l])
        y = peer_ffn(h, peer_w_query[l], peer_sub_keys[l], peer_u[l], peer_v[l])
        h = layer_norm(a * h + y, ln3_g[l], ln3_b[l])
    return h
```

```cpp
#include <hip/hip_runtime.h>
#include <hip/hip_cooperative_groups.h>
#include <cstdio>
namespace cg = cooperative_groups;

#ifndef PHASE_EN
#define PHASE_EN 0xFFFF
#endif
#ifndef PROBE_MASK
#define PROBE_MASK 0
#endif
#ifndef STAGE_MASK
#define STAGE_MASK 7
#endif

#define DI __device__ __forceinline__
typedef unsigned short u16;
typedef __attribute__((ext_vector_type(8))) short bf16x8;
typedef __attribute__((ext_vector_type(16))) float f32x16;
typedef __attribute__((ext_vector_type(2))) float f32x2;
#define MFMA(a, b, c) __builtin_amdgcn_mfma_f32_32x32x16_bf16((a), (b), (c), 0, 0, 0)

constexpr int T_TOK = 65536;
constexpr int SEQ = 8192;
constexpr float ALPHA = 1.189207115002721f;
constexpr float LN_EPS = 1e-5f;
constexpr int LDS_BYTES = 143360;
constexpr size_t MB = 1u << 20;
constexpr size_t OFF_WIN = 0, OFF_WOUT = 8 * MB, OFF_WQ = 10 * MB, OFF_WO = 12 * MB, OFF_WKV = 14 * MB, OFF_WPQ = 18 * MB,
                 OFF_SK = 22 * MB, OFF_MEMB = 23 * MB, OFF_KX = 27 * MB, OFF_VTX = 31 * MB, OFF_U8 = 35 * MB, OFF_V8 = 51 * MB, OFF_USC = 67 * MB, OFF_VSC = 68 * MB,
                 OFF_G = 99 * MB, OFF_H = 104 * MB, OFF_PA = 232 * MB, OFF_PM = 360 * MB, OFF_Z = 232 * MB, OFF_VTA = 488 * MB,
                 OFF_VTM = 552 * MB, OFF_XQ = 488 * MB, OFF_PO = 616 * MB, OFF_MIX = 680 * MB, OFF_XO = 680 * MB,
                 OFF_TOPV = 808 * MB, OFF_TOPI = 872 * MB, OFF_KVS = 808 * MB, OFF_KSUM = 936 * MB, OFF_CSC = 938 * MB, OFF_BAR = 939 * MB, WS_NEED = 940 * MB;

struct Params {
  const float* in[25];
  float* out;
  char* ws;
};

DI int otid() { int t = __builtin_amdgcn_workitem_id_x(); asm volatile("" : "+v"(t)); return t; }
typedef __bf16 bf16v2 __attribute__((ext_vector_type(2)));
DI unsigned pack2(float a, float b) { const f32x2 v = {a, b}; return __builtin_bit_cast(unsigned, __builtin_convertvector(v, bf16v2)); }
DI u16 f2bf(float x) { return (u16)(pack2(x, 0.f) & 0xffffu); }
DI float bf2f(u16 h) { return __uint_as_float(((unsigned)h) << 16); }
DI float bflo(unsigned w) { return __uint_as_float(w << 16); }
DI float bfhi(unsigned w) { return __uint_as_float(w & 0xffff0000u); }
DI float wsum(float v) { for (int o = 32; o; o >>= 1) v += __shfl_xor(v, o); return v; }
DI float wmax(float v) { for (int o = 32; o; o >>= 1) v = fmaxf(v, __shfl_xor(v, o)); return v; }
DI int perm23(int i) { return (i & 0x13) | (((i >> 3) & 1) << 2) | (((i >> 2) & 1) << 3); }
DI f32x16 zero16() { f32x16 z; for (int i = 0; i < 16; ++i) z[i] = 0.f; return z; }
DI bf16x8 ldfrag(const u16* p) { return *(const bf16x8*)p; }
DI void unpack8(const uint4& r, float* o) {
  o[0] = bflo(r.x); o[1] = bfhi(r.x); o[2] = bflo(r.y); o[3] = bfhi(r.y); o[4] = bflo(r.z); o[5] = bfhi(r.z); o[6] = bflo(r.w); o[7] = bfhi(r.w);
}

DI void transpose_w(const float* __restrict__ src, u16* __restrict__ dst, int N, int Npad, float* tl) {
  const int ntn = Npad >> 6, ntiles = 16 * ntn;
  for (int t = blockIdx.x; t < ntiles; t += gridDim.x) {
    const int kt = t / ntn, nt = t - kt * ntn, k0 = kt * 64, n0 = nt * 64;
    for (int e = otid(); e < 4096; e += 512) { int r = e >> 6, c = e & 63, n = n0 + c; tl[r * 65 + c] = (n < N) ? src[(size_t)(k0 + r) * N + n] : 0.f; }
    __syncthreads();
    for (int e = otid(); e < 4096; e += 512) { int r = e >> 6, c = e & 63; dst[(size_t)(n0 + r) * 1024 + k0 + c] = f2bf(tl[c * 65 + r]); }
    __syncthreads();
  }
}
DI void convert_bf16(const float* __restrict__ src, u16* __restrict__ dst, size_t n4) {
  const size_t stride = (size_t)gridDim.x * 512;
  for (size_t i = (size_t)blockIdx.x * 512 + otid(); i < n4; i += stride) {
    float4 v = ((const float4*)src)[i];
    uint2 o; o.x = pack2(v.x, v.y); o.y = pack2(v.z, v.w);
    ((uint2*)dst)[i] = o;
  }
}

DI void convert_fp8_rows(const float* __restrict__ src, unsigned char* __restrict__ dst, float* __restrict__ invscale) {
  const int lane = otid() & 63, wave = otid() >> 6;
  for (int row = blockIdx.x * 8 + wave; row < 16384; row += gridDim.x * 8) {
    const float* r = src + (size_t)row * 1024 + 16 * lane;
    float4 v[4];
    float am = 0.f;
    for (int i = 0; i < 4; ++i) { v[i] = *(const float4*)(r + 4 * i); am = fmaxf(am, fmaxf(fmaxf(fabsf(v[i].x), fabsf(v[i].y)), fmaxf(fabsf(v[i].z), fabsf(v[i].w)))); }
    am = wmax(am);
    const float sc = am > 0.f ? 256.f / am : 1.f;
    uint4 o; unsigned w[4];
    for (int i = 0; i < 4; ++i) { int t = 0; t = __builtin_amdgcn_cvt_pk_fp8_f32(v[i].x * sc, v[i].y * sc, t, false); t = __builtin_amdgcn_cvt_pk_fp8_f32(v[i].z * sc, v[i].w * sc, t, true); w[i] = (unsigned)t; }
    o.x = w[0]; o.y = w[1]; o.z = w[2]; o.w = w[3];
    *(uint4*)(dst + (size_t)row * 1024 + 16 * lane) = o;
    if (lane == 0) invscale[row] = am > 0.f ? am * (1.f / 256.f) : 1.f;
  }
}
typedef __attribute__((ext_vector_type(6))) unsigned v6u;
typedef __attribute__((ext_vector_type(16))) float v16f;
typedef __attribute__((ext_vector_type(32))) float v32f;
DI void convert_fp6_rows(const float* __restrict__ src, unsigned char* __restrict__ dst, float* __restrict__ invscale) {
  const int lane = otid() & 63, wave = otid() >> 6, hb = lane >> 5, l5 = lane & 31;
  for (int row = (blockIdx.x * 8 + wave) * 2 + hb; row < 16384; row += gridDim.x * 16) {
    const float* r = src + (size_t)row * 1024 + 32 * l5;
    v16f x, y;
    float am = 0.f;
#pragma unroll
    for (int i = 0; i < 4; ++i) {
      const float4 a = *(const float4*)(r + 4 * i), b = *(const float4*)(r + 16 + 4 * i);
      x[2 * i] = a.x; y[2 * i] = a.y; x[2 * i + 1] = a.z; y[2 * i + 1] = a.w; x[8 + 2 * i] = b.x; y[8 + 2 * i] = b.y; x[8 + 2 * i + 1] = b.z; y[8 + 2 * i + 1] = b.w;
      am = fmaxf(am, fmaxf(fmaxf(fabsf(a.x), fabsf(a.y)), fmaxf(fabsf(a.z), fabsf(a.w))));
      am = fmaxf(am, fmaxf(fmaxf(fabsf(b.x), fabsf(b.y)), fmaxf(fabsf(b.z), fabsf(b.w))));
    }
    for (int o = 16; o; o >>= 1) am = fmaxf(am, __shfl_xor(am, o));
    const float sc = am > 0.f ? 7.0f / am : 1.f;
#pragma unroll
    for (int i = 0; i < 16; ++i) { x[i] *= sc; y[i] *= sc; }
    const v6u q = __builtin_amdgcn_cvt_scalef32_2xpk16_fp6_f32(x, y, 1.0f);
    unsigned* d = (unsigned*)(dst + (size_t)row * 768 + 24 * l5);
    *(uint2*)d = make_uint2(q[0], q[1]); *(uint2*)(d + 2) = make_uint2(q[2], q[3]); *(uint2*)(d + 4) = make_uint2(q[4], q[5]);
    if (l5 == 0) invscale[row] = am > 0.f ? am * (1.f / 7.0f) : 1.f;
  }
}

DI void ln_rows(const float* __restrict__ src, const float* __restrict__ g, const float* __restrict__ bta, u16* __restrict__ dst) {
  const int lane = otid() & 63, wave = otid() >> 6;
  for (int row = blockIdx.x * 8 + wave; row < T_TOK; row += gridDim.x * 8) {
    float4 v[4];
    float s = 0.f;
    for (int i = 0; i < 4; ++i) { v[i] = *(const float4*)(src + (size_t)row * 1024 + i * 256 + lane * 4); s += v[i].x + v[i].y + v[i].z + v[i].w; }
    const float mu = wsum(s) * (1.f / 1024.f);
    float q = 0.f;
    for (int i = 0; i < 4; ++i) { float a = v[i].x - mu, b = v[i].y - mu, c = v[i].z - mu, d = v[i].w - mu; q += a * a + b * b + c * c + d * d; }
    const float rstd = rsqrtf(wsum(q) * (1.f / 1024.f) + LN_EPS);
    for (int i = 0; i < 4; ++i) {
      const int c0 = i * 256 + lane * 4;
      float4 gg = *(const float4*)(g + c0), bb = *(const float4*)(bta + c0);
      uint2 o;
      o.x = pack2((v[i].x - mu) * rstd * gg.x + bb.x, (v[i].y - mu) * rstd * gg.y + bb.y);
      o.y = pack2((v[i].z - mu) * rstd * gg.z + bb.z, (v[i].w - mu) * rstd * gg.w + bb.w);
      *(uint2*)(dst + (size_t)row * 1024 + c0) = o;
    }
  }
}
DI void ln_rows_b(const u16* __restrict__ Zb, const float* __restrict__ g, const float* __restrict__ bta, u16* __restrict__ H) {
  const int lane = otid() & 63, wave = otid() >> 6;
  float gg[16], bb[16];
  for (int i = 0; i < 4; ++i) {
    const float4 g4 = *(const float4*)(g + lane * 16 + 4 * i), b4 = *(const float4*)(bta + lane * 16 + 4 * i);
    gg[4*i] = g4.x; gg[4*i+1] = g4.y; gg[4*i+2] = g4.z; gg[4*i+3] = g4.w; bb[4*i] = b4.x; bb[4*i+1] = b4.y; bb[4*i+2] = b4.z; bb[4*i+3] = b4.w;
  }
  const int stride = gridDim.x * 8;
  for (int row0 = blockIdx.x * 8 + wave; row0 < T_TOK; row0 += stride * 4) {
    uint4 r[4][2];
#pragma unroll
    for (int j = 0; j < 4; ++j) {
      const int row = row0 + j * stride;
      if (row < T_TOK) { r[j][0] = *(const uint4*)(Zb + (size_t)row * 1024 + lane * 16); r[j][1] = *(const uint4*)(Zb + (size_t)row * 1024 + lane * 16 + 8); }
    }
#pragma unroll
    for (int j = 0; j < 4; ++j) {
      const int row = row0 + j * stride;
      if (row < T_TOK) {
        float v[16];
        unpack8(r[j][0], v); unpack8(r[j][1], v + 8);
        float s = 0.f;
#pragma unroll
        for (int i = 0; i < 16; ++i) s += v[i];
        const float mu = wsum(s) * (1.f / 1024.f);
        float q = 0.f;
#pragma unroll
        for (int i = 0; i < 16; ++i) { float a = v[i] - mu; q += a * a; }
        const float rstd = rsqrtf(wsum(q) * (1.f / 1024.f) + LN_EPS);
        uint4 o0, o1;
        o0.x = pack2((v[0] - mu) * rstd * gg[0] + bb[0], (v[1] - mu) * rstd * gg[1] + bb[1]); o0.y = pack2((v[2] - mu) * rstd * gg[2] + bb[2], (v[3] - mu) * rstd * gg[3] + bb[3]);
        o0.z = pack2((v[4] - mu) * rstd * gg[4] + bb[4], (v[5] - mu) * rstd * gg[5] + bb[5]); o0.w = pack2((v[6] - mu) * rstd * gg[6] + bb[6], (v[7] - mu) * rstd * gg[7] + bb[7]);
        o1.x = pack2((v[8] - mu) * rstd * gg[8] + bb[8], (v[9] - mu) * rstd * gg[9] + bb[9]); o1.y = pack2((v[10] - mu) * rstd * gg[10] + bb[10], (v[11] - mu) * rstd * gg[11] + bb[11]);
        o1.z = pack2((v[12] - mu) * rstd * gg[12] + bb[12], (v[13] - mu) * rstd * gg[13] + bb[13]); o1.w = pack2((v[14] - mu) * rstd * gg[14] + bb[14], (v[15] - mu) * rstd * gg[15] + bb[15]);
        *(uint4*)(H + (size_t)row * 1024 + lane * 16) = o0;
        *(uint4*)(H + (size_t)row * 1024 + lane * 16 + 8) = o1;
      }
    }
  }
}
DI void ln_in_rows(const float* __restrict__ src, const float* __restrict__ g, const float* __restrict__ bta, const float* __restrict__ w_in, u16* __restrict__ dst, float* __restrict__ G, float* Wg) {
  const int lane = otid() & 63, wave = otid() >> 6;
  for (int e = otid(); e < 8192; e += 512) Wg[e] = w_in[(size_t)(e >> 3) * 3592 + 3584 + (e & 7)];
  __syncthreads();
  float4 nv[4];
  { const int row = blockIdx.x * 8 + wave; for (int i = 0; i < 4; ++i) nv[i] = *(const float4*)(src + (size_t)row * 1024 + i * 256 + lane * 4); }
  for (int row = blockIdx.x * 8 + wave; row < T_TOK; row += gridDim.x * 8) {
    float4 v[4];
    float s = 0.f;
    for (int i = 0; i < 4; ++i) { v[i] = nv[i]; s += v[i].x + v[i].y + v[i].z + v[i].w; }
    { const int nrow = row + gridDim.x * 8; if (nrow < T_TOK) for (int i = 0; i < 4; ++i) nv[i] = *(const float4*)(src + (size_t)nrow * 1024 + i * 256 + lane * 4); }
    const float mu = wsum(s) * (1.f / 1024.f);
    float q = 0.f;
    for (int i = 0; i < 4; ++i) { float a = v[i].x - mu, b = v[i].y - mu, c = v[i].z - mu, d = v[i].w - mu; q += a * a + b * b + c * c + d * d; }
    const float rstd = rsqrtf(wsum(q) * (1.f / 1024.f) + LN_EPS);
    float pg[8];
#pragma unroll
    for (int j = 0; j < 8; ++j) pg[j] = 0.f;
#pragma unroll
    for (int i = 0; i < 4; ++i) {
      const int c0 = i * 256 + lane * 4;
      float4 gg = *(const float4*)(g + c0), bb = *(const float4*)(bta + c0);
      float y[4];
      y[0] = (v[i].x - mu) * rstd * gg.x + bb.x; y[1] = (v[i].y - mu) * rstd * gg.y + bb.y; y[2] = (v[i].z - mu) * rstd * gg.z + bb.z; y[3] = (v[i].w - mu) * rstd * gg.w + bb.w;
      uint2 o; o.x = pack2(y[0], y[1]); o.y = pack2(y[2], y[3]);
      *(uint2*)(dst + (size_t)row * 1024 + c0) = o;
#pragma unroll
      for (int e = 0; e < 4; ++e) {
        const float4 w0 = *(const float4*)(Wg + (c0 + e) * 8), w1 = *(const float4*)(Wg + (c0 + e) * 8 + 4);
        pg[0] += y[e] * w0.x; pg[1] += y[e] * w0.y; pg[2] += y[e] * w0.z; pg[3] += y[e] * w0.w;
        pg[4] += y[e] * w1.x; pg[5] += y[e] * w1.y; pg[6] += y[e] * w1.z; pg[7] += y[e] * w1.w;
      }
    }
#pragma unroll
    for (int off = 32; off >= 8; off >>= 1) {
      const bool up = (lane & off) != 0;
      const int nkeep = off >> 3;
#pragma unroll
      for (int i = 0; i < 4; ++i) if (i < nkeep) {
        const float send = up ? pg[i] : pg[i + nkeep];
        const float keep = up ? pg[i + nkeep] : pg[i];
        pg[i] = keep + __shfl_xor(send, off);
      }
    }
    float tot = pg[0];
    tot += __shfl_xor(tot, 4); tot += __shfl_xor(tot, 2); tot += __shfl_xor(tot, 1);
    if ((lane & 7) == 0) G[(size_t)row * 8 + (lane >> 3)] = tot;
  }
}

typedef __attribute__((ext_vector_type(4))) float f32x4;
#define MFMA16(a, b, c) __builtin_amdgcn_mfma_f32_16x16x32_bf16((a), (b), (c), 0, 0, 0)
DI uint2 pack4(const f32x16& a, int g) { uint2 o; o.x = pack2(a[4 * g], a[4 * g + 1]); o.y = pack2(a[4 * g + 2], a[4 * g + 3]); return o; }
DI void stage_rc(int b, int& R, int& C) { const int st = b >> 10, sb = b & 1023, swz = sb ^ (((sb >> 9) & 1) << 5); R = (st >> 1) * 16 + (swz >> 6); C = (st & 1) * 32 + ((swz & 63) >> 1); }
constexpr int CT_LD = 264;
template <int SWAP>
DI void gemm256(const u16* __restrict__ Ab, const u16* __restrict__ Bb, const u16* __restrict__ nAb, const u16* __restrict__ nBb, bool first, bool has_next, f32x4 (&acc)[8][4], char* lds) {
  const int tid = otid(), wid = tid >> 6, lane = tid & 63, wr = wid >> 2, wc = wid & 3, fr = lane & 15, fq = lane >> 4;
  int goff[4];
#pragma unroll
  for (int i = 0; i < 4; ++i) { int R, C; stage_rc(wid * 1024 + i * 8192 + lane * 16, R, C); goff[i] = R * 1024 + C; }
#pragma unroll
  for (int m = 0; m < 8; ++m)
#pragma unroll
    for (int n = 0; n < 4; ++n) acc[m][n] = f32x4{0.f, 0.f, 0.f, 0.f};
  const int ob = fr * 64 + fq * 16, obs = ob ^ (((ob >> 9) & 1) << 5);
  const int aoff = wr * 16384 + obs, boff = 32768 + wc * 8192 + obs;
#define GLDS_STAGE(buf, pa, pb, kt) do { _Pragma("unroll") for (int i = 0; i < 4; ++i) { \
    __builtin_amdgcn_global_load_lds((const unsigned*)((pa) + goff[i] + (kt) * 64), (__attribute__((address_space(3))) unsigned*)(lds + (buf) * 65536 + wid * 1024 + i * 8192), 16, 0, 0); \
    __builtin_amdgcn_global_load_lds((const unsigned*)((pb) + goff[i] + (kt) * 64), (__attribute__((address_space(3))) unsigned*)(lds + (buf) * 65536 + 32768 + wid * 1024 + i * 8192), 16, 0, 0); } } while (0)
  if (first) {
    GLDS_STAGE(0, Ab, Bb, 0);
    asm volatile("s_waitcnt vmcnt(0)" ::: "memory");
    __syncthreads();
  }
#pragma unroll 1
  for (int t = 0; t < 16; ++t) {
    const int cur = t & 1;
    if (t < 15) GLDS_STAGE(cur ^ 1, Ab, Bb, t + 1);
    else if (has_next) GLDS_STAGE(0, nAb, nBb, 0);
    const char* sa = lds + cur * 65536 + aoff;
    const char* sb = lds + cur * 65536 + boff;
#pragma unroll
    for (int ks = 0; ks < 2; ++ks) {
      bf16x8 At[8], Bf[4];
#pragma unroll
      for (int m = 0; m < 8; ++m) At[m] = *(const bf16x8*)(sa + m * 2048 + ks * 1024);
#pragma unroll
      for (int n = 0; n < 4; ++n) Bf[n] = *(const bf16x8*)(sb + n * 2048 + ks * 1024);
#pragma unroll
      for (int m = 0; m < 8; ++m)
#pragma unroll
        for (int n = 0; n < 4; ++n) acc[m][n] = SWAP ? MFMA16(Bf[n], At[m], acc[m][n]) : MFMA16(At[m], Bf[n], acc[m][n]);
      __builtin_amdgcn_sched_group_barrier(0x100, 12, 0);
      __builtin_amdgcn_sched_group_barrier(0x008, 32, 0);
      __builtin_amdgcn_sched_barrier(0);
    }
    asm volatile("s_waitcnt vmcnt(0)" ::: "memory");
    __syncthreads();
  }
#undef GLDS_STAGE
}
DI void stage_acc(const f32x4 (&acc)[8][4], u16* Ct) {
  const int tid = otid(), wid = tid >> 6, lane = tid & 63, wr = wid >> 2, wc = wid & 3, fr = lane & 15, fq = lane >> 4;
#pragma unroll
  for (int m = 0; m < 8; ++m)
#pragma unroll
    for (int n = 0; n < 4; ++n) {
      uint2 o; o.x = pack2(acc[m][n][0], acc[m][n][1]); o.y = pack2(acc[m][n][2], acc[m][n][3]);
      *(uint2*)(Ct + (wr * 128 + m * 16 + fr) * CT_LD + wc * 64 + n * 16 + fq * 4) = o;
    }
}
template <int SWAP>
DI void store_acc(const f32x4 (&acc)[8][4], u16* __restrict__ dst, size_t ld) {
  const int tid = otid(), wid = tid >> 6, lane = tid & 63, wr = wid >> 2, wc = wid & 3, fr = lane & 15, fq = lane >> 4;
#pragma unroll
  for (int m = 0; m < 8; ++m)
#pragma unroll
    for (int n = 0; n < 4; ++n) {
      uint2 o; o.x = pack2(acc[m][n][0], acc[m][n][1]); o.y = pack2(acc[m][n][2], acc[m][n][3]);
      if (SWAP) *(uint2*)(dst + (size_t)(wr * 128 + m * 16 + fr) * ld + wc * 64 + n * 16 + fq * 4) = o;
      else *(uint2*)(dst + (size_t)(wc * 64 + n * 16 + fr) * ld + wr * 128 + m * 16 + fq * 4) = o;
    }
}
template <int SWAP, int MODE>
DI void epilogue_staged(const f32x4 (&acc)[8][4], char* lds, u16* __restrict__ dst, size_t ld, const u16* __restrict__ Hres) {
  const int tid = otid(), wid = tid >> 6, lane = tid & 63, wr = wid >> 2, wc = wid & 3, fr = lane & 15, fq = lane >> 4;
  u16* Ct = (u16*)(lds + 65536);
#pragma unroll
  for (int h = 0; h < 2; ++h) {
    if ((SWAP ? wr : (wc >> 1)) == h) {
#pragma unroll
      for (int m = 0; m < 8; ++m)
#pragma unroll
        for (int n = 0; n < 4; ++n) {
          uint2 o; o.x = pack2(acc[m][n][0], acc[m][n][1]); o.y = pack2(acc[m][n][2], acc[m][n][3]);
          if (SWAP) *(uint2*)(Ct + (m * 16 + fr) * CT_LD + wc * 64 + n * 16 + fq * 4) = o;
          else *(uint2*)(Ct + ((wc & 1) * 64 + n * 16 + fr) * CT_LD + wr * 128 + m * 16 + fq * 4) = o;
        }
    }
    __syncthreads();
#pragma unroll 4
    for (int i = 0; i < 8; ++i) {
      const int q = tid + 512 * i, r = q >> 5, c8 = (q & 31) * 8;
      uint4 v = *(const uint4*)(Ct + r * CT_LD + c8);
      const size_t o = (size_t)(h * 128 + r) * ld + c8;
      if (MODE == 1) {
        const uint4 hv = *(const uint4*)(Hres + o);
        float y[8], hx[8]; unpack8(v, y); unpack8(hv, hx);
        v.x = pack2(ALPHA * hx[0] + y[0], ALPHA * hx[1] + y[1]); v.y = pack2(ALPHA * hx[2] + y[2], ALPHA * hx[3] + y[3]);
        v.z = pack2(ALPHA * hx[4] + y[4], ALPHA * hx[5] + y[5]); v.w = pack2(ALPHA * hx[6] + y[6], ALPHA * hx[7] + y[7]);
      }
      *(uint4*)(dst + o) = v;
    }
    __syncthreads();
  }
}
DI int lds_byte8(int r, int c) { const int st = (r >> 4) * 2 + (c >> 5), ob = (r & 15) * 64 + (c & 31) * 2; return st * 1024 + (ob ^ (((ob >> 9) & 1) << 5)); }
template <int SWAP>
DI void gemm8p(const u16* __restrict__ Ab, const u16* __restrict__ Bb, f32x4 (&acc)[2][2][4][2], char* lds) {
  constexpr int K = 1024, BK = 64, HALF = 128, HTB = 128 * 64 * 2;
  const int tid = otid(), wid = tid >> 6, lane = tid & 63, wr = wid >> 2, wc = wid & 3, fr = lane & 15, fq = lane >> 4;
  int goff0;
  { int R, C; stage_rc(tid * 16, R, C); goff0 = R * K + C; }
#define SA8(b, h) (lds + ((b) * 2 + (h)) * HTB)
#define SB8(b, h) (lds + (4 + (b) * 2 + (h)) * HTB)
#define STAGE8(P, BASE, br, kt) do { _Pragma("unroll") for (int _i = 0; _i < 2; ++_i) \
    __builtin_amdgcn_global_load_lds((const unsigned*)((BASE) + (size_t)((br) + 64 * _i) * K + (kt) * BK + goff0), (__attribute__((address_space(3))) unsigned*)((P) + wid * 1024 + _i * 8192), 16, 0, 0); } while (0)
#define LDA8(dst, b, h) _Pragma("unroll") for (int m = 0; m < 4; ++m) _Pragma("unroll") for (int k = 0; k < 2; ++k) \
    dst[m][k] = *(const bf16x8*)(SA8(b, h) + lds_byte8(wr * 64 + m * 16 + fr, k * 32 + fq * 8))
#define LDB8(dst, b, h) _Pragma("unroll") for (int n = 0; n < 2; ++n) _Pragma("unroll") for (int k = 0; k < 2; ++k) \
    dst[n][k] = *(const bf16x8*)(SB8(b, h) + lds_byte8(wc * 32 + n * 16 + fr, k * 32 + fq * 8))
#define MMA8(ai, bj, At_, Bt_) do { __builtin_amdgcn_s_setprio(1); \
    _Pragma("unroll") for (int m = 0; m < 4; ++m) _Pragma("unroll") for (int n = 0; n < 2; ++n) _Pragma("unroll") for (int k = 0; k < 2; ++k) \
      acc[ai][bj][m][n] = SWAP ? MFMA16(Bt_[n][k], At_[m][k], acc[ai][bj][m][n]) : MFMA16(At_[m][k], Bt_[n][k], acc[ai][bj][m][n]); \
    __builtin_amdgcn_s_setprio(0); } while (0)
#define WAIT_V(n) asm volatile("s_waitcnt vmcnt(" #n ")" ::: "memory")
#define WAIT_L(n) asm volatile("s_waitcnt lgkmcnt(" #n ")" ::: "memory")
#define BAR8 __builtin_amdgcn_s_barrier()
#define SCHED8 __builtin_amdgcn_sched_barrier(0)
#pragma unroll
  for (int ai = 0; ai < 2; ++ai)
#pragma unroll
    for (int bj = 0; bj < 2; ++bj)
#pragma unroll
      for (int m = 0; m < 4; ++m)
#pragma unroll
        for (int n = 0; n < 2; ++n) acc[ai][bj][m][n] = f32x4{0.f, 0.f, 0.f, 0.f};
  bf16x8 At[4][2], B0[2][2], B1[2][2];
  constexpr int nt = K / BK;
  STAGE8(SB8(0, 0), Bb, 0, 0); STAGE8(SA8(0, 0), Ab, 0, 0);
  STAGE8(SB8(0, 1), Bb, HALF, 0); STAGE8(SA8(0, 1), Ab, HALF, 0);
  if (wr == 1) BAR8;
  WAIT_V(4); BAR8;
  STAGE8(SB8(1, 0), Bb, 0, 1); STAGE8(SA8(1, 0), Ab, 0, 1); STAGE8(SB8(1, 1), Bb, HALF, 1);
  WAIT_V(6); BAR8;
#pragma unroll 1
  for (int t = 0; t < nt - 2; t += 2) {
    LDB8(B0, 0, 0); SCHED8; LDA8(At, 0, 0); STAGE8(SA8(1, 1), Ab, HALF, t + 1);
    WAIT_L(8); BAR8; WAIT_L(0); MMA8(0, 0, At, B0); BAR8; SCHED8;
    LDB8(B1, 0, 1); STAGE8(SB8(0, 0), Bb, 0, t + 2);
    BAR8; WAIT_L(0); MMA8(0, 1, At, B1); BAR8;
    LDA8(At, 0, 1); STAGE8(SA8(0, 0), Ab, 0, t + 2);
    BAR8; WAIT_L(0); MMA8(1, 0, At, B0); BAR8; SCHED8;
    STAGE8(SB8(0, 1), Bb, HALF, t + 2);
    WAIT_V(6); BAR8; MMA8(1, 1, At, B1); BAR8;
    LDB8(B0, 1, 0); SCHED8; LDA8(At, 1, 0); STAGE8(SA8(0, 1), Ab, HALF, t + 2);
    WAIT_L(8); BAR8; WAIT_L(0); MMA8(0, 0, At, B0); BAR8; SCHED8;
    LDB8(B1, 1, 1); STAGE8(SB8(1, 0), Bb, 0, t + 3);
    BAR8; WAIT_L(0); MMA8(0, 1, At, B1); BAR8;
    LDA8(At, 1, 1); STAGE8(SA8(1, 0), Ab, 0, t + 3);
    BAR8; WAIT_L(0); MMA8(1, 0, At, B0); BAR8; SCHED8;
    STAGE8(SB8(1, 1), Bb, HALF, t + 3);
    WAIT_V(6); BAR8; MMA8(1, 1, At, B1); BAR8;
  }
  { LDB8(B0, 0, 0); LDA8(At, 0, 0); STAGE8(SA8(1, 1), Ab, HALF, nt - 1);
    BAR8; WAIT_L(0); MMA8(0, 0, At, B0); BAR8;
    LDB8(B1, 0, 1); BAR8; WAIT_L(0); MMA8(0, 1, At, B1); BAR8;
    LDA8(At, 0, 1); WAIT_V(4); BAR8; WAIT_L(0); MMA8(1, 0, At, B0); MMA8(1, 1, At, B1); BAR8; }
  { LDB8(B0, 1, 0); LDA8(At, 1, 0); WAIT_V(2); BAR8; WAIT_L(0); MMA8(0, 0, At, B0); BAR8;
    LDB8(B1, 1, 1); WAIT_V(0); BAR8; WAIT_L(0); MMA8(0, 1, At, B1); BAR8;
    LDA8(At, 1, 1); BAR8; WAIT_L(0); MMA8(1, 0, At, B0); MMA8(1, 1, At, B1); BAR8; }
  if (wr == 0) BAR8;
  __syncthreads();
#undef SA8
#undef SB8
#undef STAGE8
#undef LDA8
#undef LDB8
#undef MMA8
#undef WAIT_V
#undef WAIT_L
#undef BAR8
#undef SCHED8
}
template <int SWAP>
DI void stage8(const f32x4 (&acc)[2][2][4][2], u16* Ct) {
  const int tid = otid(), wid = tid >> 6, lane = tid & 63, wr = wid >> 2, wc = wid & 3, fr = lane & 15, fq = lane >> 4;
#pragma unroll
  for (int ai = 0; ai < 2; ++ai)
#pragma unroll
    for (int bj = 0; bj < 2; ++bj)
#pragma unroll
      for (int m = 0; m < 4; ++m)
#pragma unroll
        for (int n = 0; n < 2; ++n) {
          uint2 o; o.x = pack2(acc[ai][bj][m][n][0], acc[ai][bj][m][n][1]); o.y = pack2(acc[ai][bj][m][n][2], acc[ai][bj][m][n][3]);
          if (SWAP) *(uint2*)(Ct + (ai * 128 + wr * 64 + m * 16 + fr) * CT_LD + bj * 128 + wc * 32 + n * 16 + fq * 4) = o;
          else *(uint2*)(Ct + (bj * 128 + wc * 32 + n * 16 + fr) * CT_LD + ai * 128 + wr * 64 + m * 16 + fq * 4) = o;
        }
}
template <int SWAP, int MODE>
DI void epilogue8(const f32x4 (&acc)[2][2][4][2], char* lds, u16* __restrict__ dst, size_t ld, const u16* __restrict__ Hres) {
  const int tid = otid();
  u16* Ct = (u16*)lds;
  stage8<SWAP>(acc, Ct);
  __syncthreads();
#pragma unroll 4
  for (int i = 0; i < 16; ++i) {
    const int q = tid + 512 * i, r = q >> 5, c8 = (q & 31) * 8;
    uint4 v = *(const uint4*)(Ct + r * CT_LD + c8);
    const size_t o = (size_t)r * ld + c8;
    if (MODE == 1) {
      const uint4 hv = *(const uint4*)(Hres + o);
      float y[8], hx[8]; unpack8(v, y); unpack8(hv, hx);
      v.x = pack2(ALPHA * hx[0] + y[0], ALPHA * hx[1] + y[1]); v.y = pack2(ALPHA * hx[2] + y[2], ALPHA * hx[3] + y[3]);
      v.z = pack2(ALPHA * hx[4] + y[4], ALPHA * hx[5] + y[5]); v.w = pack2(ALPHA * hx[6] + y[6], ALPHA * hx[7] + y[7]);
    }
    *(uint4*)(dst + o) = v;
  }
  __syncthreads();
}

DI bool tile_of(int it, int MT, int NT, int& mt, int& nt) {
  const int nb = gridDim.x;
  if ((nb & 7) == 0 && (MT & 7) == 0) {
    const int x = blockIdx.x & 7, slot = blockIdx.x >> 3, nx = nb >> 3, j = slot + it * nx, per = (MT >> 3) * NT;
    if (j >= per) return false;
    mt = x * (MT >> 3) + j / NT; nt = j % NT; return true;
  }
  const int j = blockIdx.x + it * nb;
  if (j >= MT * NT) return false;
  mt = j / NT; nt = j % NT; return true;
}

DI void phase_inproj(const Params& p, char* lds) {
  char* ws = p.ws;
  const u16* A = (const u16*)(ws + OFF_H); const u16* W = (const u16*)(ws + OFF_WIN);
  int mt, nt; bool have = tile_of(0, 256, 14, mt, nt);
  for (int it = 0; have; ++it) {
    const int m0 = mt * 256, n0 = nt * 256;
    int mtn, ntn; const bool hn = tile_of(it + 1, 256, 14, mtn, ntn);
    const u16* nA = A + (size_t)(hn ? mtn : 0) * 256 * 1024; const u16* nB = W + (size_t)(hn ? ntn : 0) * 256 * 1024;
    const bool tr = (n0 >= 1024 && n0 < 1536) || (n0 >= 2560 && n0 < 3072);
    f32x4 acc[2][2][4][2];
    if (tr) {
      gemm8p<0>(A + (size_t)m0 * 1024, W + (size_t)n0 * 1024, acc, lds);
      u16* dst = (n0 < 1536) ? (u16*)(ws + OFF_VTA) + ((size_t)((m0 >> 13) * 512 + (n0 - 1024))) * SEQ + (m0 & 8191)
                             : (u16*)(ws + OFF_VTM) + ((size_t)((m0 >> 13) * 512 + (n0 - 2560))) * SEQ + (m0 & 8191);
      epilogue8<0, 0>(acc, lds, dst, SEQ, nullptr);
    } else {
      gemm8p<1>(A + (size_t)m0 * 1024, W + (size_t)n0 * 1024, acc, lds);
      u16* dst; size_t ld;
      if (n0 < 1024) { dst = (u16*)(ws + OFF_PA) + (size_t)m0 * 1024 + n0; ld = 1024; }
      else if (n0 < 2560) { dst = (u16*)(ws + OFF_PM) + (size_t)m0 * 1024 + (n0 - 1536); ld = 1024; }
      else { dst = (u16*)(ws + OFF_PO) + (size_t)m0 * 512 + (n0 - 3072); ld = 512; }
      epilogue8<1, 0>(acc, lds, dst, ld, nullptr);
    }
    mt = mtn; nt = ntn; have = hn;
  }
  for (int it = 0;; ++it) {
    if (!tile_of(it, 8, 8, mt, nt)) break;
    const int m0 = mt * 256, n0 = nt * 256;
    const u16* Am = (const u16*)(ws + OFF_MEMB) + (size_t)m0 * 1024; const u16* Bm = (const u16*)(ws + OFF_WKV) + (size_t)n0 * 1024;
    f32x4 acc[2][2][4][2];
    if (n0 >= 1024) { gemm8p<0>(Am, Bm, acc, lds); epilogue8<0, 0>(acc, lds, (u16*)(ws + OFF_VTX) + ((size_t)((m0 >> 8) * 1024 + (n0 - 1024))) * 256, 256, nullptr); }
    else { gemm8p<1>(Am, Bm, acc, lds); epilogue8<1, 0>(acc, lds, (u16*)(ws + OFF_KX) + (size_t)m0 * 1024 + n0, 1024, nullptr); }
  }
}

template <int MODE>
DI void phase_gemm1024(const u16* __restrict__ A, const u16* __restrict__ Wt, u16* __restrict__ dstb, const u16* __restrict__ Hres, char* lds) {
  const int tid = otid(), wid = tid >> 6, lane = tid & 63, wr = wid >> 2, wc = wid & 3, fr = lane & 15, fq = lane >> 4;
  int mt, nt; bool have = tile_of(0, 256, 4, mt, nt);
  for (int it = 0; have; ++it) {
    const int m0 = mt * 256, n0 = nt * 256;
    int mtn, ntn; const bool hn = tile_of(it + 1, 256, 4, mtn, ntn);
    f32x4 acc[2][2][4][2];
    gemm8p<1>(A + (size_t)m0 * 1024, Wt + (size_t)n0 * 1024, acc, lds);
    epilogue8<1, MODE>(acc, lds, dstb + (size_t)m0 * 1024 + n0, 1024, (MODE == 1) ? Hres + (size_t)m0 * 1024 + n0 : nullptr);
    mt = mtn; nt = ntn; have = hn;
  }
}

DI void attn_item(const Params& p, char* lds, int item) {
  char* ws = p.ws;
  const int tid = otid(), lane = tid & 63, wave = tid >> 6, l31 = lane & 31, hh = lane >> 5;
  const int b = item >> 8, h = (item >> 5) & 7, c0 = (item & 31) * 4;
  const int qc = c0 + (wave >> 1), qt = wave & 1;
  const u16* PA = (const u16*)(ws + OFF_PA); const u16* VTa = (const u16*)(ws + OFF_VTA); u16* MIX = (u16*)(ws + OFF_MIX);
  u16* Kl = (u16*)lds;
  u16* Vl = Kl + 2 * 64 * 72;
  float* biasl = (float*)(Vl + 2 * 64 * 72);
  const int pi = perm23(l31);
  const int sr = tid >> 3, sc8 = (tid & 7) * 8;
  const u16* kg = PA + ((size_t)b * SEQ + sr) * 1024 + 512 + h * 64 + sc8;
  const u16* vg = VTa + ((size_t)((b * 8 + h) * 64 + sr)) * SEQ + sc8;
  for (int i = tid; i < 257; i += 512) biasl[i] = p.in[10][h * 257 + i] * 1.4426950408889634f;
  const size_t q0 = (size_t)b * SEQ + qc * 64 + qt * 32;
  bf16x8 Qf[4];
#pragma unroll
  for (int kk = 0; kk < 4; ++kk) Qf[kk] = ldfrag(PA + (q0 + l31) * 1024 + h * 64 + kk * 16 + 8 * hh);
  const int kcs = (c0 >= 8) ? c0 - 8 : 0, kce = c0 + 3;
  *(uint4*)(Kl + sr * 72 + sc8) = *(const uint4*)(kg + (size_t)(kcs * 64) * 1024);
  *(uint4*)(Vl + sr * 72 + sc8) = *(const uint4*)(vg + kcs * 64);
  __syncthreads();
  f32x16 O[2]; O[0] = zero16(); O[1] = zero16();
  float mrun = -INFINITY, lrun = 0.f;
#pragma unroll 1
  for (int kc = kcs; kc <= kce; ++kc) {
    const int cur = (kc - kcs) & 1;
    uint4 nk, nv;
    if (kc < kce) { nk = *(const uint4*)(kg + (size_t)((kc + 1) * 64) * 1024); nv = *(const uint4*)(vg + (kc + 1) * 64); }
    if (kc >= qc - 8 && kc <= qc) {
      f32x16 S[2];
      float mx = -INFINITY;
#pragma unroll
      for (int sub = 0; sub < 2; ++sub) {
        const u16* kl = Kl + cur * 64 * 72 + (sub * 32 + pi) * 72 + 8 * hh;
        S[sub] = zero16();
#pragma unroll
        for (int kk = 0; kk < 4; ++kk) S[sub] = MFMA(ldfrag(kl + kk * 16), Qf[kk], S[sub]);
        const int relbase = (kc * 64 + sub * 32 + 8 * hh) - (qc * 64 + qt * 32 + l31);
        if ((kc * 64 + sub * 32 + 31) - (qc * 64 + qt * 32) <= -128) {
          const float b0 = biasl[0];
#pragma unroll
          for (int r = 0; r < 16; ++r) { const float sv = S[sub][r] * 0.18033688011112042f + b0; S[sub][r] = sv; mx = fmaxf(mx, sv); }
        } else {
#pragma unroll
          for (int r = 0; r < 16; ++r) {
            int rel = relbase + 16 * (r >> 3) + (r & 7);
            rel = rel < -128 ? -128 : (rel > 128 ? 128 : rel);
            const float sv = S[sub][r] * 0.18033688011112042f + biasl[rel + 128];
            S[sub][r] = sv; mx = fmaxf(mx, sv);
          }
        }
      }
      mx = fmaxf(mx, __shfl_xor(mx, 32));
      const float mnew = fmaxf(mrun, mx);
      const float alpha = __builtin_amdgcn_exp2f(mrun - mnew);
      mrun = mnew;
      float ps = 0.f;
#pragma unroll
      for (int sub = 0; sub < 2; ++sub)
#pragma unroll
        for (int r = 0; r < 16; ++r) { const float e = __builtin_amdgcn_exp2f(S[sub][r] - mnew); S[sub][r] = e; ps += e; }
      lrun = lrun * alpha + ps;
#pragma unroll
      for (int r = 0; r < 16; ++r) { O[0][r] *= alpha; O[1][r] *= alpha; }
#pragma unroll
      for (int sub = 0; sub < 2; ++sub) {
        bf16x8 Pf[2];
#pragma unroll
        for (int ks = 0; ks < 2; ++ks) {
          union { bf16x8 v; unsigned u[4]; } cv;
          for (int j2 = 0; j2 < 4; ++j2) cv.u[j2] = pack2(S[sub][8 * ks + 2 * j2], S[sub][8 * ks + 2 * j2 + 1]);
          Pf[ks] = cv.v;
        }
        const u16* vl = Vl + cur * 64 * 72 + l31 * 72 + sub * 32 + 8 * hh;
#pragma unroll
        for (int dt = 0; dt < 2; ++dt)
#pragma unroll
          for (int ks = 0; ks < 2; ++ks) O[dt] = MFMA(ldfrag(vl + dt * 32 * 72 + 16 * ks), Pf[ks], O[dt]);
      }
    }
    if (kc < kce) { const int nx = cur ^ 1; *(uint4*)(Kl + nx * 64 * 72 + sr * 72 + sc8) = nk; *(uint4*)(Vl + nx * 64 * 72 + sr * 72 + sc8) = nv; }
    __syncthreads();
  }
  const float inv = __builtin_amdgcn_rcpf(lrun + __shfl_xor(lrun, 32));
#pragma unroll
  for (int dt = 0; dt < 2; ++dt)
#pragma unroll
    for (int g = 0; g < 4; ++g) {
      uint2 o; o.x = pack2(O[dt][4 * g] * inv, O[dt][4 * g + 1] * inv); o.y = pack2(O[dt][4 * g + 2] * inv, O[dt][4 * g + 3] * inv);
      *(uint2*)(MIX + (q0 + l31) * 1024 + h * 64 + dt * 32 + 8 * g + 4 * hh) = o;
    }
}

DI float log_sigmoid(float f) { return fminf(f, 0.f) - log1pf(expf(-fabsf(f))); }
DI float scan_sum(float v, int lane) { for (int o = 1; o < 64; o <<= 1) { float tv = __shfl_up(v, o); if (lane >= o) v += tv; } return v; }
DI float scan_max(float v, int lane) { for (int o = 1; o < 64; o <<= 1) { float tv = __shfl_up(v, o); if (lane >= o) v = fmaxf(v, tv); } return v; }

DI void conv_unit(const u16* __restrict__ PM, const float* __restrict__ conv_w, const float* __restrict__ conv_b, int b, int sl0, int ch, float scale, float* a8) {
  { const float4 b0 = *(const float4*)(conv_b + ch), b1 = *(const float4*)(conv_b + ch + 4); a8[0] = b0.x; a8[1] = b0.y; a8[2] = b0.z; a8[3] = b0.w; a8[4] = b1.x; a8[5] = b1.y; a8[6] = b1.z; a8[7] = b1.w; }
#pragma unroll
  for (int j = 0; j < 4; ++j) {
    const int sl = sl0 - 3 + j;
    if (sl >= 0) {
      const uint4 raw = *(const uint4*)(PM + ((size_t)b * SEQ + sl) * 1024 + ch);
      float x8[8]; unpack8(raw, x8);
      const float4 w0 = *(const float4*)(conv_w + j * 1024 + ch), w1 = *(const float4*)(conv_w + j * 1024 + ch + 4);
      a8[0] += w0.x * x8[0]; a8[1] += w0.y * x8[1]; a8[2] += w0.z * x8[2]; a8[3] += w0.w * x8[3];
      a8[4] += w1.x * x8[4]; a8[5] += w1.y * x8[5]; a8[6] += w1.z * x8[6]; a8[7] += w1.w * x8[7];
    }
  }
#pragma unroll
  for (int e = 0; e < 8; ++e) { const float v = a8[e]; a8[e] = scale * v * __builtin_amdgcn_rcpf(1.f + __expf(-v)); }
}

DI void mlstmA_item(const Params& p, char* lds, int item) {
  char* ws = p.ws;
  const int bh = item >> 7, c = item & 127, b = bh >> 2, hd = bh & 3;
  const int tid = otid(), lane = tid & 63, wave = tid >> 6, hh = lane >> 5, l31 = lane & 31;
  u16* KTs = (u16*)lds;
  u16* VTs = KTs + 128 * 72;
  float* win = (float*)(VTs + 128 * 72);
  const u16* PM = (const u16*)(ws + OFF_PM); const u16* VTm = (const u16*)(ws + OFF_VTM);
  const float* G = (const float*)(ws + OFF_G);
  u16* KVS = (u16*)(ws + OFF_KVS) + (size_t)item * 16384; float* KSUM = (float*)(ws + OFF_KSUM) + (size_t)item * 128; float* CSC = (float*)(ws + OFF_CSC) + (size_t)item * 4;
  if (wave == 0) {
    const size_t row = (size_t)b * SEQ + c * 64 + lane;
    const float ig = G[row * 8 + hd] + p.in[7][hd], fg = G[row * 8 + 4 + hd] + p.in[8][hd];
    const float bc = scan_sum(log_sigmoid(fg), lane);
    const float as = ig - bc;
    const float gmax = wmax(as);
    const float B = __shfl(bc, 63);
    win[lane] = expf(as - gmax);
    if (lane == 0) { CSC[0] = B; CSC[1] = B + gmax; }
  }
  for (int i = 0; i < 2; ++i) {
    const int q = tid + 512 * i, e = q >> 3, s8 = (q & 7) * 8;
    *(uint4*)(VTs + e * 72 + s8) = *(const uint4*)(VTm + ((size_t)(bh * 128 + e)) * SEQ + c * 64 + s8);
  }
  __syncthreads();
#pragma unroll 1
  for (int i = 0; i < 2; ++i) {
    const int cgk = tid & 15, t = (tid >> 4) + 32 * i;
    float a8[8];
    conv_unit(PM, p.in[5], p.in[6], b, c * 64 + t, 512 + hd * 128 + cgk * 8, 0.08838834764831845f, a8);
    const float w = win[t];
#pragma unroll
    for (int e = 0; e < 8; ++e) KTs[(cgk * 8 + e) * 72 + t] = f2bf(a8[e] * w);
  }
  __syncthreads();
  {
    const int dt = wave >> 1;
#pragma unroll
    for (int x = 0; x < 2; ++x) {
      const int e2 = (wave & 1) * 2 + x;
      f32x16 acc = zero16();
#pragma unroll
      for (int ks = 0; ks < 4; ++ks) acc = MFMA(ldfrag(KTs + (dt * 32 + l31) * 72 + ks * 16 + 8 * hh), ldfrag(VTs + (e2 * 32 + l31) * 72 + ks * 16 + 8 * hh), acc);
#pragma unroll
      for (int g = 0; g < 4; ++g) *(uint2*)(KVS + (e2 * 32 + l31) * 128 + dt * 32 + 8 * g + 4 * hh) = pack4(acc, g);
    }
    if (tid < 128) {
      float sacc = 0.f;
      for (int s8 = 0; s8 < 8; ++s8) { const uint4 raw = *(const uint4*)(KTs + tid * 72 + s8 * 8); float x8[8]; unpack8(raw, x8); for (int e = 0; e < 8; ++e) sacc += x8[e]; }
      KSUM[tid] = sacc;
    }
  }
  __syncthreads();
}

DI void phase_mlstm_scan(const Params& p) {
  char* ws = p.ws;
  const int tid = otid();
  for (int unit = blockIdx.x; unit < 256; unit += gridDim.x) {
    const int bh = unit >> 3, part = unit & 7;
    u16* kv = (u16*)(ws + OFF_KVS) + (size_t)bh * 128 * 16384 + part * 2048 + tid * 4;
    float* ks = (float*)(ws + OFF_KSUM) + (size_t)bh * 128 * 128 + tid;
    float* csc = (float*)(ws + OFF_CSC) + (size_t)bh * 128 * 4;
    const bool don = (part == 0) && (tid < 128);
    float m = 0.f, c0 = 0.f, c1 = 0.f, c2 = 0.f, c3 = 0.f, n = 0.f;
#pragma unroll 1
    for (int cb = 0; cb < 128; cb += 8) {
      uint2 raw[8]; float kr[8];
#pragma unroll
      for (int j = 0; j < 8; ++j) { raw[j] = *(const uint2*)(kv + (size_t)(cb + j) * 16384); kr[j] = don ? ks[(cb + j) * 128] : 0.f; }
#pragma unroll
      for (int j = 0; j < 8; ++j) {
        const float B = csc[(cb + j) * 4], A = csc[(cb + j) * 4 + 1];
        const float mnew = fmaxf(B + m, A);
        const float wp = __expf(B + m - mnew), wl = __expf(A - mnew);
        m = mnew;
        c0 = wp * c0 + wl * bflo(raw[j].x); c1 = wp * c1 + wl * bfhi(raw[j].x); c2 = wp * c2 + wl * bflo(raw[j].y); c3 = wp * c3 + wl * bfhi(raw[j].y);
        uint2 o; o.x = pack2(c0, c1); o.y = pack2(c2, c3);
        *(uint2*)(kv + (size_t)(cb + j) * 16384) = o;
        if (don) { n = wp * n + wl * kr[j]; ks[(cb + j) * 128] = n; }
        if (part == 0 && tid == 0) csc[(cb + j) * 4 + 2] = mnew;
      }
    }
  }
}

DI void mlstmC_pair(const Params& p, char* lds_all, int pair) {
  char* ws = p.ws;
  const int tid = otid(), hb = tid >> 8, ltid = tid & 255, lane = tid & 63, lwave = ltid >> 6, hh = lane >> 5, l31 = lane & 31;
  const int item = pair * 2 + hb;
  const int bh = item >> 7, c = item & 127, b = bh >> 2, hd = bh & 3;
  char* lds = lds_all + hb * 69632;
  u16* Qs = (u16*)lds;
  u16* Ks = Qs + 64 * 136;
  u16* VTs = Ks + 64 * 136;
  u16* Ps = VTs + 128 * 72;
  float* fs = (float*)(Ps + 64 * 72);
  float* a_s = fs; float* c_t = fs + 64; float* wint = fs + 128; float* emt = fs + 192; float* qnp = fs + 256; float* qks = fs + 512; float* red = fs + 640;
  const u16* PM = (const u16*)(ws + OFF_PM); const u16* VTm = (const u16*)(ws + OFF_VTM); const u16* PO = (const u16*)(ws + OFF_PO);
  const float* G = (const float*)(ws + OFF_G); u16* MIX = (u16*)(ws + OFF_MIX);
  const u16* CT = (const u16*)(ws + OFF_KVS) + (size_t)(item - 1) * 16384;
  const float* NP = (const float*)(ws + OFF_KSUM) + (size_t)(item - 1) * 128;
  const float* ng = p.in[9] + hd * 128;
  const float mprev = (c > 0) ? ((const float*)(ws + OFF_CSC))[(size_t)(item - 1) * 4 + 2] : 0.f;
#pragma unroll 1
  for (int i = 0; i < 8; ++i) {
    const int cg8 = ltid & 31, isK = cg8 >> 4, chl = (cg8 & 15) * 8, t = (ltid >> 5) + 8 * i;
    float a8[8];
    conv_unit(PM, p.in[5], p.in[6], b, c * 64 + t, (isK ? 512 : 0) + hd * 128 + chl, isK ? 0.08838834764831845f : 1.f, a8);
    uint4 o; o.x = pack2(a8[0], a8[1]); o.y = pack2(a8[2], a8[3]); o.z = pack2(a8[4], a8[5]); o.w = pack2(a8[6], a8[7]);
    *(uint4*)((isK ? Ks : Qs) + t * 136 + chl) = o;
  }
  for (int i = 0; i < 4; ++i) {
    const int q = ltid + 256 * i, e = q >> 3, s8 = (q & 7) * 8;
    *(uint4*)(VTs + e * 72 + s8) = *(const uint4*)(VTm + ((size_t)(bh * 128 + e)) * SEQ + c * 64 + s8);
  }
  if (lwave == 0) {
    const size_t row = (size_t)b * SEQ + c * 64 + lane;
    const float ig = G[row * 8 + hd] + p.in[7][hd], fg = G[row * 8 + 4 + hd] + p.in[8][hd];
    const float bc = scan_sum(log_sigmoid(fg), lane);
    const float as = ig - bc;
    const float gm = scan_max(as, lane);
    const float mt = bc + fmaxf(mprev, gm);
    a_s[lane] = as; c_t[lane] = bc - mt; wint[lane] = expf(bc + mprev - mt); emt[lane] = expf(-mt);
  }
  __syncthreads();
  {
    const int t = ltid & 63, part = ltid >> 6;
    float acc = 0.f;
    if (c > 0) for (int dd = 0; dd < 32; ++dd) acc += bf2f(Qs[t * 136 + part * 32 + dd]) * NP[part * 32 + dd];
    qnp[part * 64 + t] = acc;
  }
  {
    const int si = lwave >> 1, ti = lwave & 1;
    f32x16 S = zero16();
#pragma unroll
    for (int kk = 0; kk < 8; ++kk) S = MFMA(ldfrag(Ks + (si * 32 + l31) * 136 + kk * 16 + 8 * hh), ldfrag(Qs + (ti * 32 + l31) * 136 + kk * 16 + 8 * hh), S);
    const int t = ti * 32 + l31;
    const float ct = c_t[t];
    float rs = 0.f;
#pragma unroll
    for (int g = 0; g < 4; ++g) {
      float v4[4];
#pragma unroll
      for (int q = 0; q < 4; ++q) {
        const int sidx2 = si * 32 + 8 * g + 4 * hh + q;
        const float dv = (sidx2 <= t) ? S[4 * g + q] * __expf(ct + a_s[sidx2]) : 0.f;
        v4[q] = dv; rs += dv;
      }
      uint2 o; o.x = pack2(v4[0], v4[1]); o.y = pack2(v4[2], v4[3]);
      *(uint2*)(Ps + t * 72 + si * 32 + 8 * g + 4 * hh) = o;
    }
    rs += __shfl_xor(rs, 32);
    if (hh == 0) qks[si * 64 + t] = rs;
  }
  __syncthreads();
  const int et = lwave;
  f32x16 Hn[2];
#pragma unroll
  for (int tt = 0; tt < 2; ++tt) {
    const int tq = tt * 32 + l31;
    Hn[tt] = zero16();
    if (c > 0) {
#pragma unroll
      for (int kk = 0; kk < 8; ++kk) Hn[tt] = MFMA(ldfrag(CT + (et * 32 + l31) * 128 + kk * 16 + 8 * hh), ldfrag(Qs + tq * 136 + kk * 16 + 8 * hh), Hn[tt]);
    }
    const float wi = wint[tq];
#pragma unroll
    for (int r = 0; r < 16; ++r) Hn[tt][r] *= wi;
#pragma unroll
    for (int ks = 0; ks < 4; ++ks) Hn[tt] = MFMA(ldfrag(VTs + (et * 32 + l31) * 72 + ks * 16 + 8 * hh), ldfrag(Ps + tq * 72 + ks * 16 + 8 * hh), Hn[tt]);
    const float qn = qnp[tq] + qnp[64 + tq] + qnp[128 + tq] + qnp[192 + tq];
    const float den = wi * qn + qks[tq] + qks[64 + tq];
    const float inv = __builtin_amdgcn_rcpf(fmaxf(fabsf(den), emt[tq]));
    float s1 = 0.f, s2 = 0.f;
#pragma unroll
    for (int r = 0; r < 16; ++r) { Hn[tt][r] *= inv; s1 += Hn[tt][r]; s2 += Hn[tt][r] * Hn[tt][r]; }
    s1 += __shfl_xor(s1, 32); s2 += __shfl_xor(s2, 32);
    if (hh == 0) { red[(et * 64 + tq) * 2] = s1; red[(et * 64 + tq) * 2 + 1] = s2; }
  }
  __syncthreads();
#pragma unroll
  for (int tt = 0; tt < 2; ++tt) {
    const int tq = tt * 32 + l31;
    float t1 = 0.f, t2 = 0.f;
    for (int e4 = 0; e4 < 4; ++e4) { t1 += red[(e4 * 64 + tq) * 2]; t2 += red[(e4 * 64 + tq) * 2 + 1]; }
    const float mu = t1 * (1.f / 128.f);
    const float var = fmaxf(t2 * (1.f / 128.f) - mu * mu, 0.f);
    const float rstd = rsqrtf(var + LN_EPS);
    const size_t row = (size_t)b * SEQ + c * 64 + tq;
#pragma unroll
    for (int g = 0; g < 4; ++g) {
      const int e0 = et * 32 + 8 * g + 4 * hh;
      const uint2 og = *(const uint2*)(PO + row * 512 + hd * 128 + e0);
      const float4 gg = *(const float4*)(ng + e0);
      const float o0 = __builtin_amdgcn_rcpf(1.f + __expf(-bflo(og.x))), o1 = __builtin_amdgcn_rcpf(1.f + __expf(-bfhi(og.x))), o2 = __builtin_amdgcn_rcpf(1.f + __expf(-bflo(og.y))), o3 = __builtin_amdgcn_rcpf(1.f + __expf(-bfhi(og.y)));
      uint2 o;
      o.x = pack2(o0 * (Hn[tt][4 * g] - mu) * rstd * gg.x, o1 * (Hn[tt][4 * g + 1] - mu) * rstd * gg.y);
      o.y = pack2(o2 * (Hn[tt][4 * g + 2] - mu) * rstd * gg.z, o3 * (Hn[tt][4 * g + 3] - mu) * rstd * gg.w);
      *(uint2*)(MIX + row * 1024 + 512 + hd * 128 + e0) = o;
    }
  }
  __syncthreads();
}

DI void phase_mixA(const Params& p, char* lds) {
  for (int it = blockIdx.x; it < 4096; it += gridDim.x) mlstmA_item(p, lds, it);
  for (int it = blockIdx.x; it < 2048; it += gridDim.x) attn_item(p, lds, it);
}
DI void phase_mixC(const Params& p, char* lds) {
  for (int it = blockIdx.x; it < 2048; it += gridDim.x) mlstmC_pair(p, lds, it);
}

DI void phase_xattn(const Params& p, char* lds) {
  char* ws = p.ws;
  const int tid = otid(), lane = tid & 63, wave = tid >> 6, l31 = lane & 31, hh = lane >> 5;
  const u16* XQ = (const u16*)(ws + OFF_XQ); const u16* KX = (const u16*)(ws + OFF_KX); const u16* VTX = (const u16*)(ws + OFF_VTX);
  u16* XO = (u16*)(ws + OFF_XO);
  u16* Kl = (u16*)lds; u16* Vl = Kl + 2 * 32 * 264;
  const int pi = perm23(l31);
  const int kr0 = tid >> 5, kc = (tid & 31) * 8, vr = tid >> 2, vc = (tid & 3) * 8;
  for (int item = blockIdx.x; item < 1024; item += gridDim.x) {
    const int b = item >> 7, h = (item >> 5) & 3, qblk = item & 31;
    const size_t q0 = (size_t)b * SEQ + qblk * 256 + wave * 32;
    bf16x8 Qf[16];
#pragma unroll
    for (int kk = 0; kk < 16; ++kk) Qf[kk] = ldfrag(XQ + (q0 + l31) * 1024 + h * 256 + kk * 16 + 8 * hh);
    const u16* kg = KX + ((size_t)b * 256) * 1024 + h * 256;
    const u16* vg = VTX + ((size_t)((b * 4 + h) * 256)) * 256;
    {
      const uint4 k0 = *(const uint4*)(kg + (size_t)kr0 * 1024 + kc), k1 = *(const uint4*)(kg + (size_t)(kr0 + 16) * 1024 + kc);
      const uint4 v0 = *(const uint4*)(vg + (size_t)vr * 256 + vc);
      *(uint4*)(Kl + kr0 * 264 + kc) = k0; *(uint4*)(Kl + (kr0 + 16) * 264 + kc) = k1; *(uint4*)(Vl + vr * 40 + vc) = v0;
    }
    __syncthreads();
    f32x16 O[4]; for (int i = 0; i < 4; ++i) O[i] = zero16();
    float mrun = -INFINITY, lrun = 0.f;
#pragma unroll 1
    for (int st = 0; st < 16; ++st) {
      const int dh = st >> 3, kt = st & 7, cur = st & 1;
      uint4 nk0, nk1, nv0;
      if (st < 15) {
        const int ndh = (st + 1) >> 3, nkt = (st + 1) & 7;
        nk0 = *(const uint4*)(kg + (size_t)(nkt * 32 + kr0) * 1024 + kc); nk1 = *(const uint4*)(kg + (size_t)(nkt * 32 + kr0 + 16) * 1024 + kc);
        nv0 = *(const uint4*)(vg + (size_t)(ndh * 128 + vr) * 256 + nkt * 32 + vc);
      }
      const u16* kl = Kl + cur * 32 * 264 + pi * 264 + 8 * hh;
      const u16* vl = Vl + cur * 128 * 40 + l31 * 40 + 8 * hh;
      f32x16 S = zero16();
#pragma unroll
      for (int kk = 0; kk < 16; ++kk) S = MFMA(ldfrag(kl + kk * 16), Qf[kk], S);
      float mx = -INFINITY;
#pragma unroll
      for (int r = 0; r < 16; ++r) { S[r] *= 0.09016844005556021f; mx = fmaxf(mx, S[r]); }
      mx = fmaxf(mx, __shfl_xor(mx, 32));
      const float mnew = fmaxf(mrun, mx), alpha = __builtin_amdgcn_exp2f(mrun - mnew);
      mrun = mnew;
      float ps = 0.f;
#pragma unroll
      for (int r = 0; r < 16; ++r) { const float e = __builtin_amdgcn_exp2f(S[r] - mnew); S[r] = e; ps += e; }
      lrun = lrun * alpha + ps;
      bf16x8 Pf[2];
#pragma unroll
      for (int ks = 0; ks < 2; ++ks) {
        union { bf16x8 v; unsigned u[4]; } cv;
        for (int j2 = 0; j2 < 4; ++j2) cv.u[j2] = pack2(S[8 * ks + 2 * j2], S[8 * ks + 2 * j2 + 1]);
        Pf[ks] = cv.v;
      }
#pragma unroll
      for (int dt = 0; dt < 4; ++dt) {
#pragma unroll
        for (int r = 0; r < 16; ++r) O[dt][r] *= alpha;
#pragma unroll
        for (int ks = 0; ks < 2; ++ks) O[dt] = MFMA(ldfrag(vl + dt * 32 * 40 + 16 * ks), Pf[ks], O[dt]);
      }
      if (kt == 7) {
        const float inv = __builtin_amdgcn_rcpf(lrun + __shfl_xor(lrun, 32));
#pragma unroll
        for (int dt = 0; dt < 4; ++dt) {
#pragma unroll
          for (int g = 0; g < 4; ++g) {
            uint2 o; o.x = pack2(O[dt][4 * g] * inv, O[dt][4 * g + 1] * inv); o.y = pack2(O[dt][4 * g + 2] * inv, O[dt][4 * g + 3] * inv);
            *(uint2*)(XO + (q0 + l31) * 1024 + h * 256 + dh * 128 + dt * 32 + 8 * g + 4 * hh) = o;
          }
          O[dt] = zero16();
        }
        mrun = -INFINITY; lrun = 0.f;
      }
      if (st < 15) {
        const int nx = cur ^ 1;
        *(uint4*)(Kl + nx * 32 * 264 + kr0 * 264 + kc) = nk0; *(uint4*)(Kl + nx * 32 * 264 + (kr0 + 16) * 264 + kc) = nk1; *(uint4*)(Vl + nx * 128 * 40 + vr * 40 + vc) = nv0;
      }
      __syncthreads();
    }
  }
}

DI void phase_peer_query(const Params& p, char* lds) {
  char* ws = p.ws;
  const int tid = otid(), lane = tid & 63, wave = tid >> 6, wm = wave >> 1, wn = wave & 1, l31 = lane & 31, hh = lane >> 5;
  const u16* SK = (const u16*)(ws + OFF_SK);
  float* TOPV = (float*)(ws + OFF_TOPV);
  u16* Ct = (u16*)lds;
  float* Sc = (float*)lds;
  float* Ll = (float*)lds;
  for (int it = 0;; ++it) {
    int mt, hq; if (!tile_of(it, 256, 8, mt, hq)) break;
    const int m0 = mt * 256, n0 = hq * 256;
    {
      f32x4 acc[2][2][4][2];
      const u16* Aq = (const u16*)(ws + OFF_H) + (size_t)m0 * 1024; const u16* Bq = (const u16*)(ws + OFF_WPQ) + (size_t)n0 * 1024;
      gemm8p<1>(Aq, Bq, acc, lds);
      stage8<1>(acc, Ct);
    }
    __syncthreads();
    f32x16 sacc[2][2][2];
#pragma unroll
    for (int pp = 0; pp < 2; ++pp) {
#pragma unroll
      for (int i = 0; i < 2; ++i) for (int j = 0; j < 2; ++j) sacc[pp][i][j] = zero16();
#pragma unroll
      for (int kk = 0; kk < 8; ++kk) {
        const bf16x8 a0 = ldfrag(Ct + (wm * 64 + l31) * CT_LD + pp * 128 + kk * 16 + 8 * hh), a1 = ldfrag(Ct + (wm * 64 + 32 + l31) * CT_LD + pp * 128 + kk * 16 + 8 * hh);
        const bf16x8 b0 = ldfrag(SK + (size_t)(pp * 128 + wn * 64 + l31) * 128 + kk * 16 + 8 * hh), b1 = ldfrag(SK + (size_t)(pp * 128 + wn * 64 + 32 + l31) * 128 + kk * 16 + 8 * hh);
        sacc[pp][0][0] = MFMA(a0, b0, sacc[pp][0][0]); sacc[pp][0][1] = MFMA(a0, b1, sacc[pp][0][1]);
        sacc[pp][1][0] = MFMA(a1, b0, sacc[pp][1][0]); sacc[pp][1][1] = MFMA(a1, b1, sacc[pp][1][1]);
      }
    }
    __syncthreads();
#pragma unroll
    for (int pp = 0; pp < 2; ++pp) {
      const int hp = hq * 2 + pp;
#pragma unroll
      for (int i = 0; i < 2; ++i)
#pragma unroll
        for (int j = 0; j < 2; ++j)
#pragma unroll
          for (int r = 0; r < 16; ++r)
            Sc[(wm * 64 + i * 32 + (r & 3) + 8 * (r >> 2) + 4 * hh) * 132 + wn * 64 + j * 32 + l31] = sacc[pp][i][j][r];
      __syncthreads();
      {
        const int row = tid >> 1, half = tid & 1;
        const float* srow = Sc + row * 132 + half * 64;
        float v[16];
#pragma unroll
        for (int i = 0; i < 16; ++i) v[i] = -INFINITY;
#pragma unroll 2
        for (int e4 = 0; e4 < 16; ++e4) {
          const float4 s4 = *(const float4*)(srow + 4 * e4);
          const float sv[4] = {s4.x, s4.y, s4.z, s4.w};
#pragma unroll
          for (int u = 0; u < 4; ++u) {
            float x = __uint_as_float((__float_as_uint(sv[u]) & 0xFFFFFF80u) | (unsigned)(127 - (half * 64 + 4 * e4 + u)));
#pragma unroll
            for (int i = 0; i < 16; ++i) { const float hi = fmaxf(x, v[i]); x = fminf(x, v[i]); v[i] = hi; }
          }
        }
        float c[16];
#pragma unroll
        for (int i = 0; i < 16; ++i) c[i] = __shfl_xor(v[15 - i], 1);
#pragma unroll
        for (int i = 0; i < 16; ++i) c[i] = fmaxf(c[i], v[i]);
#pragma unroll
        for (int d = 8; d >= 1; d >>= 1)
#pragma unroll
          for (int i = 0; i < 16; ++i)
            if ((i & d) == 0) { const float hi = fmaxf(c[i], c[i + d]), lo = fminf(c[i], c[i + d]); c[i] = hi; c[i + d] = lo; }
        if (half == 0) {
          float* tv = TOPV + (size_t)(m0 + row) * 256 + hp * 16;
#pragma unroll
          for (int i = 0; i < 4; ++i) *(float4*)(tv + 4 * i) = make_float4(c[4 * i], c[4 * i + 1], c[4 * i + 2], c[4 * i + 3]);
        }
      }
      __syncthreads();
    }
  }
}

template <int C> struct CandFlat { static constexpr int calc() { int i = 0, rem = C; while (rem >= 16 / (i + 1)) { rem -= 16 / (i + 1); ++i; } return i * 16 + rem; } static constexpr int value = calc(); };
template <int C> DI void rank_step(const float val, const int flat, int& rank) {
  const float o = __uint_as_float(__builtin_amdgcn_readlane(__float_as_uint(val), C));
  rank += (int)(o > val) | ((int)(o == val) & (int)(CandFlat<C>::value < flat));
}
template <int C0> DI void rank_steps10(const float val, const int flat, int& rank) {
  rank_step<C0>(val, flat, rank); rank_step<C0 + 1>(val, flat, rank); rank_step<C0 + 2>(val, flat, rank); rank_step<C0 + 3>(val, flat, rank); rank_step<C0 + 4>(val, flat, rank);
  rank_step<C0 + 5>(val, flat, rank); rank_step<C0 + 6>(val, flat, rank); rank_step<C0 + 7>(val, flat, rank); rank_step<C0 + 8>(val, flat, rank); rank_step<C0 + 9>(val, flat, rank);
}
DI float dot16q(const uint4& q, const f32x2* x) {
  f32x2 a = __builtin_amdgcn_cvt_pk_f32_fp8((int)q.x, false) * x[0];
  a = __builtin_amdgcn_cvt_pk_f32_fp8((int)q.x, true) * x[1] + a;
  a = __builtin_amdgcn_cvt_pk_f32_fp8((int)q.y, false) * x[2] + a;
  a = __builtin_amdgcn_cvt_pk_f32_fp8((int)q.y, true) * x[3] + a;
  a = __builtin_amdgcn_cvt_pk_f32_fp8((int)q.z, false) * x[4] + a;
  a = __builtin_amdgcn_cvt_pk_f32_fp8((int)q.z, true) * x[5] + a;
  a = __builtin_amdgcn_cvt_pk_f32_fp8((int)q.w, false) * x[6] + a;
  a = __builtin_amdgcn_cvt_pk_f32_fp8((int)q.w, true) * x[7] + a;
  return a.x + a.y;
}
DI void axpy16q(float c, const uint4& q, f32x2* o) {
  const f32x2 c2 = {c, c};
  o[0] = __builtin_amdgcn_cvt_pk_f32_fp8((int)q.x, false) * c2 + o[0];
  o[1] = __builtin_amdgcn_cvt_pk_f32_fp8((int)q.x, true) * c2 + o[1];
  o[2] = __builtin_amdgcn_cvt_pk_f32_fp8((int)q.y, false) * c2 + o[2];
  o[3] = __builtin_amdgcn_cvt_pk_f32_fp8((int)q.y, true) * c2 + o[3];
  o[4] = __builtin_amdgcn_cvt_pk_f32_fp8((int)q.z, false) * c2 + o[4];
  o[5] = __builtin_amdgcn_cvt_pk_f32_fp8((int)q.z, true) * c2 + o[5];
  o[6] = __builtin_amdgcn_cvt_pk_f32_fp8((int)q.w, false) * c2 + o[6];
  o[7] = __builtin_amdgcn_cvt_pk_f32_fp8((int)q.w, true) * c2 + o[7];
}
struct __attribute__((packed, aligned(8))) U4a8 { unsigned a, b, c, d; };
DI v6u load6(const unsigned char* p) { const U4a8 a = *(const U4a8*)p; const uint2 c = *(const uint2*)(p + 16); v6u q; q[0] = a.a; q[1] = a.b; q[2] = a.c; q[3] = a.d; q[4] = c.x; q[5] = c.y; return q; }
DI void phase_peer_out(const Params& p, char* lds) {
  char* ws = p.ws;
  const int tid = otid(), lane = tid & 63, wave = tid >> 6, hb = lane >> 5, l5 = lane & 31;
  int* sidx = (int*)lds + wave * 384; float* sw = (float*)(sidx + 128);
  const u16* H = (const u16*)(ws + OFF_H); const unsigned* TV = (const unsigned*)(ws + OFF_TOPV);
  const unsigned char* U6 = (const unsigned char*)(ws + OFF_U8) + 24 * l5; const unsigned char* V6 = (const unsigned char*)(ws + OFF_V8) + 24 * l5;
  const float* USC = (const float*)(ws + OFF_USC); const float* VSC = (const float*)(ws + OFF_VSC);
  const float* g3 = p.in[23]; const float* b3 = p.in[24];
  int ci = 0, cj = 0; const bool cval = lane < 50;
  if (cval) { int rem = lane, i = 0; while (true) { const int cnt = 16 / (i + 1); if (rem < cnt) break; rem -= cnt; ++i; } ci = i; cj = rem; }
  const int flat = ci * 16 + cj;
  for (int t = blockIdx.x * 8 + wave; t < T_TOK; t += gridDim.x * 8) {
    f32x2 x2[16];
#pragma unroll
    for (int i = 0; i < 4; ++i) {
      const uint4 hv = *(const uint4*)(H + (size_t)t * 1024 + 32 * l5 + 8 * i);
      x2[4 * i] = f32x2{bflo(hv.x), bfhi(hv.x)}; x2[4 * i + 1] = f32x2{bflo(hv.y), bfhi(hv.y)}; x2[4 * i + 2] = f32x2{bflo(hv.z), bfhi(hv.z)}; x2[4 * i + 3] = f32x2{bflo(hv.w), bfhi(hv.w)};
    }
    float hval[8]; int hidx[8];
#pragma unroll
    for (int hq = 0; hq < 8; ++hq) {
      const unsigned ka = TV[(size_t)t * 256 + (2 * hq) * 16 + ci], kb = TV[(size_t)t * 256 + (2 * hq + 1) * 16 + cj];
      const float va = __uint_as_float(ka & 0xFFFFFF80u), vb = __uint_as_float(kb & 0xFFFFFF80u);
      const int ia = 127 - (int)(ka & 127u), ib = 127 - (int)(kb & 127u);
      hval[hq] = cval ? va + vb : -INFINITY; hidx[hq] = ia * 128 + ib;
    }
#pragma unroll
    for (int hq = 0; hq < 8; ++hq) {
      const float val = hval[hq];
      int rank = 0;
      rank_steps10<0>(val, flat, rank); rank_steps10<10>(val, flat, rank); rank_steps10<20>(val, flat, rank); rank_steps10<30>(val, flat, rank); rank_steps10<40>(val, flat, rank);
      if (cval && rank < 16) { sidx[hq * 16 + rank] = hidx[hq]; sw[hq * 16 + rank] = val; }
    }
    int el[2]; float gl[2];
#pragma unroll
    for (int grp = 0; grp < 2; ++grp) {
      el[grp] = sidx[grp * 64 + lane];
      const float sc = sw[grp * 64 + lane];
      float mx = sc; for (int o = 8; o; o >>= 1) mx = fmaxf(mx, __shfl_xor(mx, o));
      const float e = __expf(sc - mx);
      float sm = e; for (int o = 8; o; o >>= 1) sm += __shfl_xor(sm, o);
      gl[grp] = e * __builtin_amdgcn_rcpf(sm);
    }
#pragma unroll
    for (int hf = 0; hf < 2; ++hf) {
      float pd[32];
#pragma unroll
      for (int kb = 0; kb < 4; ++kb) {
        v6u qb[8];
#pragma unroll
        for (int k = 0; k < 8; ++k) {
          const int e0 = __builtin_amdgcn_readlane(el[0], hf * 32 + kb * 8 + k), e1 = __builtin_amdgcn_readlane(el[1], hf * 32 + kb * 8 + k);
          qb[k] = load6(U6 + (size_t)(hb ? e1 : e0) * 768);
        }
#pragma unroll
        for (int k = 0; k < 8; ++k) {
          const v32f f = __builtin_amdgcn_cvt_scalef32_pk32_f32_fp6(qb[k], 1.0f);
          f32x2 a = f32x2{f[0], f[1]} * x2[0];
#pragma unroll
          for (int i = 1; i < 16; ++i) a = f32x2{f[2 * i], f[2 * i + 1]} * x2[i] + a;
          pd[kb * 8 + k] = a.x + a.y;
        }
      }
#pragma unroll
      for (int off = 16; off >= 1; off >>= 1) {
        const bool up = (lane & off) != 0;
#pragma unroll
        for (int i = 0; i < off; ++i) {
          const float send = up ? pd[i] : pd[i + off];
          const float keep = up ? pd[i + off] : pd[i];
          pd[i] = keep + __shfl_xor(send, off);
        }
      }
      sw[hb * 64 + hf * 32 + l5] = pd[0];
    }
    float coefv[2];
#pragma unroll
    for (int grp = 0; grp < 2; ++grp) {
      const float dt = sw[grp * 64 + lane] * USC[el[grp]];
      const float ge = 0.5f * dt * (1.f + erff(dt * 0.7071067811865476f));
      coefv[grp] = gl[grp] * ge * VSC[el[grp]];
    }
    f32x2 o2[16];
#pragma unroll
    for (int i = 0; i < 16; ++i) o2[i] = f32x2{0.f, 0.f};
#pragma unroll
    for (int kb = 0; kb < 8; ++kb) {
      v6u qb[8];
#pragma unroll
      for (int k = 0; k < 8; ++k) {
        const int e0 = __builtin_amdgcn_readlane(el[0], kb * 8 + k), e1 = __builtin_amdgcn_readlane(el[1], kb * 8 + k);
        qb[k] = load6(V6 + (size_t)(hb ? e1 : e0) * 768);
      }
#pragma unroll
      for (int k = 0; k < 8; ++k) {
        const float c0 = __uint_as_float(__builtin_amdgcn_readlane(__float_as_uint(coefv[0]), kb * 8 + k)), c1 = __uint_as_float(__builtin_amdgcn_readlane(__float_as_uint(coefv[1]), kb * 8 + k));
        const float cf = hb ? c1 : c0;
        const f32x2 c2 = {cf, cf};
        const v32f f = __builtin_amdgcn_cvt_scalef32_pk32_f32_fp6(qb[k], 1.0f);
#pragma unroll
        for (int i = 0; i < 16; ++i) o2[i] = f32x2{f[2 * i], f[2 * i + 1]} * c2 + o2[i];
      }
    }
    float s = 0.f;
#pragma unroll
    for (int i = 0; i < 16; ++i) {
      o2[i].x += __shfl_xor(o2[i].x, 32); o2[i].y += __shfl_xor(o2[i].y, 32);
      o2[i] = x2[i] * f32x2{ALPHA, ALPHA} + o2[i]; s += o2[i].x + o2[i].y;
    }
    for (int o = 16; o; o >>= 1) s += __shfl_xor(s, o);
    const float mu = s * (1.f / 1024.f);
    float q = 0.f;
#pragma unroll
    for (int i = 0; i < 16; ++i) { const float a = o2[i].x - mu, bq = o2[i].y - mu; q += a * a + bq * bq; }
    for (int o = 16; o; o >>= 1) q += __shfl_xor(q, o);
    const float rstd = rsqrtf(q * (1.f / 1024.f) + LN_EPS);
    float* orow = p.out + (size_t)t * 1024 + 32 * l5 + 16 * hb;
#pragma unroll
    for (int q4 = 0; q4 < 4; ++q4) {
      const float4 gg = *(const float4*)(g3 + 32 * l5 + 16 * hb + 4 * q4), bb = *(const float4*)(b3 + 32 * l5 + 16 * hb + 4 * q4);
      const f32x2 a0 = hb ? o2[8 + 2 * q4] : o2[2 * q4], a1 = hb ? o2[8 + 2 * q4 + 1] : o2[2 * q4 + 1];
      float4 o;
      o.x = (a0.x - mu) * rstd * gg.x + bb.x; o.y = (a0.y - mu) * rstd * gg.y + bb.y;
      o.z = (a1.x - mu) * rstd * gg.z + bb.z; o.w = (a1.y - mu) * rstd * gg.w + bb.w;
      *(float4*)(orow + 4 * q4) = o;
    }
  }
}

#define XB_TMO      128
#define XB_XCNT(j)  (256  + 64 * (j))
#define XB_XSUB(j)  (1280 + 64 * (j))
#define XB_XGEN(j)  (2304 + 64 * (j))
#define XB_TOP      3328
#define XB_TOPGEN   3392
#define XCD_BAR_WORDS 3456
#define XB_SPIN_CAP (1u << 18)
#define LAS __attribute__((address_space(3)))
DI unsigned xb_ld(unsigned* p)              { return __hip_atomic_load(p, __ATOMIC_RELAXED, __HIP_MEMORY_SCOPE_AGENT); }
DI unsigned xb_add(unsigned* p, unsigned v) { return __hip_atomic_fetch_add(p, v, __ATOMIC_RELAXED, __HIP_MEMORY_SCOPE_AGENT); }
DI unsigned xb_xcc_id() { return (unsigned)__builtin_amdgcn_s_getreg((3 << 11) | 20) & 0xFu; }
#define XB_SPIN(cond, bar) do { unsigned _sp = 0; while (cond) { __builtin_amdgcn_s_sleep(1); \
    if ((++_sp & 255u) == 0u) { if (xb_ld(&(bar)[XB_TMO])) break; if (_sp > XB_SPIN_CAP) { atomicAdd(&(bar)[XB_TMO], 1u); break; } } } } while (0)
struct XcdBarrier { unsigned* bar; unsigned x; volatile LAS unsigned* st; };
DI XcdBarrier xcd_barrier_post(unsigned* bar, volatile LAS unsigned* st) {
  XcdBarrier b; b.bar = bar; b.x = xb_xcc_id(); b.st = st;
  if (threadIdx.x == 0) (void)xb_add(&bar[XB_XCNT(b.x)], 1u);
  return b;
}
DI void xcd_barrier_complete(unsigned* bar, unsigned x, unsigned& nloc, unsigned& nx) {
  const unsigned G = gridDim.x * gridDim.y * gridDim.z;
  unsigned sum, cnt, mine, sp = 0u;
  for (;;) {
    sum = 0u; cnt = 0u; mine = 0u;
#pragma unroll
    for (unsigned j = 0; j < 16; ++j) { const unsigned c = xb_ld(&bar[XB_XCNT(j)]); sum += c; cnt += (c > 0u) ? 1u : 0u; mine = (j == x) ? c : mine; }
    if (sum == G) break;
    __builtin_amdgcn_s_sleep(1);
    if ((++sp & 255u) == 0u) { if (xb_ld(&bar[XB_TMO])) break; if (sp > XB_SPIN_CAP) { atomicAdd(&bar[XB_TMO], 1u); break; } }
  }
  nloc = mine > 0u ? mine : 1u; nx = cnt > 0u ? cnt : 1u;
}
DI void xcd_barrier(const XcdBarrier& b) {
  asm volatile("s_waitcnt vmcnt(0)" ::: "memory");
  __syncthreads();
  if (threadIdx.x == 0) {
    unsigned* bar = b.bar;
    __builtin_amdgcn_s_waitcnt(0);
    unsigned nloc = b.st[0], nx = b.st[1];
    if (nloc == 0u) { xcd_barrier_complete(bar, b.x, nloc, nx); b.st[0] = nloc; b.st[1] = nx; }
    const unsigned old = xb_add(&bar[XB_XSUB(b.x)], 1u);
    const unsigned gen = old / nloc;
    if (old + 1u == (gen + 1u) * nloc) {
      __builtin_amdgcn_fence(__ATOMIC_RELEASE, "agent");
      asm volatile("s_waitcnt vmcnt(0)" ::: "memory");
      const unsigned og = xb_add(&bar[XB_TOP], 1u);
      const unsigned tg = og / nx;
      if (og + 1u == (tg + 1u) * nx) xb_add(&bar[XB_TOPGEN], 1u);
      else XB_SPIN(xb_ld(&bar[XB_TOPGEN]) == tg, bar);
      __builtin_amdgcn_fence(__ATOMIC_ACQUIRE, "agent");
      xb_add(&bar[XB_XGEN(b.x)], 1u);
      asm volatile("s_waitcnt vmcnt(0)" ::: "memory");
    } else {
      XB_SPIN(xb_ld(&bar[XB_XGEN(b.x)]) == gen, bar);
      __builtin_amdgcn_fence(__ATOMIC_ACQUIRE, "agent");
      asm volatile("s_waitcnt vmcnt(0)" ::: "memory");
    }
  }
  __syncthreads();
}

__global__ void __launch_bounds__(512) mega(Params p) {
  extern __shared__ __attribute__((aligned(16))) char lds[];
  cg::grid_group grid = cg::this_grid();
  char* ws = p.ws;
  u16* H = (u16*)(ws + OFF_H);
  u16* Zb = (u16*)(ws + OFF_Z);
  unsigned* barw = (unsigned*)(ws + OFF_BAR);
  volatile LAS unsigned* xst = (volatile LAS unsigned*)(LAS unsigned*)(lds + LDS_BYTES - 16);
  if (blockIdx.x == 0) for (int i = threadIdx.x; i < XCD_BAR_WORDS; i += 512) barw[i] = 0u;
  if (threadIdx.x == 0) { xst[0] = 0u; xst[1] = 0u; }
  for (int rep = 0; rep < 1 + ((PROBE_MASK >> 0) & 1); ++rep) {
    transpose_w(p.in[4], (u16*)(ws + OFF_WIN), 3592, 3584, (float*)lds);
    transpose_w(p.in[11], (u16*)(ws + OFF_WOUT), 1024, 1024, (float*)lds);
    transpose_w(p.in[14], (u16*)(ws + OFF_WQ), 1024, 1024, (float*)lds);
    transpose_w(p.in[15], (u16*)(ws + OFF_WKV), 2048, 2048, (float*)lds);
    transpose_w(p.in[16], (u16*)(ws + OFF_WO), 1024, 1024, (float*)lds);
    transpose_w(p.in[19], (u16*)(ws + OFF_WPQ), 2048, 2048, (float*)lds);
    convert_fp6_rows(p.in[21], (unsigned char*)(ws + OFF_U8), (float*)(ws + OFF_USC));
    convert_fp6_rows(p.in[22], (unsigned char*)(ws + OFF_V8), (float*)(ws + OFF_VSC));
    convert_bf16(p.in[20], (u16*)(ws + OFF_SK), (size_t)2 * 128 * 128 / 4);
    convert_bf16(p.in[1], (u16*)(ws + OFF_MEMB), (size_t)2048 * 1024 / 4);
    ln_in_rows(p.in[0], p.in[2], p.in[3], p.in[4], H, (float*)(ws + OFF_G), (float*)lds);
  }
  grid.sync();
  const XcdBarrier xb = xcd_barrier_post(barw, xst);
  if (PROBE_MASK & 0x10000) { for (int i = 0; i < 16; ++i) xcd_barrier(xb); }
  if ((PHASE_EN >> 1) & 1)
    { phase_inproj(p, lds); xcd_barrier(xb); }
  if ((PROBE_MASK >> 1) & 1) { phase_inproj(p, lds); xcd_barrier(xb); }
  if ((PHASE_EN >> 2) & 1)
    { phase_mixA(p, lds); xcd_barrier(xb); }
  if ((PROBE_MASK >> 2) & 1) { phase_mixA(p, lds); xcd_barrier(xb); }
  if ((PROBE_MASK >> 13) & 1) { for (int it = blockIdx.x; it < 4096; it += gridDim.x) mlstmA_item(p, lds, it); xcd_barrier(xb); }
  if ((PROBE_MASK >> 14) & 1) { for (int it = blockIdx.x; it < 2048; it += gridDim.x) attn_item(p, lds, it); xcd_barrier(xb); }
  if ((PHASE_EN >> 11) & 1)
    { phase_mlstm_scan(p); xcd_barrier(xb); }
  if ((PHASE_EN >> 12) & 1)
    { phase_mixC(p, lds); xcd_barrier(xb); }
  if ((PROBE_MASK >> 12) & 1) { phase_mixC(p, lds); xcd_barrier(xb); }
  if ((PHASE_EN >> 3) & 1)
    { phase_gemm1024<1>((const u16*)(ws + OFF_MIX), (const u16*)(ws + OFF_WOUT), Zb, H, lds); xcd_barrier(xb); }
  if ((PROBE_MASK >> 3) & 1) { phase_gemm1024<1>((const u16*)(ws + OFF_MIX), (const u16*)(ws + OFF_WOUT), Zb, H, lds); xcd_barrier(xb); }
  { ln_rows_b(Zb, p.in[12], p.in[13], H); xcd_barrier(xb); }
  if ((PROBE_MASK >> 4) & 1) { ln_rows_b(Zb, p.in[12], p.in[13], H); xcd_barrier(xb); }
  if ((PHASE_EN >> 5) & 1)
    { phase_gemm1024<0>(H, (const u16*)(ws + OFF_WQ), (u16*)(ws + OFF_XQ), nullptr, lds); xcd_barrier(xb); }
  if ((PROBE_MASK >> 5) & 1) { phase_gemm1024<0>(H, (const u16*)(ws + OFF_WQ), (u16*)(ws + OFF_XQ), nullptr, lds); xcd_barrier(xb); }
  if ((PHASE_EN >> 6) & 1)
    { phase_xattn(p, lds); xcd_barrier(xb); }
  if ((PROBE_MASK >> 6) & 1) { phase_xattn(p, lds); xcd_barrier(xb); }
  if ((PHASE_EN >> 7) & 1)
    { phase_gemm1024<1>((const u16*)(ws + OFF_XO), (const u16*)(ws + OFF_WO), Zb, H, lds); xcd_barrier(xb); }
  if ((PROBE_MASK >> 7) & 1) { phase_gemm1024<1>((const u16*)(ws + OFF_XO), (const u16*)(ws + OFF_WO), Zb, H, lds); xcd_barrier(xb); }
  { ln_rows_b(Zb, p.in[17], p.in[18], H); xcd_barrier(xb); }
  if ((PROBE_MASK >> 8) & 1) { ln_rows_b(Zb, p.in[17], p.in[18], H); xcd_barrier(xb); }
  if ((PHASE_EN >> 9) & 1)
    { phase_peer_query(p, lds); xcd_barrier(xb); }
  if ((PROBE_MASK >> 9) & 1) { phase_peer_query(p, lds); xcd_barrier(xb); }
  if ((PHASE_EN >> 10) & 1)
    { phase_peer_out(p, lds); }
  if ((PROBE_MASK >> 10) & 1) { phase_peer_out(p, lds); }
}

extern "C" void kernel_launch(void* const* d_in, const int* in_sizes, int n_in, void* d_out, int out_size, void* d_ws, size_t ws_size, hipStream_t stream) {
  static int grid_blocks = 0;
  if (grid_blocks == 0) {
    if (n_in != 25 || out_size != T_TOK * 1024 || ws_size < WS_NEED) { fprintf(stderr, "kernel_launch: unexpected shapes (n_in %d out %d ws %zu)\n", n_in, out_size, ws_size); grid_blocks = -1; return; }
    int dev = 0, cus = 0, per_cu = 0;
    hipGetDevice(&dev);
    hipDeviceGetAttribute(&cus, hipDeviceAttributeMultiprocessorCount, dev);
    if (hipFuncSetAttribute((const void*)mega, hipFuncAttributeMaxDynamicSharedMemorySize, LDS_BYTES) != hipSuccess) { fprintf(stderr, "hipFuncSetAttribute failed\n"); grid_blocks = -1; return; }
    hipOccupancyMaxActiveBlocksPerMultiprocessor(&per_cu, (const void*)mega, 512, LDS_BYTES);
    if (per_cu < 1) { fprintf(stderr, "occupancy query returned %d\n", per_cu); per_cu = 1; }
    grid_blocks = cus * per_cu;
  }
  if (grid_blocks < 0) return;
  Params p{};
  for (int i = 0; i < 25; ++i) p.in[i] = (const float*)d_in[i];
  p.out = (float*)d_out; p.ws = (char*)d_ws;
  void* args[] = {&p};
  hipError_t e = hipLaunchCooperativeKernel((const void*)mega, dim3(grid_blocks), dim3(512), args, LDS_BYTES, stream);
  if (e != hipSuccess) fprintf(stderr, "cooperative launch failed: %s (grid %d)\n", hipGetErrorString(e), grid_blocks);
}
```

```cpp
#include <hip/hip_runtime.h>
#include <hip/hip_cooperative_groups.h>
#include <cstdio>
namespace cg = cooperative_groups;

#ifndef PHASE_EN
#define PHASE_EN 0xFFFF
#endif
#ifndef PROBE_MASK
#define PROBE_MASK 0
#endif
#ifndef STAGE_MASK
#define STAGE_MASK 7
#endif

#define DI __device__ __forceinline__
typedef unsigned short u16;
typedef __attribute__((ext_vector_type(8))) short bf16x8;
typedef __attribute__((ext_vector_type(16))) float f32x16;
typedef __attribute__((ext_vector_type(2))) float f32x2;
#define MFMA(a, b, c) __builtin_amdgcn_mfma_f32_32x32x16_bf16((a), (b), (c), 0, 0, 0)

constexpr int T_TOK = 65536;
constexpr int SEQ = 8192;
constexpr float ALPHA = 1.189207115002721f;
constexpr float LN_EPS = 1e-5f;
constexpr int LDS_BYTES = 143360;
constexpr size_t MB = 1u << 20;
constexpr size_t OFF_WIN = 0, OFF_WOUT = 8 * MB, OFF_WQ = 10 * MB, OFF_WO = 12 * MB, OFF_WKV = 14 * MB, OFF_WPQ = 18 * MB,
                 OFF_SK = 22 * MB, OFF_MEMB = 23 * MB, OFF_KX = 27 * MB, OFF_VTX = 31 * MB, OFF_U8 = 35 * MB, OFF_V8 = 51 * MB, OFF_USC = 67 * MB, OFF_VSC = 68 * MB,
                 OFF_G = 99 * MB, OFF_H = 104 * MB, OFF_PA = 232 * MB, OFF_PM = 360 * MB, OFF_Z = 232 * MB, OFF_VTA = 488 * MB,
                 OFF_VTM = 552 * MB, OFF_XQ = 488 * MB, OFF_PO = 616 * MB, OFF_MIX = 680 * MB, OFF_XO = 680 * MB,
                 OFF_TOPV = 808 * MB, OFF_TOPI = 872 * MB, OFF_KVS = 808 * MB, OFF_KSUM = 936 * MB, OFF_CSC = 938 * MB, OFF_BAR = 939 * MB, WS_NEED = 940 * MB;

struct Params {
  const float* in[25];
  float* out;
  char* ws;
};

DI int otid() { int t = __builtin_amdgcn_workitem_id_x(); asm volatile("" : "+v"(t)); return t; }
typedef __bf16 bf16v2 __attribute__((ext_vector_type(2)));
DI unsigned pack2(float a, float b) { const f32x2 v = {a, b}; return __builtin_bit_cast(unsigned, __builtin_convertvector(v, bf16v2)); }
DI u16 f2bf(float x) { return (u16)(pack2(x, 0.f) & 0xffffu); }
DI float bf2f(u16 h) { return __uint_as_float(((unsigned)h) << 16); }
DI float bflo(unsigned w) { return __uint_as_float(w << 16); }
DI float bfhi(unsigned w) { return __uint_as_float(w & 0xffff0000u); }
DI float wsum(float v) { for (int o = 32; o; o >>= 1) v += __shfl_xor(v, o); return v; }
DI float wmax(float v) { for (int o = 32; o; o >>= 1) v = fmaxf(v, __shfl_xor(v, o)); return v; }
DI int perm23(int i) { return (i & 0x13) | (((i >> 3) & 1) << 2) | (((i >> 2) & 1) << 3); }
DI f32x16 zero16() { f32x16 z; for (int i = 0; i < 16; ++i) z[i] = 0.f; return z; }
DI bf16x8 ldfrag(const u16* p) { return *(const bf16x8*)p; }
DI void unpack8(const uint4& r, float* o) {
  o[0] = bflo(r.x); o[1] = bfhi(r.x); o[2] = bflo(r.y); o[3] = bfhi(r.y); o[4] = bflo(r.z); o[5] = bfhi(r.z); o[6] = bflo(r.w); o[7] = bfhi(r.w);
}

DI void transpose_w(const float* __restrict__ src, u16* __restrict__ dst, int N, int Npad, float* tl) {
  const int ntn = Npad >> 6, ntiles = 16 * ntn;
  for (int t = blockIdx.x; t < ntiles; t += gridDim.x) {
    const int kt = t / ntn, nt = t - kt * ntn, k0 = kt * 64, n0 = nt * 64;
    for (int e = otid(); e < 4096; e += 512) { int r = e >> 6, c = e & 63, n = n0 + c; tl[r * 65 + c] = (n < N) ? src[(size_t)(k0 + r) * N + n] : 0.f; }
    __syncthreads();
    for (int e = otid(); e < 4096; e += 512) { int r = e >> 6, c = e & 63; dst[(size_t)(n0 + r) * 1024 + k0 + c] = f2bf(tl[c * 65 + r]); }
    __syncthreads();
  }
}
DI void convert_bf16(const float* __restrict__ src, u16* __restrict__ dst, size_t n4) {
  const size_t stride = (size_t)gridDim.x * 512;
  for (size_t i = (size_t)blockIdx.x * 512 + otid(); i < n4; i += stride) {
    float4 v = ((const float4*)src)[i];
    uint2 o; o.x = pack2(v.x, v.y); o.y = pack2(v.z, v.w);
    ((uint2*)dst)[i] = o;
  }
}

DI void convert_fp8_rows(const float* __restrict__ src, unsigned char* __restrict__ dst, float* __restrict__ invscale) {
  const int lane = otid() & 63, wave = otid() >> 6;
  for (int row = blockIdx.x * 8 + wave; row < 16384; row += gridDim.x * 8) {
    const float* r = src + (size_t)row * 1024 + 16 * lane;
    float4 v[4];
    float am = 0.f;
    for (int i = 0; i < 4; ++i) { v[i] = *(const float4*)(r + 4 * i); am = fmaxf(am, fmaxf(fmaxf(fabsf(v[i].x), fabsf(v[i].y)), fmaxf(fabsf(v[i].z), fabsf(v[i].w)))); }
    am = wmax(am);
    const float sc = am > 0.f ? 256.f / am : 1.f;
    uint4 o; unsigned w[4];
    for (int i = 0; i < 4; ++i) { int t = 0; t = __builtin_amdgcn_cvt_pk_fp8_f32(v[i].x * sc, v[i].y * sc, t, false); t = __builtin_amdgcn_cvt_pk_fp8_f32(v[i].z * sc, v[i].w * sc, t, true); w[i] = (unsigned)t; }
    o.x = w[0]; o.y = w[1]; o.z = w[2]; o.w = w[3];
    *(uint4*)(dst + (size_t)row * 1024 + 16 * lane) = o;
    if (lane == 0) invscale[row] = am > 0.f ? am * (1.f / 256.f) : 1.f;
  }
}
typedef __attribute__((ext_vector_type(6))) unsigned v6u;
typedef __attribute__((ext_vector_type(16))) float v16f;
typedef __attribute__((ext_vector_type(32))) float v32f;
DI void convert_fp6_rows(const float* __restrict__ src, unsigned char* __restrict__ dst, float* __restrict__ invscale) {
  const int lane = otid() & 63, wave = otid() >> 6, hb = lane >> 5, l5 = lane & 31;
  for (int row = (blockIdx.x * 8 + wave) * 2 + hb; row < 16384; row += gridDim.x * 16) {
    const float* r = src + (size_t)row * 1024 + 32 * l5;
    v16f x, y;
    float am = 0.f;
#pragma unroll
    for (int i = 0; i < 4; ++i) {
      const float4 a = *(const float4*)(r + 4 * i), b = *(const float4*)(r + 16 + 4 * i);
      x[2 * i] = a.x; y[2 * i] = a.y; x[2 * i + 1] = a.z; y[2 * i + 1] = a.w; x[8 + 2 * i] = b.x; y[8 + 2 * i] = b.y; x[8 + 2 * i + 1] = b.z; y[8 + 2 * i + 1] = b.w;
      am = fmaxf(am, fmaxf(fmaxf(fabsf(a.x), fabsf(a.y)), fmaxf(fabsf(a.z), fabsf(a.w))));
      am = fmaxf(am, fmaxf(fmaxf(fabsf(b.x), fabsf(b.y)), fmaxf(fabsf(b.z), fabsf(b.w))));
    }
    for (int o = 16; o; o >>= 1) am = fmaxf(am, __shfl_xor(am, o));
    const float sc = am > 0.f ? 7.0f / am : 1.f;
#pragma unroll
    for (int i = 0; i < 16; ++i) { x[i] *= sc; y[i] *= sc; }
    const v6u q = __builtin_amdgcn_cvt_scalef32_2xpk16_fp6_f32(x, y, 1.0f);
    unsigned* d = (unsigned*)(dst + (size_t)row * 768 + 24 * l5);
    *(uint2*)d = make_uint2(q[0], q[1]); *(uint2*)(d + 2) = make_uint2(q[2], q[3]); *(uint2*)(d + 4) = make_uint2(q[4], q[5]);
    if (l5 == 0) invscale[row] = am > 0.f ? am * (1.f / 7.0f) : 1.f;
  }
}

DI void ln_rows(const float* __restrict__ src, const float* __restrict__ g, const float* __restrict__ bta, u16* __restrict__ dst) {
  const int lane = otid() & 63, wave = otid() >> 6;
  for (int row = blockIdx.x * 8 + wave; row < T_TOK; row += gridDim.x * 8) {
    float4 v[4];
    float s = 0.f;
    for (int i = 0; i < 4; ++i) { v[i] = *(const float4*)(src + (size_t)row * 1024 + i * 256 + lane * 4); s += v[i].x + v[i].y + v[i].z + v[i].w; }
    const float mu = wsum(s) * (1.f / 1024.f);
    float q = 0.f;
    for (int i = 0; i < 4; ++i) { float a = v[i].x - mu, b = v[i].y - mu, c = v[i].z - mu, d = v[i].w - mu; q += a * a + b * b + c * c + d * d; }
    const float rstd = rsqrtf(wsum(q) * (1.f / 1024.f) + LN_EPS);
    for (int i = 0; i < 4; ++i) {
      const int c0 = i * 256 + lane * 4;
      float4 gg = *(const float4*)(g + c0), bb = *(const float4*)(bta + c0);
      uint2 o;
      o.x = pack2((v[i].x - mu) * rstd * gg.x + bb.x, (v[i].y - mu) * rstd * gg.y + bb.y);
      o.y = pack2((v[i].z - mu) * rstd * gg.z + bb.z, (v[i].w - mu) * rstd * gg.w + bb.w);
      *(uint2*)(dst + (size_t)row * 1024 + c0) = o;
    }
  }
}
DI void ln_rows_b(const u16* __restrict__ Zb, const float* __restrict__ g, const float* __restrict__ bta, u16* __restrict__ H) {
  const int lane = otid() & 63, wave = otid() >> 6;
  float gg[16], bb[16];
  for (int i = 0; i < 4; ++i) {
    const float4 g4 = *(const float4*)(g + lane * 16 + 4 * i), b4 = *(const float4*)(bta + lane * 16 + 4 * i);
    gg[4*i] = g4.x; gg[4*i+1] = g4.y; gg[4*i+2] = g4.z; gg[4*i+3] = g4.w; bb[4*i] = b4.x; bb[4*i+1] = b4.y; bb[4*i+2] = b4.z; bb[4*i+3] = b4.w;
  }
  const int stride = gridDim.x * 8;
  for (int row0 = blockIdx.x * 8 + wave; row0 < T_TOK; row0 += stride * 4) {
    uint4 r[4][2];
#pragma unroll
    for (int j = 0; j < 4; ++j) {
      const int row = row0 + j * stride;
      if (row < T_TOK) { r[j][0] = *(const uint4*)(Zb + (size_t)row * 1024 + lane * 16); r[j][1] = *(const uint4*)(Zb + (size_t)row * 1024 + lane * 16 + 8); }
    }
#pragma unroll
    for (int j = 0; j < 4; ++j) {
      const int row = row0 + j * stride;
      if (row < T_TOK) {
        float v[16];
        unpack8(r[j][0], v); unpack8(r[j][1], v + 8);
        float s = 0.f;
#pragma unroll
        for (int i = 0; i < 16; ++i) s += v[i];
        const float mu = wsum(s) * (1.f / 1024.f);
        float q = 0.f;
#pragma unroll
        for (int i = 0; i < 16; ++i) { float a = v[i] - mu; q += a * a; }
        const float rstd = rsqrtf(wsum(q) * (1.f / 1024.f) + LN_EPS);
        uint4 o0, o1;
        o0.x = pack2((v[0] - mu) * rstd * gg[0] + bb[0], (v[1] - mu) * rstd * gg[1] + bb[1]); o0.y = pack2((v[2] - mu) * rstd * gg[2] + bb[2], (v[3] - mu) * rstd * gg[3] + bb[3]);
        o0.z = pack2((v[4] - mu) * rstd * gg[4] + bb[4], (v[5] - mu) * rstd * gg[5] + bb[5]); o0.w = pack2((v[6] - mu) * rstd * gg[6] + bb[6], (v[7] - mu) * rstd * gg[7] + bb[7]);
        o1.x = pack2((v[8] - mu) * rstd * gg[8] + bb[8], (v[9] - mu) * rstd * gg[9] + bb[9]); o1.y = pack2((v[10] - mu) * rstd * gg[10] + bb[10], (v[11] - mu) * rstd * gg[11] + bb[11]);
        o1.z = pack2((v[12] - mu) * rstd * gg[12] + bb[12], (v[13] - mu) * rstd * gg[13] + bb[13]); o1.w = pack2((v[14] - mu) * rstd * gg[14] + bb[14], (v[15] - mu) * rstd * gg[15] + bb[15]);
        *(uint4*)(H + (size_t)row * 1024 + lane * 16) = o0;
        *(uint4*)(H + (size_t)row * 1024 + lane * 16 + 8) = o1;
      }
    }
  }
}
DI void ln_in_rows(const float* __restrict__ src, const float* __restrict__ g, const float* __restrict__ bta, const float* __restrict__ w_in, u16* __restrict__ dst, float* __restrict__ G, float* Wg) {
  const int lane = otid() & 63, wave = otid() >> 6;
  for (int e = otid(); e < 8192; e += 512) Wg[e] = w_in[(size_t)(e >> 3) * 3592 + 3584 + (e & 7)];
  __syncthreads();
  float4 nv[4];
  { const int row = blockIdx.x * 8 + wave; for (int i = 0; i < 4; ++i) nv[i] = *(const float4*)(src + (size_t)row * 1024 + i * 256 + lane * 4); }
  for (int row = blockIdx.x * 8 + wave; row < T_TOK; row += gridDim.x * 8) {
    float4 v[4];
    float s = 0.f;
    for (int i = 0; i < 4; ++i) { v[i] = nv[i]; s += v[i].x + v[i].y + v[i].z + v[i].w; }
    { const int nrow = row + gridDim.x * 8; if (nrow < T_TOK) for (int i = 0; i < 4; ++i) nv[i] = *(const float4*)(src + (size_t)nrow * 1024 + i * 256 + lane * 4); }
    const float mu = wsum(s) * (1.f / 1024.f);
    float q = 0.f;
    for (int i = 0; i < 4; ++i) { float a = v[i].x - mu, b = v[i].y - mu, c = v[i].z - mu, d = v[i].w - mu; q += a * a + b * b + c * c + d * d; }
    const float rstd = rsqrtf(wsum(q) * (1.f / 1024.f) + LN_EPS);
    float pg[8];
#pragma unroll
    for (int j = 0; j < 8; ++j) pg[j] = 0.f;
#pragma unroll
    for (int i = 0; i < 4; ++i) {
      const int c0 = i * 256 + lane * 4;
      float4 gg = *(const float4*)(g + c0), bb = *(const float4*)(bta + c0);
      float y[4];
      y[0] = (v[i].x - mu) * rstd * gg.x + bb.x; y[1] = (v[i].y - mu) * rstd * gg.y + bb.y; y[2] = (v[i].z - mu) * rstd * gg.z + bb.z; y[3] = (v[i].w - mu) * rstd * gg.w + bb.w;
      uint2 o; o.x = pack2(y[0], y[1]); o.y = pack2(y[2], y[3]);
      *(uint2*)(dst + (size_t)row * 1024 + c0) = o;
#pragma unroll
      for (int e = 0; e < 4; ++e) {
        const float4 w0 = *(const float4*)(Wg + (c0 + e) * 8), w1 = *(const float4*)(Wg + (c0 + e) * 8 + 4);
        pg[0] += y[e] * w0.x; pg[1] += y[e] * w0.y; pg[2] += y[e] * w0.z; pg[3] += y[e] * w0.w;
        pg[4] += y[e] * w1.x; pg[5] += y[e] * w1.y; pg[6] += y[e] * w1.z; pg[7] += y[e] * w1.w;
      }
    }
#pragma unroll
    for (int off = 32; off >= 8; off >>= 1) {
      const bool up = (lane & off) != 0;
      const int nkeep = off >> 3;
#pragma unroll
      for (int i = 0; i < 4; ++i) if (i < nkeep) {
        const float send = up ? pg[i] : pg[i + nkeep];
        const float keep = up ? pg[i + nkeep] : pg[i];
        pg[i] = keep + __shfl_xor(send, off);
      }
    }
    float tot = pg[0];
    tot += __shfl_xor(tot, 4); tot += __shfl_xor(tot, 2); tot += __shfl_xor(tot, 1);
    if ((lane & 7) == 0) G[(size_t)row * 8 + (lane >> 3)] = tot;
  }
}

typedef __attribute__((ext_vector_type(4))) float f32x4;
#define MFMA16(a, b, c) __builtin_amdgcn_mfma_f32_16x16x32_bf16((a), (b), (c), 0, 0, 0)
DI uint2 pack4(const f32x16& a, int g) { uint2 o; o.x = pack2(a[4 * g], a[4 * g + 1]); o.y = pack2(a[4 * g + 2], a[4 * g + 3]); return o; }
DI void stage_rc(int b, int& R, int& C) { const int st = b >> 10, sb = b & 1023, swz = sb ^ (((sb >> 9) & 1) << 5); R = (st >> 1) * 16 + (swz >> 6); C = (st & 1) * 32 + ((swz & 63) >> 1); }
constexpr int CT_LD = 264;
template <int SWAP>
DI void gemm256(const u16* __restrict__ Ab, const u16* __restrict__ Bb, const u16* __restrict__ nAb, const u16* __restrict__ nBb, bool first, bool has_next, f32x4 (&acc)[8][4], char* lds) {
  const int tid = otid(), wid = tid >> 6, lane = tid & 63, wr = wid >> 2, wc = wid & 3, fr = lane & 15, fq = lane >> 4;
  int goff[4];
#pragma unroll
  for (int i = 0; i < 4; ++i) { int R, C; stage_rc(wid * 1024 + i * 8192 + lane * 16, R, C); goff[i] = R * 1024 + C; }
#pragma unroll
  for (int m = 0; m < 8; ++m)
#pragma unroll
    for (int n = 0; n < 4; ++n) acc[m][n] = f32x4{0.f, 0.f, 0.f, 0.f};
  const int ob = fr * 64 + fq * 16, obs = ob ^ (((ob >> 9) & 1) << 5);
  const int aoff = wr * 16384 + obs, boff = 32768 + wc * 8192 + obs;
#define GLDS_STAGE(buf, pa, pb, kt) do { _Pragma("unroll") for (int i = 0; i < 4; ++i) { \
    __builtin_amdgcn_global_load_lds((const unsigned*)((pa) + goff[i] + (kt) * 64), (__attribute__((address_space(3))) unsigned*)(lds + (buf) * 65536 + wid * 1024 + i * 8192), 16, 0, 0); \
    __builtin_amdgcn_global_load_lds((const unsigned*)((pb) + goff[i] + (kt) * 64), (__attribute__((address_space(3))) unsigned*)(lds + (buf) * 65536 + 32768 + wid * 1024 + i * 8192), 16, 0, 0); } } while (0)
  if (first) {
    GLDS_STAGE(0, Ab, Bb, 0);
    asm volatile("s_waitcnt vmcnt(0)" ::: "memory");
    __syncthreads();
  }
#pragma unroll 1
  for (int t = 0; t < 16; ++t) {
    const int cur = t & 1;
    if (t < 15) GLDS_STAGE(cur ^ 1, Ab, Bb, t + 1);
    else if (has_next) GLDS_STAGE(0, nAb, nBb, 0);
    const char* sa = lds + cur * 65536 + aoff;
    const char* sb = lds + cur * 65536 + boff;
#pragma unroll
    for (int ks = 0; ks < 2; ++ks) {
      bf16x8 At[8], Bf[4];
#pragma unroll
      for (int m = 0; m < 8; ++m) At[m] = *(const bf16x8*)(sa + m * 2048 + ks * 1024);
#pragma unroll
      for (int n = 0; n < 4; ++n) Bf[n] = *(const bf16x8*)(sb + n * 2048 + ks * 1024);
#pragma unroll
      for (int m = 0; m < 8; ++m)
#pragma unroll
        for (int n = 0; n < 4; ++n) acc[m][n] = SWAP ? MFMA16(Bf[n], At[m], acc[m][n]) : MFMA16(At[m], Bf[n], acc[m][n]);
      __builtin_amdgcn_sched_group_barrier(0x100, 12, 0);
      __builtin_amdgcn_sched_group_barrier(0x008, 32, 0);
      __builtin_amdgcn_sched_barrier(0);
    }
    asm volatile("s_waitcnt vmcnt(0)" ::: "memory");
    __syncthreads();
  }
#undef GLDS_STAGE
}
DI void stage_acc(const f32x4 (&acc)[8][4], u16* Ct) {
  const int tid = otid(), wid = tid >> 6, lane = tid & 63, wr = wid >> 2, wc = wid & 3, fr = lane & 15, fq = lane >> 4;
#pragma unroll
  for (int m = 0; m < 8; ++m)
#pragma unroll
    for (int n = 0; n < 4; ++n) {
      uint2 o; o.x = pack2(acc[m][n][0], acc[m][n][1]); o.y = pack2(acc[m][n][2], acc[m][n][3]);
      *(uint2*)(Ct + (wr * 128 + m * 16 + fr) * CT_LD + wc * 64 + n * 16 + fq * 4) = o;
    }
}
template <int SWAP>
DI void store_acc(const f32x4 (&acc)[8][4], u16* __restrict__ dst, size_t ld) {
  const int tid = otid(), wid = tid >> 6, lane = tid & 63, wr = wid >> 2, wc = wid & 3, fr = lane & 15, fq = lane >> 4;
#pragma unroll
  for (int m = 0; m < 8; ++m)
#pragma unroll
    for (int n = 0; n < 4; ++n) {
      uint2 o; o.x = pack2(acc[m][n][0], acc[m][n][1]); o.y = pack2(acc[m][n][2], acc[m][n][3]);
      if (SWAP) *(uint2*)(dst + (size_t)(wr * 128 + m * 16 + fr) * ld + wc * 64 + n * 16 + fq * 4) = o;
      else *(uint2*)(dst + (size_t)(wc * 64 + n * 16 + fr) * ld + wr * 128 + m * 16 + fq * 4) = o;
    }
}
template <int SWAP, int MODE>
DI void epilogue_staged(const f32x4 (&acc)[8][4], char* lds, u16* __restrict__ dst, size_t ld, const u16* __restrict__ Hres) {
  const int tid = otid(), wid = tid >> 6, lane = tid & 63, wr = wid >> 2, wc = wid & 3, fr = lane & 15, fq = lane >> 4;
  u16* Ct = (u16*)(lds + 65536);
#pragma unroll
  for (int h = 0; h < 2; ++h) {
    if ((SWAP ? wr : (wc >> 1)) == h) {
#pragma unroll
      for (int m = 0; m < 8; ++m)
#pragma unroll
        for (int n = 0; n < 4; ++n) {
          uint2 o; o.x = pack2(acc[m][n][0], acc[m][n][1]); o.y = pack2(acc[m][n][2], acc[m][n][3]);
          if (SWAP) *(uint2*)(Ct + (m * 16 + fr) * CT_LD + wc * 64 + n * 16 + fq * 4) = o;
          else *(uint2*)(Ct + ((wc & 1) * 64 + n * 16 + fr) * CT_LD + wr * 128 + m * 16 + fq * 4) = o;
        }
    }
    __syncthreads();
#pragma unroll 4
    for (int i = 0; i < 8; ++i) {
      const int q = tid + 512 * i, r = q >> 5, c8 = (q & 31) * 8;
      uint4 v = *(const uint4*)(Ct + r * CT_LD + c8);
      const size_t o = (size_t)(h * 128 + r) * ld + c8;
      if (MODE == 1) {
        const uint4 hv = *(const uint4*)(Hres + o);
        float y[8], hx[8]; unpack8(v, y); unpack8(hv, hx);
        v.x = pack2(ALPHA * hx[0] + y[0], ALPHA * hx[1] + y[1]); v.y = pack2(ALPHA * hx[2] + y[2], ALPHA * hx[3] + y[3]);
        v.z = pack2(ALPHA * hx[4] + y[4], ALPHA * hx[5] + y[5]); v.w = pack2(ALPHA * hx[6] + y[6], ALPHA * hx[7] + y[7]);
      }
      *(uint4*)(dst + o) = v;
    }
    __syncthreads();
  }
}
DI int lds_byte8(int r, int c) { const int st = (r >> 4) * 2 + (c >> 5), ob = (r & 15) * 64 + (c & 31) * 2; return st * 1024 + (ob ^ (((ob >> 9) & 1) << 5)); }
template <int SWAP>
DI void gemm8p(const u16* __restrict__ Ab, const u16* __restrict__ Bb, f32x4 (&acc)[2][2][4][2], char* lds) {
  constexpr int K = 1024, BK = 64, HALF = 128, HTB = 128 * 64 * 2;
  const int tid = otid(), wid = tid >> 6, lane = tid & 63, wr = wid >> 2, wc = wid & 3, fr = lane & 15, fq = lane >> 4;
  int goff0;
  { int R, C; stage_rc(tid * 16, R, C); goff0 = R * K + C; }
#define SA8(b, h) (lds + ((b) * 2 + (h)) * HTB)
#define SB8(b, h) (lds + (4 + (b) * 2 + (h)) * HTB)
#define STAGE8(P, BASE, br, kt) do { _Pragma("unroll") for (int _i = 0; _i < 2; ++_i) \
    __builtin_amdgcn_global_load_lds((const unsigned*)((BASE) + (size_t)((br) + 64 * _i) * K + (kt) * BK + goff0), (__attribute__((address_space(3))) unsigned*)((P) + wid * 1024 + _i * 8192), 16, 0, 0); } while (0)
#define LDA8(dst, b, h) _Pragma("unroll") for (int m = 0; m < 4; ++m) _Pragma("unroll") for (int k = 0; k < 2; ++k) \
    dst[m][k] = *(const bf16x8*)(SA8(b, h) + lds_byte8(wr * 64 + m * 16 + fr, k * 32 + fq * 8))
#define LDB8(dst, b, h) _Pragma("unroll") for (int n = 0; n < 2; ++n) _Pragma("unroll") for (int k = 0; k < 2; ++k) \
    dst[n][k] = *(const bf16x8*)(SB8(b, h) + lds_byte8(wc * 32 + n * 16 + fr, k * 32 + fq * 8))
#define MMA8(ai, bj, At_, Bt_) do { __builtin_amdgcn_s_setprio(1); \
    _Pragma("unroll") for (int m = 0; m < 4; ++m) _Pragma("unroll") for (int n = 0; n < 2; ++n) _Pragma("unroll") for (int k = 0; k < 2; ++k) \
      acc[ai][bj][m][n] = SWAP ? MFMA16(Bt_[n][k], At_[m][k], acc[ai][bj][m][n]) : MFMA16(At_[m][k], Bt_[n][k], acc[ai][bj][m][n]); \
    __builtin_amdgcn_s_setprio(0); } while (0)
#define WAIT_V(n) asm volatile("s_waitcnt vmcnt(" #n ")" ::: "memory")
#define WAIT_L(n) asm volatile("s_waitcnt lgkmcnt(" #n ")" ::: "memory")
#define BAR8 __builtin_amdgcn_s_barrier()
#define SCHED8 __builtin_amdgcn_sched_barrier(0)
#pragma unroll
  for (int ai = 0; ai < 2; ++ai)
#pragma unroll
    for (int bj = 0; bj < 2; ++bj)
#pragma unroll
      for (int m = 0; m < 4; ++m)
#pragma unroll
        for (int n = 0; n < 2; ++n) acc[ai][bj][m][n] = f32x4{0.f, 0.f, 0.f, 0.f};
  bf16x8 At[4][2], B0[2][2], B1[2][2];
  constexpr int nt = K / BK;
  STAGE8(SB8(0, 0), Bb, 0, 0); STAGE8(SA8(0, 0), Ab, 0, 0);
  STAGE8(SB8(0, 1), Bb, HALF, 0); STAGE8(SA8(0, 1), Ab, HALF, 0);
  if (wr == 1) BAR8;
  WAIT_V(4); BAR8;
  STAGE8(SB8(1, 0), Bb, 0, 1); STAGE8(SA8(1, 0), Ab, 0, 1); STAGE8(SB8(1, 1), Bb, HALF, 1);
  WAIT_V(6); BAR8;
#pragma unroll 1
  for (int t = 0; t < nt - 2; t += 2) {
    LDB8(B0, 0, 0); SCHED8; LDA8(At, 0, 0); STAGE8(SA8(1, 1), Ab, HALF, t + 1);
    WAIT_L(8); BAR8; WAIT_L(0); MMA8(0, 0, At, B0); BAR8; SCHED8;
    LDB8(B1, 0, 1); STAGE8(SB8(0, 0), Bb, 0, t + 2);
    BAR8; WAIT_L(0); MMA8(0, 1, At, B1); BAR8;
    LDA8(At, 0, 1); STAGE8(SA8(0, 0), Ab, 0, t + 2);
    BAR8; WAIT_L(0); MMA8(1, 0, At, B0); BAR8; SCHED8;
    STAGE8(SB8(0, 1), Bb, HALF, t + 2);
    WAIT_V(6); BAR8; MMA8(1, 1, At, B1); BAR8;
    LDB8(B0, 1, 0); SCHED8; LDA8(At, 1, 0); STAGE8(SA8(0, 1), Ab, HALF, t + 2);
    WAIT_L(8); BAR8; WAIT_L(0); MMA8(0, 0, At, B0); BAR8; SCHED8;
    LDB8(B1, 1, 1); STAGE8(SB8(1, 0), Bb, 0, t + 3);
    BAR8; WAIT_L(0); MMA8(0, 1, At, B1); BAR8;
    LDA8(At, 1, 1); STAGE8(SA8(1, 0), Ab, 0, t + 3);
    BAR8; WAIT_L(0); MMA8(1, 0, At, B0); BAR8; SCHED8;
    STAGE8(SB8(1, 1), Bb, HALF, t + 3);
    WAIT_V(6); BAR8; MMA8(1, 1, At, B1); BAR8;
  }
  { LDB8(B0, 0, 0); LDA8(At, 0, 0); STAGE8(SA8(1, 1), Ab, HALF, nt - 1);
    BAR8; WAIT_L(0); MMA8(0, 0, At, B0); BAR8;
    LDB8(B1, 0, 1); BAR8; WAIT_L(0); MMA8(0, 1, At, B1); BAR8;
    LDA8(At, 0, 1); WAIT_V(4); BAR8; WAIT_L(0); MMA8(1, 0, At, B0); MMA8(1, 1, At, B1); BAR8; }
  { LDB8(B0, 1, 0); LDA8(At, 1, 0); WAIT_V(2); BAR8; WAIT_L(0); MMA8(0, 0, At, B0); BAR8;
    LDB8(B1, 1, 1); WAIT_V(0); BAR8; WAIT_L(0); MMA8(0, 1, At, B1); BAR8;
    LDA8(At, 1, 1); BAR8; WAIT_L(0); MMA8(1, 0, At, B0); MMA8(1, 1, At, B1); BAR8; }
  if (wr == 0) BAR8;
  __syncthreads();
#undef SA8
#undef SB8
#undef STAGE8
#undef LDA8
#undef LDB8
#undef MMA8
#undef WAIT_V
#undef WAIT_L
#undef BAR8
#undef SCHED8
}
template <int SWAP>
DI void stage8(const f32x4 (&acc)[2][2][4][2], u16* Ct) {
  const int tid = otid(), wid = tid >> 6, lane = tid & 63, wr = wid >> 2, wc = wid & 3, fr = lane & 15, fq = lane >> 4;
#pragma unroll
  for (int ai = 0; ai < 2; ++ai)
#pragma unroll
    for (int bj = 0; bj < 2; ++bj)
#pragma unroll
      for (int m = 0; m < 4; ++m)
#pragma unroll
        for (int n = 0; n < 2; ++n) {
          uint2 o; o.x = pack2(acc[ai][bj][m][n][0], acc[ai][bj][m][n][1]); o.y = pack2(acc[ai][bj][m][n][2], acc[ai][bj][m][n][3]);
          if (SWAP) *(uint2*)(Ct + (ai * 128 + wr * 64 + m * 16 + fr) * CT_LD + bj * 128 + wc * 32 + n * 16 + fq * 4) = o;
          else *(uint2*)(Ct + (bj * 128 + wc * 32 + n * 16 + fr) * CT_LD + ai * 128 + wr * 64 + m * 16 + fq * 4) = o;
        }
}
template <int SWAP, int MODE>
DI void epilogue8(const f32x4 (&acc)[2][2][4][2], char* lds, u16* __restrict__ dst, size_t ld, const u16* __restrict__ Hres) {
  const int tid = otid();
  u16* Ct = (u16*)lds;
  stage8<SWAP>(acc, Ct);
  __syncthreads();
#pragma unroll 4
  for (int i = 0; i < 16; ++i) {
    const int q = tid + 512 * i, r = q >> 5, c8 = (q & 31) * 8;
    uint4 v = *(const uint4*)(Ct + r * CT_LD + c8);
    const size_t o = (size_t)r * ld + c8;
    if (MODE == 1) {
      const uint4 hv = *(const uint4*)(Hres + o);
      float y[8], hx[8]; unpack8(v, y); unpack8(hv, hx);
      v.x = pack2(ALPHA * hx[0] + y[0], ALPHA * hx[1] + y[1]); v.y = pack2(ALPHA * hx[2] + y[2], ALPHA * hx[3] + y[3]);
      v.z = pack2(ALPHA * hx[4] + y[4], ALPHA * hx[5] + y[5]); v.w = pack2(ALPHA * hx[6] + y[6], ALPHA * hx[7] + y[7]);
    }
    *(uint4*)(dst + o) = v;
  }
  __syncthreads();
}

DI bool tile_of(int it, int MT, int NT, int& mt, int& nt) {
  const int nb = gridDim.x;
  if ((nb & 7) == 0 && (MT & 7) == 0) {
    const int x = blockIdx.x & 7, slot = blockIdx.x >> 3, nx = nb >> 3, j = slot + it * nx, per = (MT >> 3) * NT;
    if (j >= per) return false;
    if (NT == 14 && (MT >> 3) == 32) {
      const int r = j / 28, w = j - r * 28, nh = r >> 3, mg = r & 7;
      mt = x * 32 + mg * 4 + w / 7; nt = nh * 7 + w % 7; return true;
    }
    mt = x * (MT >> 3) + j / NT; nt = j % NT; return true;
  }
  const int j = blockIdx.x + it * nb;
  if (j >= MT * NT) return false;
  mt = j / NT; nt = j % NT; return true;
}

DI void phase_inproj(const Params& p, char* lds) {
  char* ws = p.ws;
  const u16* A = (const u16*)(ws + OFF_H); const u16* W = (const u16*)(ws + OFF_WIN);
  int mt, nt; bool have = tile_of(0, 256, 14, mt, nt);
  for (int it = 0; have; ++it) {
    const int m0 = mt * 256, n0 = nt * 256;
    int mtn, ntn; const bool hn = tile_of(it + 1, 256, 14, mtn, ntn);
    const u16* nA = A + (size_t)(hn ? mtn : 0) * 256 * 1024; const u16* nB = W + (size_t)(hn ? ntn : 0) * 256 * 1024;
    const bool tr = (n0 >= 1024 && n0 < 1536) || (n0 >= 2560 && n0 < 3072);
    f32x4 acc[2][2][4][2];
    if (tr) {
      gemm8p<0>(A + (size_t)m0 * 1024, W + (size_t)n0 * 1024, acc, lds);
      u16* dst = (n0 < 1536) ? (u16*)(ws + OFF_VTA) + ((size_t)((m0 >> 13) * 512 + (n0 - 1024))) * SEQ + (m0 & 8191)
                             : (u16*)(ws + OFF_VTM) + ((size_t)((m0 >> 13) * 512 + (n0 - 2560))) * SEQ + (m0 & 8191);
      epilogue8<0, 0>(acc, lds, dst, SEQ, nullptr);
    } else {
      gemm8p<1>(A + (size_t)m0 * 1024, W + (size_t)n0 * 1024, acc, lds);
      u16* dst; size_t ld;
      if (n0 < 1024) { dst = (u16*)(ws + OFF_PA) + (size_t)m0 * 1024 + n0; ld = 1024; }
      else if (n0 < 2560) { dst = (u16*)(ws + OFF_PM) + (size_t)m0 * 1024 + (n0 - 1536); ld = 1024; }
      else { dst = (u16*)(ws + OFF_PO) + (size_t)m0 * 512 + (n0 - 3072); ld = 512; }
      epilogue8<1, 0>(acc, lds, dst, ld, nullptr);
    }
    mt = mtn; nt = ntn; have = hn;
  }
  for (int it = 0;; ++it) {
    if (!tile_of(it, 8, 8, mt, nt)) break;
    const int m0 = mt * 256, n0 = nt * 256;
    const u16* Am = (const u16*)(ws + OFF_MEMB) + (size_t)m0 * 1024; const u16* Bm = (const u16*)(ws + OFF_WKV) + (size_t)n0 * 1024;
    f32x4 acc[2][2][4][2];
    if (n0 >= 1024) { gemm8p<0>(Am, Bm, acc, lds); epilogue8<0, 0>(acc, lds, (u16*)(ws + OFF_VTX) + ((size_t)((m0 >> 8) * 1024 + (n0 - 1024))) * 256, 256, nullptr); }
    else { gemm8p<1>(Am, Bm, acc, lds); epilogue8<1, 0>(acc, lds, (u16*)(ws + OFF_KX) + (size_t)m0 * 1024 + n0, 1024, nullptr); }
  }
}

template <int MODE>
DI void phase_gemm1024(const u16* __restrict__ A, const u16* __restrict__ Wt, u16* __restrict__ dstb, const u16* __restrict__ Hres, char* lds) {
  const int tid = otid(), wid = tid >> 6, lane = tid & 63, wr = wid >> 2, wc = wid & 3, fr = lane & 15, fq = lane >> 4;
  int mt, nt; bool have = tile_of(0, 256, 4, mt, nt);
  for (int it = 0; have; ++it) {
    const int m0 = mt * 256, n0 = nt * 256;
    int mtn, ntn; const bool hn = tile_of(it + 1, 256, 4, mtn, ntn);
    f32x4 acc[2][2][4][2];
    gemm8p<1>(A + (size_t)m0 * 1024, Wt + (size_t)n0 * 1024, acc, lds);
    epilogue8<1, MODE>(acc, lds, dstb + (size_t)m0 * 1024 + n0, 1024, (MODE == 1) ? Hres + (size_t)m0 * 1024 + n0 : nullptr);
    mt = mtn; nt = ntn; have = hn;
  }
}

DI void attn_item(const Params& p, char* lds, int item) {
  char* ws = p.ws;
  const int tid = otid(), lane = tid & 63, wave = tid >> 6, l31 = lane & 31, hh = lane >> 5;
  const int b = item >> 8, h = (item >> 5) & 7, c0 = (item & 31) * 4;
  const int qc = c0 + (wave >> 1), qt = wave & 1;
  const u16* PA = (const u16*)(ws + OFF_PA); const u16* VTa = (const u16*)(ws + OFF_VTA); u16* MIX = (u16*)(ws + OFF_MIX);
  u16* Kl = (u16*)lds;
  u16* Vl = Kl + 2 * 64 * 72;
  float* biasl = (float*)(Vl + 2 * 64 * 72);
  const int pi = perm23(l31);
  const int sr = tid >> 3, sc8 = (tid & 7) * 8;
  const u16* kg = PA + ((size_t)b * SEQ + sr) * 1024 + 512 + h * 64 + sc8;
  const u16* vg = VTa + ((size_t)((b * 8 + h) * 64 + sr)) * SEQ + sc8;
  for (int i = tid; i < 257; i += 512) biasl[i] = p.in[10][h * 257 + i] * 1.4426950408889634f;
  const size_t q0 = (size_t)b * SEQ + qc * 64 + qt * 32;
  bf16x8 Qf[4];
#pragma unroll
  for (int kk = 0; kk < 4; ++kk) Qf[kk] = ldfrag(PA + (q0 + l31) * 1024 + h * 64 + kk * 16 + 8 * hh);
  const int kcs = (c0 >= 8) ? c0 - 8 : 0, kce = c0 + 3;
  *(uint4*)(Kl + sr * 72 + sc8) = *(const uint4*)(kg + (size_t)(kcs * 64) * 1024);
  *(uint4*)(Vl + sr * 72 + sc8) = *(const uint4*)(vg + kcs * 64);
  __syncthreads();
  f32x16 O[2]; O[0] = zero16(); O[1] = zero16();
  float mrun = -INFINITY, lrun = 0.f;
#pragma unroll 1
  for (int kc = kcs; kc <= kce; ++kc) {
    const int cur = (kc - kcs) & 1;
    uint4 nk, nv;
    if (kc < kce) { nk = *(const uint4*)(kg + (size_t)((kc + 1) * 64) * 1024); nv = *(const uint4*)(vg + (kc + 1) * 64); }
    if (kc >= qc - 8 && kc <= qc) {
      f32x16 S[2];
      float mx = -INFINITY;
#pragma unroll
      for (int sub = 0; sub < 2; ++sub) {
        const u16* kl = Kl + cur * 64 * 72 + (sub * 32 + pi) * 72 + 8 * hh;
        S[sub] = zero16();
#pragma unroll
        for (int kk = 0; kk < 4; ++kk) S[sub] = MFMA(ldfrag(kl + kk * 16), Qf[kk], S[sub]);
        const int relbase = (kc * 64 + sub * 32 + 8 * hh) - (qc * 64 + qt * 32 + l31);
        if ((kc * 64 + sub * 32 + 31) - (qc * 64 + qt * 32) <= -128) {
          const float b0 = biasl[0];
#pragma unroll
          for (int r = 0; r < 16; ++r) { const float sv = S[sub][r] * 0.18033688011112042f + b0; S[sub][r] = sv; mx = fmaxf(mx, sv); }
        } else {
#pragma unroll
          for (int r = 0; r < 16; ++r) {
            int rel = relbase + 16 * (r >> 3) + (r & 7);
            rel = rel < -128 ? -128 : (rel > 128 ? 128 : rel);
            const float sv = S[sub][r] * 0.18033688011112042f + biasl[rel + 128];
            S[sub][r] = sv; mx = fmaxf(mx, sv);
          }
        }
      }
      mx = fmaxf(mx, __shfl_xor(mx, 32));
      const float mnew = fmaxf(mrun, mx);
      const float alpha = __builtin_amdgcn_exp2f(mrun - mnew);
      mrun = mnew;
      float ps = 0.f;
#pragma unroll
      for (int sub = 0; sub < 2; ++sub)
#pragma unroll
        for (int r = 0; r < 16; ++r) { const float e = __builtin_amdgcn_exp2f(S[sub][r] - mnew); S[sub][r] = e; ps += e; }
      lrun = lrun * alpha + ps;
#pragma unroll
      for (int r = 0; r < 16; ++r) { O[0][r] *= alpha; O[1][r] *= alpha; }
#pragma unroll
      for (int sub = 0; sub < 2; ++sub) {
        bf16x8 Pf[2];
#pragma unroll
        for (int ks = 0; ks < 2; ++ks) {
          union { bf16x8 v; unsigned u[4]; } cv;
          for (int j2 = 0; j2 < 4; ++j2) cv.u[j2] = pack2(S[sub][8 * ks + 2 * j2], S[sub][8 * ks + 2 * j2 + 1]);
          Pf[ks] = cv.v;
        }
        const u16* vl = Vl + cur * 64 * 72 + l31 * 72 + sub * 32 + 8 * hh;
#pragma unroll
        for (int dt = 0; dt < 2; ++dt)
#pragma unroll
          for (int ks = 0; ks < 2; ++ks) O[dt] = MFMA(ldfrag(vl + dt * 32 * 72 + 16 * ks), Pf[ks], O[dt]);
      }
    }
    if (kc < kce) { const int nx = cur ^ 1; *(uint4*)(Kl + nx * 64 * 72 + sr * 72 + sc8) = nk; *(uint4*)(Vl + nx * 64 * 72 + sr * 72 + sc8) = nv; }
    __syncthreads();
  }
  const float inv = __builtin_amdgcn_rcpf(lrun + __shfl_xor(lrun, 32));
#pragma unroll
  for (int dt = 0; dt < 2; ++dt)
#pragma unroll
    for (int g = 0; g < 4; ++g) {
      uint2 o; o.x = pack2(O[dt][4 * g] * inv, O[dt][4 * g + 1] * inv); o.y = pack2(O[dt][4 * g + 2] * inv, O[dt][4 * g + 3] * inv);
      *(uint2*)(MIX + (q0 + l31) * 1024 + h * 64 + dt * 32 + 8 * g + 4 * hh) = o;
    }
}

DI float log_sigmoid(float f) { return fminf(f, 0.f) - log1pf(expf(-fabsf(f))); }
DI float scan_sum(float v, int lane) { for (int o = 1; o < 64; o <<= 1) { float tv = __shfl_up(v, o); if (lane >= o) v += tv; } return v; }
DI float scan_max(float v, int lane) { for (int o = 1; o < 64; o <<= 1) { float tv = __shfl_up(v, o); if (lane >= o) v = fmaxf(v, tv); } return v; }

DI void conv_unit(const u16* __restrict__ PM, const float* __restrict__ conv_w, const float* __restrict__ conv_b, int b, int sl0, int ch, float scale, float* a8) {
  { const float4 b0 = *(const float4*)(conv_b + ch), b1 = *(const float4*)(conv_b + ch + 4); a8[0] = b0.x; a8[1] = b0.y; a8[2] = b0.z; a8[3] = b0.w; a8[4] = b1.x; a8[5] = b1.y; a8[6] = b1.z; a8[7] = b1.w; }
#pragma unroll
  for (int j = 0; j < 4; ++j) {
    const int sl = sl0 - 3 + j;
    if (sl >= 0) {
      const uint4 raw = *(const uint4*)(PM + ((size_t)b * SEQ + sl) * 1024 + ch);
      float x8[8]; unpack8(raw, x8);
      const float4 w0 = *(const float4*)(conv_w + j * 1024 + ch), w1 = *(const float4*)(conv_w + j * 1024 + ch + 4);
      a8[0] += w0.x * x8[0]; a8[1] += w0.y * x8[1]; a8[2] += w0.z * x8[2]; a8[3] += w0.w * x8[3];
      a8[4] += w1.x * x8[4]; a8[5] += w1.y * x8[5]; a8[6] += w1.z * x8[6]; a8[7] += w1.w * x8[7];
    }
  }
#pragma unroll
  for (int e = 0; e < 8; ++e) { const float v = a8[e]; a8[e] = scale * v * __builtin_amdgcn_rcpf(1.f + __expf(-v)); }
}

DI void mlstmA_item(const Params& p, char* lds, int item) {
  char* ws = p.ws;
  const int bh = item >> 7, c = item & 127, b = bh >> 2, hd = bh & 3;
  const int tid = otid(), lane = tid & 63, wave = tid >> 6, hh = lane >> 5, l31 = lane & 31;
  u16* KTs = (u16*)lds;
  u16* VTs = KTs + 128 * 72;
  float* win = (float*)(VTs + 128 * 72);
  const u16* PM = (const u16*)(ws + OFF_PM); const u16* VTm = (const u16*)(ws + OFF_VTM);
  const float* G = (const float*)(ws + OFF_G);
  u16* KVS = (u16*)(ws + OFF_KVS) + (size_t)item * 16384; float* KSUM = (float*)(ws + OFF_KSUM) + (size_t)item * 128; float* CSC = (float*)(ws + OFF_CSC) + (size_t)item * 4;
  if (wave == 0) {
    const size_t row = (size_t)b * SEQ + c * 64 + lane;
    const float ig = G[row * 8 + hd] + p.in[7][hd], fg = G[row * 8 + 4 + hd] + p.in[8][hd];
    const float bc = scan_sum(log_sigmoid(fg), lane);
    const float as = ig - bc;
    const float gmax = wmax(as);
    const float B = __shfl(bc, 63);
    win[lane] = expf(as - gmax);
    if (lane == 0) { CSC[0] = B; CSC[1] = B + gmax; }
  }
  for (int i = 0; i < 2; ++i) {
    const int q = tid + 512 * i, e = q >> 3, s8 = (q & 7) * 8;
    *(uint4*)(VTs + e * 72 + s8) = *(const uint4*)(VTm + ((size_t)(bh * 128 + e)) * SEQ + c * 64 + s8);
  }
  __syncthreads();
#pragma unroll 1
  for (int i = 0; i < 2; ++i) {
    const int cgk = tid & 15, t = (tid >> 4) + 32 * i;
    float a8[8];
    conv_unit(PM, p.in[5], p.in[6], b, c * 64 + t, 512 + hd * 128 + cgk * 8, 0.08838834764831845f, a8);
    const float w = win[t];
#pragma unroll
    for (int e = 0; e < 8; ++e) KTs[(cgk * 8 + e) * 72 + t] = f2bf(a8[e] * w);
  }
  __syncthreads();
  {
    const int dt = wave >> 1;
#pragma unroll
    for (int x = 0; x < 2; ++x) {
      const int e2 = (wave & 1) * 2 + x;
      f32x16 acc = zero16();
#pragma unroll
      for (int ks = 0; ks < 4; ++ks) acc = MFMA(ldfrag(KTs + (dt * 32 + l31) * 72 + ks * 16 + 8 * hh), ldfrag(VTs + (e2 * 32 + l31) * 72 + ks * 16 + 8 * hh), acc);
#pragma unroll
      for (int g = 0; g < 4; ++g) *(uint2*)(KVS + (e2 * 32 + l31) * 128 + dt * 32 + 8 * g + 4 * hh) = pack4(acc, g);
    }
    if (tid < 128) {
      float sacc = 0.f;
      for (int s8 = 0; s8 < 8; ++s8) { const uint4 raw = *(const uint4*)(KTs + tid * 72 + s8 * 8); float x8[8]; unpack8(raw, x8); for (int e = 0; e < 8; ++e) sacc += x8[e]; }
      KSUM[tid] = sacc;
    }
  }
  __syncthreads();
}

DI void phase_mlstm_scan(const Params& p) {
  char* ws = p.ws;
  const int tid = otid();
  for (int unit = blockIdx.x; unit < 256; unit += gridDim.x) {
    const int bh = unit >> 3, part = unit & 7;
    u16* kv = (u16*)(ws + OFF_KVS) + (size_t)bh * 128 * 16384 + part * 2048 + tid * 4;
    float* ks = (float*)(ws + OFF_KSUM) + (size_t)bh * 128 * 128 + tid;
    float* csc = (float*)(ws + OFF_CSC) + (size_t)bh * 128 * 4;
    const bool don = (part == 0) && (tid < 128);
    float m = 0.f, c0 = 0.f, c1 = 0.f, c2 = 0.f, c3 = 0.f, n = 0.f;
#pragma unroll 1
    for (int cb = 0; cb < 128; cb += 8) {
      uint2 raw[8]; float kr[8];
#pragma unroll
      for (int j = 0; j < 8; ++j) { raw[j] = *(const uint2*)(kv + (size_t)(cb + j) * 16384); kr[j] = don ? ks[(cb + j) * 128] : 0.f; }
#pragma unroll
      for (int j = 0; j < 8; ++j) {
        const float B = csc[(cb + j) * 4], A = csc[(cb + j) * 4 + 1];
        const float mnew = fmaxf(B + m, A);
        const float wp = __expf(B + m - mnew), wl = __expf(A - mnew);
        m = mnew;
        c0 = wp * c0 + wl * bflo(raw[j].x); c1 = wp * c1 + wl * bfhi(raw[j].x); c2 = wp * c2 + wl * bflo(raw[j].y); c3 = wp * c3 + wl * bfhi(raw[j].y);
        uint2 o; o.x = pack2(c0, c1); o.y = pack2(c2, c3);
        *(uint2*)(kv + (size_t)(cb + j) * 16384) = o;
        if (don) { n = wp * n + wl * kr[j]; ks[(cb + j) * 128] = n; }
        if (part == 0 && tid == 0) csc[(cb + j) * 4 + 2] = mnew;
      }
    }
  }
}

DI void mlstmC_pair(const Params& p, char* lds_all, int pair) {
  char* ws = p.ws;
  const int tid = otid(), hb = tid >> 8, ltid = tid & 255, lane = tid & 63, lwave = ltid >> 6, hh = lane >> 5, l31 = lane & 31;
  const int item = pair * 2 + hb;
  const int bh = item >> 7, c = item & 127, b = bh >> 2, hd = bh & 3;
  char* lds = lds_all + hb * 69632;
  u16* Qs = (u16*)lds;
  u16* Ks = Qs + 64 * 136;
  u16* VTs = Ks + 64 * 136;
  u16* Ps = VTs + 128 * 72;
  float* fs = (float*)(Ps + 64 * 72);
  float* a_s = fs; float* c_t = fs + 64; float* wint = fs + 128; float* emt = fs + 192; float* qnp = fs + 256; float* qks = fs + 512; float* red = fs + 640;
  const u16* PM = (const u16*)(ws + OFF_PM); const u16* VTm = (const u16*)(ws + OFF_VTM); const u16* PO = (const u16*)(ws + OFF_PO);
  const float* G = (const float*)(ws + OFF_G); u16* MIX = (u16*)(ws + OFF_MIX);
  const u16* CT = (const u16*)(ws + OFF_KVS) + (size_t)(item - 1) * 16384;
  const float* NP = (const float*)(ws + OFF_KSUM) + (size_t)(item - 1) * 128;
  const float* ng = p.in[9] + hd * 128;
  const float mprev = (c > 0) ? ((const float*)(ws + OFF_CSC))[(size_t)(item - 1) * 4 + 2] : 0.f;
#pragma unroll 1
  for (int i = 0; i < 8; ++i) {
    const int cg8 = ltid & 31, isK = cg8 >> 4, chl = (cg8 & 15) * 8, t = (ltid >> 5) + 8 * i;
    float a8[8];
    conv_unit(PM, p.in[5], p.in[6], b, c * 64 + t, (isK ? 512 : 0) + hd * 128 + chl, isK ? 0.08838834764831845f : 1.f, a8);
    uint4 o; o.x = pack2(a8[0], a8[1]); o.y = pack2(a8[2], a8[3]); o.z = pack2(a8[4], a8[5]); o.w = pack2(a8[6], a8[7]);
    *(uint4*)((isK ? Ks : Qs) + t * 136 + chl) = o;
  }
  for (int i = 0; i < 4; ++i) {
    const int q = ltid + 256 * i, e = q >> 3, s8 = (q & 7) * 8;
    *(uint4*)(VTs + e * 72 + s8) = *(const uint4*)(VTm + ((size_t)(bh * 128 + e)) * SEQ + c * 64 + s8);
  }
  if (lwave == 0) {
    const size_t row = (size_t)b * SEQ + c * 64 + lane;
    const float ig = G[row * 8 + hd] + p.in[7][hd], fg = G[row * 8 + 4 + hd] + p.in[8][hd];
    const float bc = scan_sum(log_sigmoid(fg), lane);
    const float as = ig - bc;
    const float gm = scan_max(as, lane);
    const float mt = bc + fmaxf(mprev, gm);
    a_s[lane] = as; c_t[lane] = bc - mt; wint[lane] = expf(bc + mprev - mt); emt[lane] = expf(-mt);
  }
  __syncthreads();
  {
    const int t = ltid & 63, part = ltid >> 6;
    float acc = 0.f;
    if (c > 0) for (int dd = 0; dd < 32; ++dd) acc += bf2f(Qs[t * 136 + part * 32 + dd]) * NP[part * 32 + dd];
    qnp[part * 64 + t] = acc;
  }
  {
    const int si = lwave >> 1, ti = lwave & 1;
    f32x16 S = zero16();
#pragma unroll
    for (int kk = 0; kk < 8; ++kk) S = MFMA(ldfrag(Ks + (si * 32 + l31) * 136 + kk * 16 + 8 * hh), ldfrag(Qs + (ti * 32 + l31) * 136 + kk * 16 + 8 * hh), S);
    const int t = ti * 32 + l31;
    const float ct = c_t[t];
    float rs = 0.f;
#pragma unroll
    for (int g = 0; g < 4; ++g) {
      float v4[4];
#pragma unroll
      for (int q = 0; q < 4; ++q) {
        const int sidx2 = si * 32 + 8 * g + 4 * hh + q;
        const float dv = (sidx2 <= t) ? S[4 * g + q] * __expf(ct + a_s[sidx2]) : 0.f;
        v4[q] = dv; rs += dv;
      }
      uint2 o; o.x = pack2(v4[0], v4[1]); o.y = pack2(v4[2], v4[3]);
      *(uint2*)(Ps + t * 72 + si * 32 + 8 * g + 4 * hh) = o;
    }
    rs += __shfl_xor(rs, 32);
    if (hh == 0) qks[si * 64 + t] = rs;
  }
  __syncthreads();
  const int et = lwave;
  f32x16 Hn[2];
#pragma unroll
  for (int tt = 0; tt < 2; ++tt) {
    const int tq = tt * 32 + l31;
    Hn[tt] = zero16();
    if (c > 0) {
#pragma unroll
      for (int kk = 0; kk < 8; ++kk) Hn[tt] = MFMA(ldfrag(CT + (et * 32 + l31) * 128 + kk * 16 + 8 * hh), ldfrag(Qs + tq * 136 + kk * 16 + 8 * hh), Hn[tt]);
    }
    const float wi = wint[tq];
#pragma unroll
    for (int r = 0; r < 16; ++r) Hn[tt][r] *= wi;
#pragma unroll
    for (int ks = 0; ks < 4; ++ks) Hn[tt] = MFMA(ldfrag(VTs + (et * 32 + l31) * 72 + ks * 16 + 8 * hh), ldfrag(Ps + tq * 72 + ks * 16 + 8 * hh), Hn[tt]);
    const float qn = qnp[tq] + qnp[64 + tq] + qnp[128 + tq] + qnp[192 + tq];
    const float den = wi * qn + qks[tq] + qks[64 + tq];
    const float inv = __builtin_amdgcn_rcpf(fmaxf(fabsf(den), emt[tq]));
    float s1 = 0.f, s2 = 0.f;
#pragma unroll
    for (int r = 0; r < 16; ++r) { Hn[tt][r] *= inv; s1 += Hn[tt][r]; s2 += Hn[tt][r] * Hn[tt][r]; }
    s1 += __shfl_xor(s1, 32); s2 += __shfl_xor(s2, 32);
    if (hh == 0) { red[(et * 64 + tq) * 2] = s1; red[(et * 64 + tq) * 2 + 1] = s2; }
  }
  __syncthreads();
#pragma unroll
  for (int tt = 0; tt < 2; ++tt) {
    const int tq = tt * 32 + l31;
    float t1 = 0.f, t2 = 0.f;
    for (int e4 = 0; e4 < 4; ++e4) { t1 += red[(e4 * 64 + tq) * 2]; t2 += red[(e4 * 64 + tq) * 2 + 1]; }
    const float mu = t1 * (1.f / 128.f);
    const float var = fmaxf(t2 * (1.f / 128.f) - mu * mu, 0.f);
    const float rstd = rsqrtf(var + LN_EPS);
    const size_t row = (size_t)b * SEQ + c * 64 + tq;
#pragma unroll
    for (int g = 0; g < 4; ++g) {
      const int e0 = et * 32 + 8 * g + 4 * hh;
      const uint2 og = *(const uint2*)(PO + row * 512 + hd * 128 + e0);
      const float4 gg = *(const float4*)(ng + e0);
      const float o0 = __builtin_amdgcn_rcpf(1.f + __expf(-bflo(og.x))), o1 = __builtin_amdgcn_rcpf(1.f + __expf(-bfhi(og.x))), o2 = __builtin_amdgcn_rcpf(1.f + __expf(-bflo(og.y))), o3 = __builtin_amdgcn_rcpf(1.f + __expf(-bfhi(og.y)));
      uint2 o;
      o.x = pack2(o0 * (Hn[tt][4 * g] - mu) * rstd * gg.x, o1 * (Hn[tt][4 * g + 1] - mu) * rstd * gg.y);
      o.y = pack2(o2 * (Hn[tt][4 * g + 2] - mu) * rstd * gg.z, o3 * (Hn[tt][4 * g + 3] - mu) * rstd * gg.w);
      *(uint2*)(MIX + row * 1024 + 512 + hd * 128 + e0) = o;
    }
  }
  __syncthreads();
}

DI void phase_mixA(const Params& p, char* lds) {
  for (int it = blockIdx.x; it < 4096; it += gridDim.x) mlstmA_item(p, lds, it);
  for (int it = blockIdx.x; it < 2048; it += gridDim.x) attn_item(p, lds, it);
}
DI void phase_mixC(const Params& p, char* lds) {
  for (int it = blockIdx.x; it < 2048; it += gridDim.x) mlstmC_pair(p, lds, it);
}

DI void phase_xattn(const Params& p, char* lds) {
  char* ws = p.ws;
  const int tid = otid(), lane = tid & 63, wave = tid >> 6, l31 = lane & 31, hh = lane >> 5;
  const u16* XQ = (const u16*)(ws + OFF_XQ); const u16* KX = (const u16*)(ws + OFF_KX); const u16* VTX = (const u16*)(ws + OFF_VTX);
  u16* XO = (u16*)(ws + OFF_XO);
  u16* Kl = (u16*)lds; u16* Vl = Kl + 2 * 32 * 264;
  const int pi = perm23(l31);
  const int kr0 = tid >> 5, kc = (tid & 31) * 8, vr = tid >> 2, vc = (tid & 3) * 8;
  for (int item = blockIdx.x; item < 1024; item += gridDim.x) {
    const int b = item >> 7, h = (item >> 5) & 3, qblk = item & 31;
    const size_t q0 = (size_t)b * SEQ + qblk * 256 + wave * 32;
    bf16x8 Qf[16];
#pragma unroll
    for (int kk = 0; kk < 16; ++kk) Qf[kk] = ldfrag(XQ + (q0 + l31) * 1024 + h * 256 + kk * 16 + 8 * hh);
    const u16* kg = KX + ((size_t)b * 256) * 1024 + h * 256;
    const u16* vg = VTX + ((size_t)((b * 4 + h) * 256)) * 256;
    {
      const uint4 k0 = *(const uint4*)(kg + (size_t)kr0 * 1024 + kc), k1 = *(const uint4*)(kg + (size_t)(kr0 + 16) * 1024 + kc);
      const uint4 v0 = *(const uint4*)(vg + (size_t)vr * 256 + vc);
      *(uint4*)(Kl + kr0 * 264 + kc) = k0; *(uint4*)(Kl + (kr0 + 16) * 264 + kc) = k1; *(uint4*)(Vl + vr * 40 + vc) = v0;
    }
    __syncthreads();
    f32x16 O[4]; for (int i = 0; i < 4; ++i) O[i] = zero16();
    float mrun = -INFINITY, lrun = 0.f;
#pragma unroll 1
    for (int st = 0; st < 16; ++st) {
      const int dh = st >> 3, kt = st & 7, cur = st & 1;
      uint4 nk0, nk1, nv0;
      if (st < 15) {
        const int ndh = (st + 1) >> 3, nkt = (st + 1) & 7;
        nk0 = *(const uint4*)(kg + (size_t)(nkt * 32 + kr0) * 1024 + kc); nk1 = *(const uint4*)(kg + (size_t)(nkt * 32 + kr0 + 16) * 1024 + kc);
        nv0 = *(const uint4*)(vg + (size_t)(ndh * 128 + vr) * 256 + nkt * 32 + vc);
      }
      const u16* kl = Kl + cur * 32 * 264 + pi * 264 + 8 * hh;
      const u16* vl = Vl + cur * 128 * 40 + l31 * 40 + 8 * hh;
      f32x16 S = zero16();
#pragma unroll
      for (int kk = 0; kk < 16; ++kk) S = MFMA(ldfrag(kl + kk * 16), Qf[kk], S);
      float mx = -INFINITY;
#pragma unroll
      for (int r = 0; r < 16; ++r) { S[r] *= 0.09016844005556021f; mx = fmaxf(mx, S[r]); }
      mx = fmaxf(mx, __shfl_xor(mx, 32));
      const float mnew = fmaxf(mrun, mx), alpha = __builtin_amdgcn_exp2f(mrun - mnew);
      mrun = mnew;
      float ps = 0.f;
#pragma unroll
      for (int r = 0; r < 16; ++r) { const float e = __builtin_amdgcn_exp2f(S[r] - mnew); S[r] = e; ps += e; }
      lrun = lrun * alpha + ps;
      bf16x8 Pf[2];
#pragma unroll
      for (int ks = 0; ks < 2; ++ks) {
        union { bf16x8 v; unsigned u[4]; } cv;
        for (int j2 = 0; j2 < 4; ++j2) cv.u[j2] = pack2(S[8 * ks + 2 * j2], S[8 * ks + 2 * j2 + 1]);
        Pf[ks] = cv.v;
      }
#pragma unroll
      for (int dt = 0; dt < 4; ++dt) {
#pragma unroll
        for (int r = 0; r < 16; ++r) O[dt][r] *= alpha;
#pragma unroll
        for (int ks = 0; ks < 2; ++ks) O[dt] = MFMA(ldfrag(vl + dt * 32 * 40 + 16 * ks), Pf[ks], O[dt]);
      }
      if (kt == 7) {
        const float inv = __builtin_amdgcn_rcpf(lrun + __shfl_xor(lrun, 32));
#pragma unroll
        for (int dt = 0; dt < 4; ++dt) {
#pragma unroll
          for (int g = 0; g < 4; ++g) {
            uint2 o; o.x = pack2(O[dt][4 * g] * inv, O[dt][4 * g + 1] * inv); o.y = pack2(O[dt][4 * g + 2] * inv, O[dt][4 * g + 3] * inv);
            *(uint2*)(XO + (q0 + l31) * 1024 + h * 256 + dh * 128 + dt * 32 + 8 * g + 4 * hh) = o;
          }
          O[dt] = zero16();
        }
        mrun = -INFINITY; lrun = 0.f;
      }
      if (st < 15) {
        const int nx = cur ^ 1;
        *(uint4*)(Kl + nx * 32 * 264 + kr0 * 264 + kc) = nk0; *(uint4*)(Kl + nx * 32 * 264 + (kr0 + 16) * 264 + kc) = nk1; *(uint4*)(Vl + nx * 128 * 40 + vr * 40 + vc) = nv0;
      }
      __syncthreads();
    }
  }
}

DI void phase_peer_query(const Params& p, char* lds) {
  char* ws = p.ws;
  const int tid = otid(), lane = tid & 63, wave = tid >> 6, wm = wave >> 1, wn = wave & 1, l31 = lane & 31, hh = lane >> 5;
  const u16* SK = (const u16*)(ws + OFF_SK);
  float* TOPV = (float*)(ws + OFF_TOPV);
  u16* Ct = (u16*)lds;
  float* Sc = (float*)lds;
  float* Ll = (float*)lds;
  for (int it = 0;; ++it) {
    int mt, hq; if (!tile_of(it, 256, 8, mt, hq)) break;
    const int m0 = mt * 256, n0 = hq * 256;
    {
      f32x4 acc[2][2][4][2];
      const u16* Aq = (const u16*)(ws + OFF_H) + (size_t)m0 * 1024; const u16* Bq = (const u16*)(ws + OFF_WPQ) + (size_t)n0 * 1024;
      gemm8p<1>(Aq, Bq, acc, lds);
      stage8<1>(acc, Ct);
    }
    __syncthreads();
    f32x16 sacc[2][2][2];
#pragma unroll
    for (int pp = 0; pp < 2; ++pp) {
#pragma unroll
      for (int i = 0; i < 2; ++i) for (int j = 0; j < 2; ++j) sacc[pp][i][j] = zero16();
#pragma unroll
      for (int kk = 0; kk < 8; ++kk) {
        const bf16x8 a0 = ldfrag(Ct + (wm * 64 + l31) * CT_LD + pp * 128 + kk * 16 + 8 * hh), a1 = ldfrag(Ct + (wm * 64 + 32 + l31) * CT_LD + pp * 128 + kk * 16 + 8 * hh);
        const bf16x8 b0 = ldfrag(SK + (size_t)(pp * 128 + wn * 64 + l31) * 128 + kk * 16 + 8 * hh), b1 = ldfrag(SK + (size_t)(pp * 128 + wn * 64 + 32 + l31) * 128 + kk * 16 + 8 * hh);
        sacc[pp][0][0] = MFMA(a0, b0, sacc[pp][0][0]); sacc[pp][0][1] = MFMA(a0, b1, sacc[pp][0][1]);
        sacc[pp][1][0] = MFMA(a1, b0, sacc[pp][1][0]); sacc[pp][1][1] = MFMA(a1, b1, sacc[pp][1][1]);
      }
    }
    __syncthreads();
#pragma unroll
    for (int pp = 0; pp < 2; ++pp) {
      const int hp = hq * 2 + pp;
#pragma unroll
      for (int i = 0; i < 2; ++i)
#pragma unroll
        for (int j = 0; j < 2; ++j)
#pragma unroll
          for (int r = 0; r < 16; ++r)
            Sc[(wm * 64 + i * 32 + (r & 3) + 8 * (r >> 2) + 4 * hh) * 132 + wn * 64 + j * 32 + l31] = sacc[pp][i][j][r];
      __syncthreads();
      {
        const int row = tid >> 1, half = tid & 1;
        const float* srow = Sc + row * 132 + half * 64;
        float v[16];
#pragma unroll
        for (int i = 0; i < 16; ++i) v[i] = -INFINITY;
#pragma unroll 2
        for (int e4 = 0; e4 < 16; ++e4) {
          const float4 s4 = *(const float4*)(srow + 4 * e4);
          const float sv[4] = {s4.x, s4.y, s4.z, s4.w};
#pragma unroll
          for (int u = 0; u < 4; ++u) {
            float x = __uint_as_float((__float_as_uint(sv[u]) & 0xFFFFFF80u) | (unsigned)(127 - (half * 64 + 4 * e4 + u)));
#pragma unroll
            for (int i = 0; i < 16; ++i) { const float hi = fmaxf(x, v[i]); x = fminf(x, v[i]); v[i] = hi; }
          }
        }
        float c[16];
#pragma unroll
        for (int i = 0; i < 16; ++i) c[i] = __shfl_xor(v[15 - i], 1);
#pragma unroll
        for (int i = 0; i < 16; ++i) c[i] = fmaxf(c[i], v[i]);
#pragma unroll
        for (int d = 8; d >= 1; d >>= 1)
#pragma unroll
          for (int i = 0; i < 16; ++i)
            if ((i & d) == 0) { const float hi = fmaxf(c[i], c[i + d]), lo = fminf(c[i], c[i + d]); c[i] = hi; c[i + d] = lo; }
        if (half == 0) {
          float* tv = TOPV + (size_t)(m0 + row) * 256 + hp * 16;
#pragma unroll
          for (int i = 0; i < 4; ++i) *(float4*)(tv + 4 * i) = make_float4(c[4 * i], c[4 * i + 1], c[4 * i + 2], c[4 * i + 3]);
        }
      }
      __syncthreads();
    }
  }
}

template <int C> struct CandFlat { static constexpr int calc() { int i = 0, rem = C; while (rem >= 16 / (i + 1)) { rem -= 16 / (i + 1); ++i; } return i * 16 + rem; } static constexpr int value = calc(); };
template <int C> DI void rank_step(const float val, const int flat, int& rank) {
  const float o = __uint_as_float(__builtin_amdgcn_readlane(__float_as_uint(val), C));
  rank += (int)(o > val) | ((int)(o == val) & (int)(CandFlat<C>::value < flat));
}
template <int C0> DI void rank_steps10(const float val, const int flat, int& rank) {
  rank_step<C0>(val, flat, rank); rank_step<C0 + 1>(val, flat, rank); rank_step<C0 + 2>(val, flat, rank); rank_step<C0 + 3>(val, flat, rank); rank_step<C0 + 4>(val, flat, rank);
  rank_step<C0 + 5>(val, flat, rank); rank_step<C0 + 6>(val, flat, rank); rank_step<C0 + 7>(val, flat, rank); rank_step<C0 + 8>(val, flat, rank); rank_step<C0 + 9>(val, flat, rank);
}
DI float dot16q(const uint4& q, const f32x2* x) {
  f32x2 a = __builtin_amdgcn_cvt_pk_f32_fp8((int)q.x, false) * x[0];
  a = __builtin_amdgcn_cvt_pk_f32_fp8((int)q.x, true) * x[1] + a;
  a = __builtin_amdgcn_cvt_pk_f32_fp8((int)q.y, false) * x[2] + a;
  a = __builtin_amdgcn_cvt_pk_f32_fp8((int)q.y, true) * x[3] + a;
  a = __builtin_amdgcn_cvt_pk_f32_fp8((int)q.z, false) * x[4] + a;
  a = __builtin_amdgcn_cvt_pk_f32_fp8((int)q.z, true) * x[5] + a;
  a = __builtin_amdgcn_cvt_pk_f32_fp8((int)q.w, false) * x[6] + a;
  a = __builtin_amdgcn_cvt_pk_f32_fp8((int)q.w, true) * x[7] + a;
  return a.x + a.y;
}
DI void axpy16q(float c, const uint4& q, f32x2* o) {
  const f32x2 c2 = {c, c};
  o[0] = __builtin_amdgcn_cvt_pk_f32_fp8((int)q.x, false) * c2 + o[0];
  o[1] = __builtin_amdgcn_cvt_pk_f32_fp8((int)q.x, true) * c2 + o[1];
  o[2] = __builtin_amdgcn_cvt_pk_f32_fp8((int)q.y, false) * c2 + o[2];
  o[3] = __builtin_amdgcn_cvt_pk_f32_fp8((int)q.y, true) * c2 + o[3];
  o[4] = __builtin_amdgcn_cvt_pk_f32_fp8((int)q.z, false) * c2 + o[4];
  o[5] = __builtin_amdgcn_cvt_pk_f32_fp8((int)q.z, true) * c2 + o[5];
  o[6] = __builtin_amdgcn_cvt_pk_f32_fp8((int)q.w, false) * c2 + o[6];
  o[7] = __builtin_amdgcn_cvt_pk_f32_fp8((int)q.w, true) * c2 + o[7];
}
struct __attribute__((packed, aligned(8))) U4a8 { unsigned a, b, c, d; };
DI v6u load6(const unsigned char* p) { const U4a8 a = *(const U4a8*)p; const uint2 c = *(const uint2*)(p + 16); v6u q; q[0] = a.a; q[1] = a.b; q[2] = a.c; q[3] = a.d; q[4] = c.x; q[5] = c.y; return q; }
DI void phase_peer_out(const Params& p, char* lds) {
  char* ws = p.ws;
  const int tid = otid(), lane = tid & 63, wave = tid >> 6, hb = lane >> 5, l5 = lane & 31;
  int* sidx = (int*)lds + wave * 384; float* sw = (float*)(sidx + 128);
  const u16* H = (const u16*)(ws + OFF_H); const unsigned* TV = (const unsigned*)(ws + OFF_TOPV);
  const unsigned char* U6 = (const unsigned char*)(ws + OFF_U8) + 24 * l5; const unsigned char* V6 = (const unsigned char*)(ws + OFF_V8) + 24 * l5;
  const float* USC = (const float*)(ws + OFF_USC); const float* VSC = (const float*)(ws + OFF_VSC);
  const float* g3 = p.in[23]; const float* b3 = p.in[24];
  int ci = 0, cj = 0; const bool cval = lane < 50;
  if (cval) { int rem = lane, i = 0; while (true) { const int cnt = 16 / (i + 1); if (rem < cnt) break; rem -= cnt; ++i; } ci = i; cj = rem; }
  const int flat = ci * 16 + cj;
  for (int t = blockIdx.x * 8 + wave; t < T_TOK; t += gridDim.x * 8) {
    f32x2 x2[16];
#pragma unroll
    for (int i = 0; i < 4; ++i) {
      const uint4 hv = *(const uint4*)(H + (size_t)t * 1024 + 32 * l5 + 8 * i);
      x2[4 * i] = f32x2{bflo(hv.x), bfhi(hv.x)}; x2[4 * i + 1] = f32x2{bflo(hv.y), bfhi(hv.y)}; x2[4 * i + 2] = f32x2{bflo(hv.z), bfhi(hv.z)}; x2[4 * i + 3] = f32x2{bflo(hv.w), bfhi(hv.w)};
    }
    float hval[8]; int hidx[8];
#pragma unroll
    for (int hq = 0; hq < 8; ++hq) {
      const unsigned ka = TV[(size_t)t * 256 + (2 * hq) * 16 + ci], kb = TV[(size_t)t * 256 + (2 * hq + 1) * 16 + cj];
      const float va = __uint_as_float(ka & 0xFFFFFF80u), vb = __uint_as_float(kb & 0xFFFFFF80u);
      const int ia = 127 - (int)(ka & 127u), ib = 127 - (int)(kb & 127u);
      hval[hq] = cval ? va + vb : -INFINITY; hidx[hq] = ia * 128 + ib;
    }
#pragma unroll
    for (int hq = 0; hq < 8; ++hq) {
      const float val = hval[hq];
      int rank = 0;
      rank_steps10<0>(val, flat, rank); rank_steps10<10>(val, flat, rank); rank_steps10<20>(val, flat, rank); rank_steps10<30>(val, flat, rank); rank_steps10<40>(val, flat, rank);
      if (cval && rank < 16) { sidx[hq * 16 + rank] = hidx[hq]; sw[hq * 16 + rank] = val; }
    }
    int el[2]; float gl[2];
#pragma unroll
    for (int grp = 0; grp < 2; ++grp) {
      el[grp] = sidx[grp * 64 + lane];
      const float sc = sw[grp * 64 + lane];
      float mx = sc; for (int o = 8; o; o >>= 1) mx = fmaxf(mx, __shfl_xor(mx, o));
      const float e = __expf(sc - mx);
      float sm = e; for (int o = 8; o; o >>= 1) sm += __shfl_xor(sm, o);
      gl[grp] = e * __builtin_amdgcn_rcpf(sm);
    }
#pragma unroll
    for (int hf = 0; hf < 2; ++hf) {
      float pd[32];
#pragma unroll
      for (int kb = 0; kb < 4; ++kb) {
        v6u qb[8];
#pragma unroll
        for (int k = 0; k < 8; ++k) {
          const int e0 = __builtin_amdgcn_readlane(el[0], hf * 32 + kb * 8 + k), e1 = __builtin_amdgcn_readlane(el[1], hf * 32 + kb * 8 + k);
          qb[k] = load6(U6 + (size_t)(hb ? e1 : e0) * 768);
        }
#pragma unroll
        for (int k = 0; k < 8; ++k) {
          const v32f f = __builtin_amdgcn_cvt_scalef32_pk32_f32_fp6(qb[k], 1.0f);
          f32x2 a = f32x2{f[0], f[1]} * x2[0];
#pragma unroll
          for (int i = 1; i < 16; ++i) a = f32x2{f[2 * i], f[2 * i + 1]} * x2[i] + a;
          pd[kb * 8 + k] = a.x + a.y;
        }
      }
#pragma unroll
      for (int off = 16; off >= 1; off >>= 1) {
        const bool up = (lane & off) != 0;
#pragma unroll
        for (int i = 0; i < off; ++i) {
          const float send = up ? pd[i] : pd[i + off];
          const float keep = up ? pd[i + off] : pd[i];
          pd[i] = keep + __shfl_xor(send, off);
        }
      }
      sw[hb * 64 + hf * 32 + l5] = pd[0];
    }
    float coefv[2];
#pragma unroll
    for (int grp = 0; grp < 2; ++grp) {
      const float dt = sw[grp * 64 + lane] * USC[el[grp]];
      const float ge = 0.5f * dt * (1.f + erff(dt * 0.7071067811865476f));
      coefv[grp] = gl[grp] * ge * VSC[el[grp]];
    }
    f32x2 o2[16];
#pragma unroll
    for (int i = 0; i < 16; ++i) o2[i] = f32x2{0.f, 0.f};
#pragma unroll
    for (int kb = 0; kb < 8; ++kb) {
      v6u qb[8];
#pragma unroll
      for (int k = 0; k < 8; ++k) {
        const int e0 = __builtin_amdgcn_readlane(el[0], kb * 8 + k), e1 = __builtin_amdgcn_readlane(el[1], kb * 8 + k);
        qb[k] = load6(V6 + (size_t)(hb ? e1 : e0) * 768);
      }
#pragma unroll
      for (int k = 0; k < 8; ++k) {
        const float c0 = __uint_as_float(__builtin_amdgcn_readlane(__float_as_uint(coefv[0]), kb * 8 + k)), c1 = __uint_as_float(__builtin_amdgcn_readlane(__float_as_uint(coefv[1]), kb * 8 + k));
        const float cf = hb ? c1 : c0;
        const f32x2 c2 = {cf, cf};
        const v32f f = __builtin_amdgcn_cvt_scalef32_pk32_f32_fp6(qb[k], 1.0f);
#pragma unroll
        for (int i = 0; i < 16; ++i) o2[i] = f32x2{f[2 * i], f[2 * i + 1]} * c2 + o2[i];
      }
    }
    float s = 0.f;
#pragma unroll
    for (int i = 0; i < 16; ++i) {
      o2[i].x += __shfl_xor(o2[i].x, 32); o2[i].y += __shfl_xor(o2[i].y, 32);
      o2[i] = x2[i] * f32x2{ALPHA, ALPHA} + o2[i]; s += o2[i].x + o2[i].y;
    }
    for (int o = 16; o; o >>= 1) s += __shfl_xor(s, o);
    const float mu = s * (1.f / 1024.f);
    float q = 0.f;
#pragma unroll
    for (int i = 0; i < 16; ++i) { const float a = o2[i].x - mu, bq = o2[i].y - mu; q += a * a + bq * bq; }
    for (int o = 16; o; o >>= 1) q += __shfl_xor(q, o);
    const float rstd = rsqrtf(q * (1.f / 1024.f) + LN_EPS);
    float* orow = p.out + (size_t)t * 1024 + 32 * l5 + 16 * hb;
#pragma unroll
    for (int q4 = 0; q4 < 4; ++q4) {
      const float4 gg = *(const float4*)(g3 + 32 * l5 + 16 * hb + 4 * q4), bb = *(const float4*)(b3 + 32 * l5 + 16 * hb + 4 * q4);
      const f32x2 a0 = hb ? o2[8 + 2 * q4] : o2[2 * q4], a1 = hb ? o2[8 + 2 * q4 + 1] : o2[2 * q4 + 1];
      float4 o;
      o.x = (a0.x - mu) * rstd * gg.x + bb.x; o.y = (a0.y - mu) * rstd * gg.y + bb.y;
      o.z = (a1.x - mu) * rstd * gg.z + bb.z; o.w = (a1.y - mu) * rstd * gg.w + bb.w;
      *(float4*)(orow + 4 * q4) = o;
    }
  }
}

#define XB_TMO      128
#define XB_XCNT(j)  (256  + 64 * (j))
#define XB_XSUB(j)  (1280 + 64 * (j))
#define XB_XGEN(j)  (2304 + 64 * (j))
#define XB_TOP      3328
#define XB_TOPGEN   3392
#define XCD_BAR_WORDS 3456
#define XB_SPIN_CAP (1u << 18)
#define LAS __attribute__((address_space(3)))
DI unsigned xb_ld(unsigned* p)              { return __hip_atomic_load(p, __ATOMIC_RELAXED, __HIP_MEMORY_SCOPE_AGENT); }
DI unsigned xb_add(unsigned* p, unsigned v) { return __hip_atomic_fetch_add(p, v, __ATOMIC_RELAXED, __HIP_MEMORY_SCOPE_AGENT); }
DI unsigned xb_xcc_id() { return (unsigned)__builtin_amdgcn_s_getreg((3 << 11) | 20) & 0xFu; }
#define XB_SPIN(cond, bar) do { unsigned _sp = 0; while (cond) { __builtin_amdgcn_s_sleep(1); \
    if ((++_sp & 255u) == 0u) { if (xb_ld(&(bar)[XB_TMO])) break; if (_sp > XB_SPIN_CAP) { atomicAdd(&(bar)[XB_TMO], 1u); break; } } } } while (0)
struct XcdBarrier { unsigned* bar; unsigned x; volatile LAS unsigned* st; };
DI XcdBarrier xcd_barrier_post(unsigned* bar, volatile LAS unsigned* st) {
  XcdBarrier b; b.bar = bar; b.x = xb_xcc_id(); b.st = st;
  if (threadIdx.x == 0) (void)xb_add(&bar[XB_XCNT(b.x)], 1u);
  return b;
}
DI void xcd_barrier_complete(unsigned* bar, unsigned x, unsigned& nloc, unsigned& nx) {
  const unsigned G = gridDim.x * gridDim.y * gridDim.z;
  unsigned sum, cnt, mine, sp = 0u;
  for (;;) {
    sum = 0u; cnt = 0u; mine = 0u;
#pragma unroll
    for (unsigned j = 0; j < 16; ++j) { const unsigned c = xb_ld(&bar[XB_XCNT(j)]); sum += c; cnt += (c > 0u) ? 1u : 0u; mine = (j == x) ? c : mine; }
    if (sum == G) break;
    __builtin_amdgcn_s_sleep(1);
    if ((++sp & 255u) == 0u) { if (xb_ld(&bar[XB_TMO])) break; if (sp > XB_SPIN_CAP) { atomicAdd(&bar[XB_TMO], 1u); break; } }
  }
  nloc = mine > 0u ? mine : 1u; nx = cnt > 0u ? cnt : 1u;
}
DI void xcd_barrier(const XcdBarrier& b) {
  asm volatile("s_waitcnt vmcnt(0)" ::: "memory");
  __syncthreads();
  if (threadIdx.x == 0) {
    unsigned* bar = b.bar;
    __builtin_amdgcn_s_waitcnt(0);
    unsigned nloc = b.st[0], nx = b.st[1];
    if (nloc == 0u) { xcd_barrier_complete(bar, b.x, nloc, nx); b.st[0] = nloc; b.st[1] = nx; }
    const unsigned old = xb_add(&bar[XB_XSUB(b.x)], 1u);
    const unsigned gen = old / nloc;
    if (old + 1u == (gen + 1u) * nloc) {
      __builtin_amdgcn_fence(__ATOMIC_RELEASE, "agent");
      asm volatile("s_waitcnt vmcnt(0)" ::: "memory");
      const unsigned og = xb_add(&bar[XB_TOP], 1u);
      const unsigned tg = og / nx;
      if (og + 1u == (tg + 1u) * nx) xb_add(&bar[XB_TOPGEN], 1u);
      else XB_SPIN(xb_ld(&bar[XB_TOPGEN]) == tg, bar);
      __builtin_amdgcn_fence(__ATOMIC_ACQUIRE, "agent");
      xb_add(&bar[XB_XGEN(b.x)], 1u);
      asm volatile("s_waitcnt vmcnt(0)" ::: "memory");
    } else {
      XB_SPIN(xb_ld(&bar[XB_XGEN(b.x)]) == gen, bar);
      __builtin_amdgcn_fence(__ATOMIC_ACQUIRE, "agent");
      asm volatile("s_waitcnt vmcnt(0)" ::: "memory");
    }
  }
  __syncthreads();
}

__global__ void __launch_bounds__(512) mega(Params p) {
  extern __shared__ __attribute__((aligned(16))) char lds[];
  cg::grid_group grid = cg::this_grid();
  char* ws = p.ws;
  u16* H = (u16*)(ws + OFF_H);
  u16* Zb = (u16*)(ws + OFF_Z);
  unsigned* barw = (unsigned*)(ws + OFF_BAR);
  volatile LAS unsigned* xst = (volatile LAS unsigned*)(LAS unsigned*)(lds + LDS_BYTES - 16);
  if (blockIdx.x == 0) for (int i = threadIdx.x; i < XCD_BAR_WORDS; i += 512) barw[i] = 0u;
  if (threadIdx.x == 0) { xst[0] = 0u; xst[1] = 0u; }
  for (int rep = 0; rep < 1 + ((PROBE_MASK >> 0) & 1); ++rep) {
    transpose_w(p.in[4], (u16*)(ws + OFF_WIN), 3592, 3584, (float*)lds);
    transpose_w(p.in[11], (u16*)(ws + OFF_WOUT), 1024, 1024, (float*)lds);
    transpose_w(p.in[14], (u16*)(ws + OFF_WQ), 1024, 1024, (float*)lds);
    transpose_w(p.in[15], (u16*)(ws + OFF_WKV), 2048, 2048, (float*)lds);
    transpose_w(p.in[16], (u16*)(ws + OFF_WO), 1024, 1024, (float*)lds);
    transpose_w(p.in[19], (u16*)(ws + OFF_WPQ), 2048, 2048, (float*)lds);
    convert_fp6_rows(p.in[21], (unsigned char*)(ws + OFF_U8), (float*)(ws + OFF_USC));
    convert_fp6_rows(p.in[22], (unsigned char*)(ws + OFF_V8), (float*)(ws + OFF_VSC));
    convert_bf16(p.in[20], (u16*)(ws + OFF_SK), (size_t)2 * 128 * 128 / 4);
    convert_bf16(p.in[1], (u16*)(ws + OFF_MEMB), (size_t)2048 * 1024 / 4);
    ln_in_rows(p.in[0], p.in[2], p.in[3], p.in[4], H, (float*)(ws + OFF_G), (float*)lds);
  }
  grid.sync();
  const XcdBarrier xb = xcd_barrier_post(barw, xst);
  if (PROBE_MASK & 0x10000) { for (int i = 0; i < 16; ++i) xcd_barrier(xb); }
  if ((PHASE_EN >> 1) & 1)
    { phase_inproj(p, lds); xcd_barrier(xb); }
  if ((PROBE_MASK >> 1) & 1) { phase_inproj(p, lds); xcd_barrier(xb); }
  if ((PHASE_EN >> 2) & 1)
    { phase_mixA(p, lds); xcd_barrier(xb); }
  if ((PROBE_MASK >> 2) & 1) { phase_mixA(p, lds); xcd_barrier(xb); }
  if ((PROBE_MASK >> 13) & 1) { for (int it = blockIdx.x; it < 4096; it += gridDim.x) mlstmA_item(p, lds, it); xcd_barrier(xb); }
  if ((PROBE_MASK >> 14) & 1) { for (int it = blockIdx.x; it < 2048; it += gridDim.x) attn_item(p, lds, it); xcd_barrier(xb); }
  if ((PHASE_EN >> 11) & 1)
    { phase_mlstm_scan(p); xcd_barrier(xb); }
  if ((PHASE_EN >> 12) & 1)
    { phase_mixC(p, lds); xcd_barrier(xb); }
  if ((PROBE_MASK >> 12) & 1) { phase_mixC(p, lds); xcd_barrier(xb); }
  if ((PHASE_EN >> 3) & 1)
    { phase_gemm1024<1>((const u16*)(ws + OFF_MIX), (const u16*)(ws + OFF_WOUT), Zb, H, lds); xcd_barrier(xb); }
  if ((PROBE_MASK >> 3) & 1) { phase_gemm1024<1>((const u16*)(ws + OFF_MIX), (const u16*)(ws + OFF_WOUT), Zb, H, lds); xcd_barrier(xb); }
  { ln_rows_b(Zb, p.in[12], p.in[13], H); xcd_barrier(xb); }
  if ((PROBE_MASK >> 4) & 1) { ln_rows_b(Zb, p.in[12], p.in[13], H); xcd_barrier(xb); }
  if ((PHASE_EN >> 5) & 1)
    { phase_gemm1024<0>(H, (const u16*)(ws + OFF_WQ), (u16*)(ws + OFF_XQ), nullptr, lds); xcd_barrier(xb); }
  if ((PROBE_MASK >> 5) & 1) { phase_gemm1024<0>(H, (const u16*)(ws + OFF_WQ), (u16*)(ws + OFF_XQ), nullptr, lds); xcd_barrier(xb); }
  if ((PHASE_EN >> 6) & 1)
    { phase_xattn(p, lds); xcd_barrier(xb); }
  if ((PROBE_MASK >> 6) & 1) { phase_xattn(p, lds); xcd_barrier(xb); }
  if ((PHASE_EN >> 7) & 1)
    { phase_gemm1024<1>((const u16*)(ws + OFF_XO), (const u16*)(ws + OFF_WO), Zb, H, lds); xcd_barrier(xb); }
  if ((PROBE_MASK >> 7) & 1) { phase_gemm1024<1>((const u16*)(ws + OFF_XO), (const u16*)(ws + OFF_WO), Zb, H, lds); xcd_barrier(xb); }
  { ln_rows_b(Zb, p.in[17], p.in[18], H); xcd_barrier(xb); }
  if ((PROBE_MASK >> 8) & 1) { ln_rows_b(Zb, p.in[17], p.in[18], H); xcd_barrier(xb); }
  if ((PHASE_EN >> 9) & 1)
    { phase_peer_query(p, lds); xcd_barrier(xb); }
  if ((PROBE_MASK >> 9) & 1) { phase_peer_query(p, lds); xcd_barrier(xb); }
  if ((PHASE_EN >> 10) & 1)
    { phase_peer_out(p, lds); }
  if ((PROBE_MASK >> 10) & 1) { phase_peer_out(p, lds); }
}

extern "C" void kernel_launch(void* const* d_in, const int* in_sizes, int n_in, void* d_out, int out_size, void* d_ws, size_t ws_size, hipStream_t stream) {
  static int grid_blocks = 0;
  if (grid_blocks == 0) {
    if (n_in != 25 || out_size != T_TOK * 1024 || ws_size < WS_NEED) { fprintf(stderr, "kernel_launch: unexpected shapes (n_in %d out %d ws %zu)\n", n_in, out_size, ws_size); grid_blocks = -1; return; }
    int dev = 0, cus = 0, per_cu = 0;
    hipGetDevice(&dev);
    hipDeviceGetAttribute(&cus, hipDeviceAttributeMultiprocessorCount, dev);
    if (hipFuncSetAttribute((const void*)mega, hipFuncAttributeMaxDynamicSharedMemorySize, LDS_BYTES) != hipSuccess) { fprintf(stderr, "hipFuncSetAttribute failed\n"); grid_blocks = -1; return; }
    hipOccupancyMaxActiveBlocksPerMultiprocessor(&per_cu, (const void*)mega, 512, LDS_BYTES);
    if (per_cu < 1) { fprintf(stderr, "occupancy query returned %d\n", per_cu); per_cu = 1; }
    grid_blocks = cus * per_cu;
  }
  if (grid_blocks < 0) return;
  Params p{};
  for (int i = 0; i < 25; ++i) p.in[i] = (const float*)d_in[i];
  p.out = (float*)d_out; p.ws = (char*)d_ws;
  void* args[] = {&p};
  hipError_t e = hipLaunchCooperativeKernel((const void*)mega, dim3(grid_blocks), dim3(512), args, LDS_BYTES, stream);
  if (e != hipSuccess) fprintf(stderr, "cooperative launch failed: %s (grid %d)\n", hipGetErrorString(e), grid_blocks);
}
```

```cpp
#include <hip/hip_runtime.h>
#include <hip/hip_cooperative_groups.h>
#include <cstdio>
namespace cg = cooperative_groups;

#ifndef PHASE_EN
#define PHASE_EN 0xFFFF
#endif
#ifndef PROBE_MASK
#define PROBE_MASK 0
#endif
#ifndef STAGE_MASK
#define STAGE_MASK 7
#endif

#define DI __device__ __forceinline__
typedef unsigned short u16;
typedef __attribute__((ext_vector_type(8))) short bf16x8;
typedef __attribute__((ext_vector_type(16))) float f32x16;
typedef __attribute__((ext_vector_type(2))) float f32x2;
#define MFMA(a, b, c) __builtin_amdgcn_mfma_f32_32x32x16_bf16((a), (b), (c), 0, 0, 0)

constexpr int T_TOK = 65536;
constexpr int SEQ = 8192;
constexpr float ALPHA = 1.189207115002721f;
constexpr float LN_EPS = 1e-5f;
constexpr int LDS_BYTES = 143360;
constexpr size_t MB = 1u << 20;
constexpr size_t OFF_WIN = 0, OFF_WOUT = 8 * MB, OFF_WQ = 10 * MB, OFF_WO = 12 * MB, OFF_WKV = 14 * MB, OFF_WPQ = 18 * MB,
                 OFF_SK = 22 * MB, OFF_MEMB = 23 * MB, OFF_KX = 27 * MB, OFF_VTX = 31 * MB, OFF_U8 = 35 * MB, OFF_V8 = 51 * MB, OFF_USC = 67 * MB, OFF_VSC = 68 * MB,
                 OFF_G = 99 * MB, OFF_H = 104 * MB, OFF_PA = 232 * MB, OFF_PM = 360 * MB, OFF_Z = 232 * MB, OFF_VTA = 488 * MB,
                 OFF_VTM = 552 * MB, OFF_XQ = 488 * MB, OFF_PO = 616 * MB, OFF_MIX = 680 * MB, OFF_XO = 680 * MB,
                 OFF_TOPV = 808 * MB, OFF_TOPI = 872 * MB, OFF_KVS = 808 * MB, OFF_KSUM = 936 * MB, OFF_CSC = 938 * MB, OFF_BAR = 939 * MB, WS_NEED = 940 * MB;

struct Params {
  const float* in[25];
  float* out;
  char* ws;
};

DI int otid() { int t = __builtin_amdgcn_workitem_id_x(); asm volatile("" : "+v"(t)); return t; }
typedef __bf16 bf16v2 __attribute__((ext_vector_type(2)));
DI unsigned pack2(float a, float b) { const f32x2 v = {a, b}; return __builtin_bit_cast(unsigned, __builtin_convertvector(v, bf16v2)); }
DI u16 f2bf(float x) { return (u16)(pack2(x, 0.f) & 0xffffu); }
DI float bf2f(u16 h) { return __uint_as_float(((unsigned)h) << 16); }
DI float bflo(unsigned w) { return __uint_as_float(w << 16); }
DI float bfhi(unsigned w) { return __uint_as_float(w & 0xffff0000u); }
DI float wsum(float v) { for (int o = 32; o; o >>= 1) v += __shfl_xor(v, o); return v; }
DI float wmax(float v) { for (int o = 32; o; o >>= 1) v = fmaxf(v, __shfl_xor(v, o)); return v; }
DI int perm23(int i) { return (i & 0x13) | (((i >> 3) & 1) << 2) | (((i >> 2) & 1) << 3); }
DI f32x16 zero16() { f32x16 z; for (int i = 0; i < 16; ++i) z[i] = 0.f; return z; }
DI bf16x8 ldfrag(const u16* p) { return *(const bf16x8*)p; }
DI void unpack8(const uint4& r, float* o) {
  o[0] = bflo(r.x); o[1] = bfhi(r.x); o[2] = bflo(r.y); o[3] = bfhi(r.y); o[4] = bflo(r.z); o[5] = bfhi(r.z); o[6] = bflo(r.w); o[7] = bfhi(r.w);
}

DI void transpose_w(const float* __restrict__ src, u16* __restrict__ dst, int N, int Npad, float* tl) {
  const int ntn = Npad >> 6, ntiles = 16 * ntn;
  for (int t = blockIdx.x; t < ntiles; t += gridDim.x) {
    const int kt = t / ntn, nt = t - kt * ntn, k0 = kt * 64, n0 = nt * 64;
    for (int e = otid(); e < 4096; e += 512) { int r = e >> 6, c = e & 63, n = n0 + c; tl[r * 65 + c] = (n < N) ? src[(size_t)(k0 + r) * N + n] : 0.f; }
    __syncthreads();
    for (int e = otid(); e < 4096; e += 512) { int r = e >> 6, c = e & 63; dst[(size_t)(n0 + r) * 1024 + k0 + c] = f2bf(tl[c * 65 + r]); }
    __syncthreads();
  }
}
DI void convert_bf16(const float* __restrict__ src, u16* __restrict__ dst, size_t n4) {
  const size_t stride = (size_t)gridDim.x * 512;
  for (size_t i = (size_t)blockIdx.x * 512 + otid(); i < n4; i += stride) {
    float4 v = ((const float4*)src)[i];
    uint2 o; o.x = pack2(v.x, v.y); o.y = pack2(v.z, v.w);
    ((uint2*)dst)[i] = o;
  }
}

DI void convert_fp8_rows(const float* __restrict__ src, unsigned char* __restrict__ dst, float* __restrict__ invscale) {
  const int lane = otid() & 63, wave = otid() >> 6;
  for (int row = blockIdx.x * 8 + wave; row < 16384; row += gridDim.x * 8) {
    const float* r = src + (size_t)row * 1024 + 16 * lane;
    float4 v[4];
    float am = 0.f;
    for (int i = 0; i < 4; ++i) { v[i] = *(const float4*)(r + 4 * i); am = fmaxf(am, fmaxf(fmaxf(fabsf(v[i].x), fabsf(v[i].y)), fmaxf(fabsf(v[i].z), fabsf(v[i].w)))); }
    am = wmax(am);
    const float sc = am > 0.f ? 256.f / am : 1.f;
    uint4 o; unsigned w[4];
    for (int i = 0; i < 4; ++i) { int t = 0; t = __builtin_amdgcn_cvt_pk_fp8_f32(v[i].x * sc, v[i].y * sc, t, false); t = __builtin_amdgcn_cvt_pk_fp8_f32(v[i].z * sc, v[i].w * sc, t, true); w[i] = (unsigned)t; }
    o.x = w[0]; o.y = w[1]; o.z = w[2]; o.w = w[3];
    *(uint4*)(dst + (size_t)row * 1024 + 16 * lane) = o;
    if (lane == 0) invscale[row] = am > 0.f ? am * (1.f / 256.f) : 1.f;
  }
}
typedef __attribute__((ext_vector_type(6))) unsigned v6u;
typedef __attribute__((ext_vector_type(16))) float v16f;
typedef __attribute__((ext_vector_type(32))) float v32f;
DI void convert_fp6_rows(const float* __restrict__ src, unsigned char* __restrict__ dst, float* __restrict__ invscale) {
  const int lane = otid() & 63, wave = otid() >> 6, hb = lane >> 5, l5 = lane & 31;
  for (int row = (blockIdx.x * 8 + wave) * 2 + hb; row < 16384; row += gridDim.x * 16) {
    const float* r = src + (size_t)row * 1024 + 32 * l5;
    v16f x, y;
    float am = 0.f;
#pragma unroll
    for (int i = 0; i < 4; ++i) {
      const float4 a = *(const float4*)(r + 4 * i), b = *(const float4*)(r + 16 + 4 * i);
      x[2 * i] = a.x; y[2 * i] = a.y; x[2 * i + 1] = a.z; y[2 * i + 1] = a.w; x[8 + 2 * i] = b.x; y[8 + 2 * i] = b.y; x[8 + 2 * i + 1] = b.z; y[8 + 2 * i + 1] = b.w;
      am = fmaxf(am, fmaxf(fmaxf(fabsf(a.x), fabsf(a.y)), fmaxf(fabsf(a.z), fabsf(a.w))));
      am = fmaxf(am, fmaxf(fmaxf(fabsf(b.x), fabsf(b.y)), fmaxf(fabsf(b.z), fabsf(b.w))));
    }
    for (int o = 16; o; o >>= 1) am = fmaxf(am, __shfl_xor(am, o));
    const float sc = am > 0.f ? 7.0f / am : 1.f;
#pragma unroll
    for (int i = 0; i < 16; ++i) { x[i] *= sc; y[i] *= sc; }
    const v6u q = __builtin_amdgcn_cvt_scalef32_2xpk16_fp6_f32(x, y, 1.0f);
    unsigned* d = (unsigned*)(dst + (size_t)row * 768 + 24 * l5);
    *(uint2*)d = make_uint2(q[0], q[1]); *(uint2*)(d + 2) = make_uint2(q[2], q[3]); *(uint2*)(d + 4) = make_uint2(q[4], q[5]);
    if (l5 == 0) invscale[row] = am > 0.f ? am * (1.f / 7.0f) : 1.f;
  }
}

DI void ln_rows(const float* __restrict__ src, const float* __restrict__ g, const float* __restrict__ bta, u16* __restrict__ dst) {
  const int lane = otid() & 63, wave = otid() >> 6;
  for (int row = blockIdx.x * 8 + wave; row < T_TOK; row += gridDim.x * 8) {
    float4 v[4];
    float s = 0.f;
    for (int i = 0; i < 4; ++i) { v[i] = *(const float4*)(src + (size_t)row * 1024 + i * 256 + lane * 4); s += v[i].x + v[i].y + v[i].z + v[i].w; }
    const float mu = wsum(s) * (1.f / 1024.f);
    float q = 0.f;
    for (int i = 0; i < 4; ++i) { float a = v[i].x - mu, b = v[i].y - mu, c = v[i].z - mu, d = v[i].w - mu; q += a * a + b * b + c * c + d * d; }
    const float rstd = rsqrtf(wsum(q) * (1.f / 1024.f) + LN_EPS);
    for (int i = 0; i < 4; ++i) {
      const int c0 = i * 256 + lane * 4;
      float4 gg = *(const float4*)(g + c0), bb = *(const float4*)(bta + c0);
      uint2 o;
      o.x = pack2((v[i].x - mu) * rstd * gg.x + bb.x, (v[i].y - mu) * rstd * gg.y + bb.y);
      o.y = pack2((v[i].z - mu) * rstd * gg.z + bb.z, (v[i].w - mu) * rstd * gg.w + bb.w);
      *(uint2*)(dst + (size_t)row * 1024 + c0) = o;
    }
  }
}
DI void ln_rows_b(const u16* __restrict__ Zb, const float* __restrict__ g, const float* __restrict__ bta, u16* __restrict__ H) {
  const int lane = otid() & 63, wave = otid() >> 6;
  float gg[16], bb[16];
  for (int i = 0; i < 4; ++i) {
    const float4 g4 = *(const float4*)(g + lane * 16 + 4 * i), b4 = *(const float4*)(bta + lane * 16 + 4 * i);
    gg[4*i] = g4.x; gg[4*i+1] = g4.y; gg[4*i+2] = g4.z; gg[4*i+3] = g4.w; bb[4*i] = b4.x; bb[4*i+1] = b4.y; bb[4*i+2] = b4.z; bb[4*i+3] = b4.w;
  }
  const int stride = gridDim.x * 8;
  for (int row0 = blockIdx.x * 8 + wave; row0 < T_TOK; row0 += stride * 4) {
    uint4 r[4][2];
#pragma unroll
    for (int j = 0; j < 4; ++j) {
      const int row = row0 + j * stride;
      if (row < T_TOK) { r[j][0] = *(const uint4*)(Zb + (size_t)row * 1024 + lane * 16); r[j][1] = *(const uint4*)(Zb + (size_t)row * 1024 + lane * 16 + 8); }
    }
#pragma unroll
    for (int j = 0; j < 4; ++j) {
      const int row = row0 + j * stride;
      if (row < T_TOK) {
        float v[16];
        unpack8(r[j][0], v); unpack8(r[j][1], v + 8);
        float s = 0.f;
#pragma unroll
        for (int i = 0; i < 16; ++i) s += v[i];
        const float mu = wsum(s) * (1.f / 1024.f);
        float q = 0.f;
#pragma unroll
        for (int i = 0; i < 16; ++i) { float a = v[i] - mu; q += a * a; }
        const float rstd = rsqrtf(wsum(q) * (1.f / 1024.f) + LN_EPS);
        uint4 o0, o1;
        o0.x = pack2((v[0] - mu) * rstd * gg[0] + bb[0], (v[1] - mu) * rstd * gg[1] + bb[1]); o0.y = pack2((v[2] - mu) * rstd * gg[2] + bb[2], (v[3] - mu) * rstd * gg[3] + bb[3]);
        o0.z = pack2((v[4] - mu) * rstd * gg[4] + bb[4], (v[5] - mu) * rstd * gg[5] + bb[5]); o0.w = pack2((v[6] - mu) * rstd * gg[6] + bb[6], (v[7] - mu) * rstd * gg[7] + bb[7]);
        o1.x = pack2((v[8] - mu) * rstd * gg[8] + bb[8], (v[9] - mu) * rstd * gg[9] + bb[9]); o1.y = pack2((v[10] - mu) * rstd * gg[10] + bb[10], (v[11] - mu) * rstd * gg[11] + bb[11]);
        o1.z = pack2((v[12] - mu) * rstd * gg[12] + bb[12], (v[13] - mu) * rstd * gg[13] + bb[13]); o1.w = pack2((v[14] - mu) * rstd * gg[14] + bb[14], (v[15] - mu) * rstd * gg[15] + bb[15]);
        *(uint4*)(H + (size_t)row * 1024 + lane * 16) = o0;
        *(uint4*)(H + (size_t)row * 1024 + lane * 16 + 8) = o1;
      }
    }
  }
}
DI void ln_in_rows(const float* __restrict__ src, const float* __restrict__ g, const float* __restrict__ bta, const float* __restrict__ w_in, u16* __restrict__ dst, float* __restrict__ G, float* Wg) {
  const int lane = otid() & 63, wave = otid() >> 6;
  for (int e = otid(); e < 8192; e += 512) Wg[e] = w_in[(size_t)(e >> 3) * 3592 + 3584 + (e & 7)];
  __syncthreads();
  float4 nv[4];
  { const int row = blockIdx.x * 8 + wave; for (int i = 0; i < 4; ++i) nv[i] = *(const float4*)(src + (size_t)row * 1024 + i * 256 + lane * 4); }
  for (int row = blockIdx.x * 8 + wave; row < T_TOK; row += gridDim.x * 8) {
    float4 v[4];
    float s = 0.f;
    for (int i = 0; i < 4; ++i) { v[i] = nv[i]; s += v[i].x + v[i].y + v[i].z + v[i].w; }
    { const int nrow = row + gridDim.x * 8; if (nrow < T_TOK) for (int i = 0; i < 4; ++i) nv[i] = *(const float4*)(src + (size_t)nrow * 1024 + i * 256 + lane * 4); }
    const float mu = wsum(s) * (1.f / 1024.f);
    float q = 0.f;
    for (int i = 0; i < 4; ++i) { float a = v[i].x - mu, b = v[i].y - mu, c = v[i].z - mu, d = v[i].w - mu; q += a * a + b * b + c * c + d * d; }
    const float rstd = rsqrtf(wsum(q) * (1.f / 1024.f) + LN_EPS);
    float pg[8];
#pragma unroll
    for (int j = 0; j < 8; ++j) pg[j] = 0.f;
#pragma unroll
    for (int i = 0; i < 4; ++i) {
      const int c0 = i * 256 + lane * 4;
      float4 gg = *(const float4*)(g + c0), bb = *(const float4*)(bta + c0);
      float y[4];
      y[0] = (v[i].x - mu) * rstd * gg.x + bb.x; y[1] = (v[i].y - mu) * rstd * gg.y + bb.y; y[2] = (v[i].z - mu) * rstd * gg.z + bb.z; y[3] = (v[i].w - mu) * rstd * gg.w + bb.w;
      uint2 o; o.x = pack2(y[0], y[1]); o.y = pack2(y[2], y[3]);
      *(uint2*)(dst + (size_t)row * 1024 + c0) = o;
#pragma unroll
      for (int e = 0; e < 4; ++e) {
        const float4 w0 = *(const float4*)(Wg + (c0 + e) * 8), w1 = *(const float4*)(Wg + (c0 + e) * 8 + 4);
        pg[0] += y[e] * w0.x; pg[1] += y[e] * w0.y; pg[2] += y[e] * w0.z; pg[3] += y[e] * w0.w;
        pg[4] += y[e] * w1.x; pg[5] += y[e] * w1.y; pg[6] += y[e] * w1.z; pg[7] += y[e] * w1.w;
      }
    }
#pragma unroll
    for (int off = 32; off >= 8; off >>= 1) {
      const bool up = (lane & off) != 0;
      const int nkeep = off >> 3;
#pragma unroll
      for (int i = 0; i < 4; ++i) if (i < nkeep) {
        const float send = up ? pg[i] : pg[i + nkeep];
        const float keep = up ? pg[i + nkeep] : pg[i];
        pg[i] = keep + __shfl_xor(send, off);
      }
    }
    float tot = pg[0];
    tot += __shfl_xor(tot, 4); tot += __shfl_xor(tot, 2); tot += __shfl_xor(tot, 1);
    if ((lane & 7) == 0) G[(size_t)row * 8 + (lane >> 3)] = tot;
  }
}

typedef __attribute__((ext_vector_type(4))) float f32x4;
#define MFMA16(a, b, c) __builtin_amdgcn_mfma_f32_16x16x32_bf16((a), (b), (c), 0, 0, 0)
DI uint2 pack4(const f32x16& a, int g) { uint2 o; o.x = pack2(a[4 * g], a[4 * g + 1]); o.y = pack2(a[4 * g + 2], a[4 * g + 3]); return o; }
DI void stage_rc(int b, int& R, int& C) { const int st = b >> 10, sb = b & 1023, swz = sb ^ (((sb >> 9) & 1) << 5); R = (st >> 1) * 16 + (swz >> 6); C = (st & 1) * 32 + ((swz & 63) >> 1); }
constexpr int CT_LD = 264;
template <int SWAP>
DI void gemm256(const u16* __restrict__ Ab, const u16* __restrict__ Bb, const u16* __restrict__ nAb, const u16* __restrict__ nBb, bool first, bool has_next, f32x4 (&acc)[8][4], char* lds) {
  const int tid = otid(), wid = tid >> 6, lane = tid & 63, wr = wid >> 2, wc = wid & 3, fr = lane & 15, fq = lane >> 4;
  int goff[4];
#pragma unroll
  for (int i = 0; i < 4; ++i) { int R, C; stage_rc(wid * 1024 + i * 8192 + lane * 16, R, C); goff[i] = R * 1024 + C; }
#pragma unroll
  for (int m = 0; m < 8; ++m)
#pragma unroll
    for (int n = 0; n < 4; ++n) acc[m][n] = f32x4{0.f, 0.f, 0.f, 0.f};
  const int ob = fr * 64 + fq * 16, obs = ob ^ (((ob >> 9) & 1) << 5);
  const int aoff = wr * 16384 + obs, boff = 32768 + wc * 8192 + obs;
#define GLDS_STAGE(buf, pa, pb, kt) do { _Pragma("unroll") for (int i = 0; i < 4; ++i) { \
    __builtin_amdgcn_global_load_lds((const unsigned*)((pa) + goff[i] + (kt) * 64), (__attribute__((address_space(3))) unsigned*)(lds + (buf) * 65536 + wid * 1024 + i * 8192), 16, 0, 0); \
    __builtin_amdgcn_global_load_lds((const unsigned*)((pb) + goff[i] + (kt) * 64), (__attribute__((address_space(3))) unsigned*)(lds + (buf) * 65536 + 32768 + wid * 1024 + i * 8192), 16, 0, 0); } } while (0)
  if (first) {
    GLDS_STAGE(0, Ab, Bb, 0);
    asm volatile("s_waitcnt vmcnt(0)" ::: "memory");
    __syncthreads();
  }
#pragma unroll 1
  for (int t = 0; t < 16; ++t) {
    const int cur = t & 1;
    if (t < 15) GLDS_STAGE(cur ^ 1, Ab, Bb, t + 1);
    else if (has_next) GLDS_STAGE(0, nAb, nBb, 0);
    const char* sa = lds + cur * 65536 + aoff;
    const char* sb = lds + cur * 65536 + boff;
#pragma unroll
    for (int ks = 0; ks < 2; ++ks) {
      bf16x8 At[8], Bf[4];
#pragma unroll
      for (int m = 0; m < 8; ++m) At[m] = *(const bf16x8*)(sa + m * 2048 + ks * 1024);
#pragma unroll
      for (int n = 0; n < 4; ++n) Bf[n] = *(const bf16x8*)(sb + n * 2048 + ks * 1024);
#pragma unroll
      for (int m = 0; m < 8; ++m)
#pragma unroll
        for (int n = 0; n < 4; ++n) acc[m][n] = SWAP ? MFMA16(Bf[n], At[m], acc[m][n]) : MFMA16(At[m], Bf[n], acc[m][n]);
      __builtin_amdgcn_sched_group_barrier(0x100, 12, 0);
      __builtin_amdgcn_sched_group_barrier(0x008, 32, 0);
      __builtin_amdgcn_sched_barrier(0);
    }
    asm volatile("s_waitcnt vmcnt(0)" ::: "memory");
    __syncthreads();
  }
#undef GLDS_STAGE
}
DI void stage_acc(const f32x4 (&acc)[8][4], u16* Ct) {
  const int tid = otid(), wid = tid >> 6, lane = tid & 63, wr = wid >> 2, wc = wid & 3, fr = lane & 15, fq = lane >> 4;
#pragma unroll
  for (int m = 0; m < 8; ++m)
#pragma unroll
    for (int n = 0; n < 4; ++n) {
      uint2 o; o.x = pack2(acc[m][n][0], acc[m][n][1]); o.y = pack2(acc[m][n][2], acc[m][n][3]);
      *(uint2*)(Ct + (wr * 128 + m * 16 + fr) * CT_LD + wc * 64 + n * 16 + fq * 4) = o;
    }
}
template <int SWAP>
DI void store_acc(const f32x4 (&acc)[8][4], u16* __restrict__ dst, size_t ld) {
  const int tid = otid(), wid = tid >> 6, lane = tid & 63, wr = wid >> 2, wc = wid & 3, fr = lane & 15, fq = lane >> 4;
#pragma unroll
  for (int m = 0; m < 8; ++m)
#pragma unroll
    for (int n = 0; n < 4; ++n) {
      uint2 o; o.x = pack2(acc[m][n][0], acc[m][n][1]); o.y = pack2(acc[m][n][2], acc[m][n][3]);
      if (SWAP) *(uint2*)(dst + (size_t)(wr * 128 + m * 16 + fr) * ld + wc * 64 + n * 16 + fq * 4) = o;
      else *(uint2*)(dst + (size_t)(wc * 64 + n * 16 + fr) * ld + wr * 128 + m * 16 + fq * 4) = o;
    }
}
template <int SWAP, int MODE>
DI void epilogue_staged(const f32x4 (&acc)[8][4], char* lds, u16* __restrict__ dst, size_t ld, const u16* __restrict__ Hres) {
  const int tid = otid(), wid = tid >> 6, lane = tid & 63, wr = wid >> 2, wc = wid & 3, fr = lane & 15, fq = lane >> 4;
  u16* Ct = (u16*)(lds + 65536);
#pragma unroll
  for (int h = 0; h < 2; ++h) {
    if ((SWAP ? wr : (wc >> 1)) == h) {
#pragma unroll
      for (int m = 0; m < 8; ++m)
#pragma unroll
        for (int n = 0; n < 4; ++n) {
          uint2 o; o.x = pack2(acc[m][n][0], acc[m][n][1]); o.y = pack2(acc[m][n][2], acc[m][n][3]);
          if (SWAP) *(uint2*)(Ct + (m * 16 + fr) * CT_LD + wc * 64 + n * 16 + fq * 4) = o;
          else *(uint2*)(Ct + ((wc & 1) * 64 + n * 16 + fr) * CT_LD + wr * 128 + m * 16 + fq * 4) = o;
        }
    }
    __syncthreads();
#pragma unroll 4
    for (int i = 0; i < 8; ++i) {
      const int q = tid + 512 * i, r = q >> 5, c8 = (q & 31) * 8;
      uint4 v = *(const uint4*)(Ct + r * CT_LD + c8);
      const size_t o = (size_t)(h * 128 + r) * ld + c8;
      if (MODE == 1) {
        const uint4 hv = *(const uint4*)(Hres + o);
        float y[8], hx[8]; unpack8(v, y); unpack8(hv, hx);
        v.x = pack2(ALPHA * hx[0] + y[0], ALPHA * hx[1] + y[1]); v.y = pack2(ALPHA * hx[2] + y[2], ALPHA * hx[3] + y[3]);
        v.z = pack2(ALPHA * hx[4] + y[4], ALPHA * hx[5] + y[5]); v.w = pack2(ALPHA * hx[6] + y[6], ALPHA * hx[7] + y[7]);
      }
      *(uint4*)(dst + o) = v;
    }
    __syncthreads();
  }
}
DI int lds_byte8(int r, int c) { const int st = (r >> 4) * 2 + (c >> 5), ob = (r & 15) * 64 + (c & 31) * 2; return st * 1024 + (ob ^ (((ob >> 9) & 1) << 5)); }
template <int SWAP>
DI void gemm8p(const u16* __restrict__ Ab, const u16* __restrict__ Bb, f32x4 (&acc)[2][2][4][2], char* lds) {
  constexpr int K = 1024, BK = 64, HALF = 128, HTB = 128 * 64 * 2;
  const int tid = otid(), wid = tid >> 6, lane = tid & 63, wr = wid >> 2, wc = wid & 3, fr = lane & 15, fq = lane >> 4;
  int goff0;
  { int R, C; stage_rc(tid * 16, R, C); goff0 = R * K + C; }
#define SA8(b, h) (lds + ((b) * 2 + (h)) * HTB)
#define SB8(b, h) (lds + (4 + (b) * 2 + (h)) * HTB)
#define STAGE8(P, BASE, br, kt) do { _Pragma("unroll") for (int _i = 0; _i < 2; ++_i) \
    __builtin_amdgcn_global_load_lds((const unsigned*)((BASE) + (size_t)((br) + 64 * _i) * K + (kt) * BK + goff0), (__attribute__((address_space(3))) unsigned*)((P) + wid * 1024 + _i * 8192), 16, 0, 0); } while (0)
#define LDA8(dst, b, h) _Pragma("unroll") for (int m = 0; m < 4; ++m) _Pragma("unroll") for (int k = 0; k < 2; ++k) \
    dst[m][k] = *(const bf16x8*)(SA8(b, h) + lds_byte8(wr * 64 + m * 16 + fr, k * 32 + fq * 8))
#define LDB8(dst, b, h) _Pragma("unroll") for (int n = 0; n < 2; ++n) _Pragma("unroll") for (int k = 0; k < 2; ++k) \
    dst[n][k] = *(const bf16x8*)(SB8(b, h) + lds_byte8(wc * 32 + n * 16 + fr, k * 32 + fq * 8))
#define MMA8(ai, bj, At_, Bt_) do { __builtin_amdgcn_s_setprio(1); \
    _Pragma("unroll") for (int m = 0; m < 4; ++m) _Pragma("unroll") for (int n = 0; n < 2; ++n) _Pragma("unroll") for (int k = 0; k < 2; ++k) \
      acc[ai][bj][m][n] = SWAP ? MFMA16(Bt_[n][k], At_[m][k], acc[ai][bj][m][n]) : MFMA16(At_[m][k], Bt_[n][k], acc[ai][bj][m][n]); \
    __builtin_amdgcn_s_setprio(0); } while (0)
#define WAIT_V(n) asm volatile("s_waitcnt vmcnt(" #n ")" ::: "memory")
#define WAIT_L(n) asm volatile("s_waitcnt lgkmcnt(" #n ")" ::: "memory")
#define BAR8 __builtin_amdgcn_s_barrier()
#define SCHED8 __builtin_amdgcn_sched_barrier(0)
#pragma unroll
  for (int ai = 0; ai < 2; ++ai)
#pragma unroll
    for (int bj = 0; bj < 2; ++bj)
#pragma unroll
      for (int m = 0; m < 4; ++m)
#pragma unroll
        for (int n = 0; n < 2; ++n) acc[ai][bj][m][n] = f32x4{0.f, 0.f, 0.f, 0.f};
  bf16x8 At[4][2], B0[2][2], B1[2][2];
  constexpr int nt = K / BK;
  STAGE8(SB8(0, 0), Bb, 0, 0); STAGE8(SA8(0, 0), Ab, 0, 0);
  STAGE8(SB8(0, 1), Bb, HALF, 0); STAGE8(SA8(0, 1), Ab, HALF, 0);
  if (wr == 1) BAR8;
  WAIT_V(4); BAR8;
  STAGE8(SB8(1, 0), Bb, 0, 1); STAGE8(SA8(1, 0), Ab, 0, 1); STAGE8(SB8(1, 1), Bb, HALF, 1);
  WAIT_V(6); BAR8;
#pragma unroll 1
  for (int t = 0; t < nt - 2; t += 2) {
    LDB8(B0, 0, 0); SCHED8; LDA8(At, 0, 0); STAGE8(SA8(1, 1), Ab, HALF, t + 1);
    WAIT_L(8); BAR8; WAIT_L(0); MMA8(0, 0, At, B0); BAR8; SCHED8;
    LDB8(B1, 0, 1); STAGE8(SB8(0, 0), Bb, 0, t + 2);
    BAR8; WAIT_L(0); MMA8(0, 1, At, B1); BAR8;
    LDA8(At, 0, 1); STAGE8(SA8(0, 0), Ab, 0, t + 2);
    BAR8; WAIT_L(0); MMA8(1, 0, At, B0); BAR8; SCHED8;
    STAGE8(SB8(0, 1), Bb, HALF, t + 2);
    WAIT_V(6); BAR8; MMA8(1, 1, At, B1); BAR8;
    LDB8(B0, 1, 0); SCHED8; LDA8(At, 1, 0); STAGE8(SA8(0, 1), Ab, HALF, t + 2);
    WAIT_L(8); BAR8; WAIT_L(0); MMA8(0, 0, At, B0); BAR8; SCHED8;
    LDB8(B1, 1, 1); STAGE8(SB8(1, 0), Bb, 0, t + 3);
    BAR8; WAIT_L(0); MMA8(0, 1, At, B1); BAR8;
    LDA8(At, 1, 1); STAGE8(SA8(1, 0), Ab, 0, t + 3);
    BAR8; WAIT_L(0); MMA8(1, 0, At, B0); BAR8; SCHED8;
    STAGE8(SB8(1, 1), Bb, HALF, t + 3);
    WAIT_V(6); BAR8; MMA8(1, 1, At, B1); BAR8;
  }
  { LDB8(B0, 0, 0); LDA8(At, 0, 0); STAGE8(SA8(1, 1), Ab, HALF, nt - 1);
    BAR8; WAIT_L(0); MMA8(0, 0, At, B0); BAR8;
    LDB8(B1, 0, 1); BAR8; WAIT_L(0); MMA8(0, 1, At, B1); BAR8;
    LDA8(At, 0, 1); WAIT_V(4); BAR8; WAIT_L(0); MMA8(1, 0, At, B0); MMA8(1, 1, At, B1); BAR8; }
  { LDB8(B0, 1, 0); LDA8(At, 1, 0); WAIT_V(2); BAR8; WAIT_L(0); MMA8(0, 0, At, B0); BAR8;
    LDB8(B1, 1, 1); WAIT_V(0); BAR8; WAIT_L(0); MMA8(0, 1, At, B1); BAR8;
    LDA8(At, 1, 1); BAR8; WAIT_L(0); MMA8(1, 0, At, B0); MMA8(1, 1, At, B1); BAR8; }
  if (wr == 0) BAR8;
  __syncthreads();
#undef SA8
#undef SB8
#undef STAGE8
#undef LDA8
#undef LDB8
#undef MMA8
#undef WAIT_V
#undef WAIT_L
#undef BAR8
#undef SCHED8
}
template <int SWAP>
DI void stage8(const f32x4 (&acc)[2][2][4][2], u16* Ct) {
  const int tid = otid(), wid = tid >> 6, lane = tid & 63, wr = wid >> 2, wc = wid & 3, fr = lane & 15, fq = lane >> 4;
#pragma unroll
  for (int ai = 0; ai < 2; ++ai)
#pragma unroll
    for (int bj = 0; bj < 2; ++bj)
#pragma unroll
      for (int m = 0; m < 4; ++m)
#pragma unroll
        for (int n = 0; n < 2; ++n) {
          uint2 o; o.x = pack2(acc[ai][bj][m][n][0], acc[ai][bj][m][n][1]); o.y = pack2(acc[ai][bj][m][n][2], acc[ai][bj][m][n][3]);
          if (SWAP) *(uint2*)(Ct + (ai * 128 + wr * 64 + m * 16 + fr) * CT_LD + bj * 128 + wc * 32 + n * 16 + fq * 4) = o;
          else *(uint2*)(Ct + (bj * 128 + wc * 32 + n * 16 + fr) * CT_LD + ai * 128 + wr * 64 + m * 16 + fq * 4) = o;
        }
}
template <int SWAP, int MODE>
DI void epilogue8(const f32x4 (&acc)[2][2][4][2], char* lds, u16* __restrict__ dst, size_t ld, const u16* __restrict__ Hres) {
  const int tid = otid();
  u16* Ct = (u16*)lds;
  stage8<SWAP>(acc, Ct);
  __syncthreads();
#pragma unroll 4
  for (int i = 0; i < 16; ++i) {
    const int q = tid + 512 * i, r = q >> 5, c8 = (q & 31) * 8;
    uint4 v = *(const uint4*)(Ct + r * CT_LD + c8);
    const size_t o = (size_t)r * ld + c8;
    if (MODE == 1) {
      const uint4 hv = *(const uint4*)(Hres + o);
      float y[8], hx[8]; unpack8(v, y); unpack8(hv, hx);
      v.x = pack2(ALPHA * hx[0] + y[0], ALPHA * hx[1] + y[1]); v.y = pack2(ALPHA * hx[2] + y[2], ALPHA * hx[3] + y[3]);
      v.z = pack2(ALPHA * hx[4] + y[4], ALPHA * hx[5] + y[5]); v.w = pack2(ALPHA * hx[6] + y[6], ALPHA * hx[7] + y[7]);
    }
    *(uint4*)(dst + o) = v;
  }
  __syncthreads();
}

DI bool tile_of(int it, int MT, int NT, int& mt, int& nt) {
  const int nb = gridDim.x;
  if ((nb & 7) == 0 && (MT & 7) == 0) {
    const int x = blockIdx.x & 7, slot = blockIdx.x >> 3, nx = nb >> 3, j = slot + it * nx, per = (MT >> 3) * NT;
    if (j >= per) return false;
    if (NT == 14 && (MT >> 3) == 32) {
      const int r = j / 28, w = j - r * 28, nh = r >> 3, mg = r & 7;
      mt = x * 32 + mg * 4 + w / 7; nt = nh * 7 + w % 7; return true;
    }
    mt = x * (MT >> 3) + j / NT; nt = j % NT; return true;
  }
  const int j = blockIdx.x + it * nb;
  if (j >= MT * NT) return false;
  mt = j / NT; nt = j % NT; return true;
}

DI void phase_inproj(const Params& p, char* lds) {
  char* ws = p.ws;
  const u16* A = (const u16*)(ws + OFF_H); const u16* W = (const u16*)(ws + OFF_WIN);
  int mt, nt; bool have = tile_of(0, 256, 14, mt, nt);
  for (int it = 0; have; ++it) {
    const int m0 = mt * 256, n0 = nt * 256;
    int mtn, ntn; const bool hn = tile_of(it + 1, 256, 14, mtn, ntn);
    const u16* nA = A + (size_t)(hn ? mtn : 0) * 256 * 1024; const u16* nB = W + (size_t)(hn ? ntn : 0) * 256 * 1024;
    const bool tr = (n0 >= 1024 && n0 < 1536) || (n0 >= 2560 && n0 < 3072);
    f32x4 acc[2][2][4][2];
    if (tr) {
      gemm8p<0>(A + (size_t)m0 * 1024, W + (size_t)n0 * 1024, acc, lds);
      u16* dst = (n0 < 1536) ? (u16*)(ws + OFF_VTA) + ((size_t)((m0 >> 13) * 512 + (n0 - 1024))) * SEQ + (m0 & 8191)
                             : (u16*)(ws + OFF_VTM) + ((size_t)((m0 >> 13) * 512 + (n0 - 2560))) * SEQ + (m0 & 8191);
      epilogue8<0, 0>(acc, lds, dst, SEQ, nullptr);
    } else {
      gemm8p<1>(A + (size_t)m0 * 1024, W + (size_t)n0 * 1024, acc, lds);
      u16* dst; size_t ld;
      if (n0 < 1024) { dst = (u16*)(ws + OFF_PA) + (size_t)m0 * 1024 + n0; ld = 1024; }
      else if (n0 < 2560) { dst = (u16*)(ws + OFF_PM) + (size_t)m0 * 1024 + (n0 - 1536); ld = 1024; }
      else { dst = (u16*)(ws + OFF_PO) + (size_t)m0 * 512 + (n0 - 3072); ld = 512; }
      epilogue8<1, 0>(acc, lds, dst, ld, nullptr);
    }
    mt = mtn; nt = ntn; have = hn;
  }
  for (int it = 0;; ++it) {
    if (!tile_of(it, 8, 8, mt, nt)) break;
    const int m0 = mt * 256, n0 = nt * 256;
    const u16* Am = (const u16*)(ws + OFF_MEMB) + (size_t)m0 * 1024; const u16* Bm = (const u16*)(ws + OFF_WKV) + (size_t)n0 * 1024;
    f32x4 acc[2][2][4][2];
    if (n0 >= 1024) { gemm8p<0>(Am, Bm, acc, lds); epilogue8<0, 0>(acc, lds, (u16*)(ws + OFF_VTX) + ((size_t)((m0 >> 8) * 1024 + (n0 - 1024))) * 256, 256, nullptr); }
    else { gemm8p<1>(Am, Bm, acc, lds); epilogue8<1, 0>(acc, lds, (u16*)(ws + OFF_KX) + (size_t)m0 * 1024 + n0, 1024, nullptr); }
  }
}

template <int MODE>
DI void phase_gemm1024(const u16* __restrict__ A, const u16* __restrict__ Wt, u16* __restrict__ dstb, const u16* __restrict__ Hres, char* lds) {
  const int tid = otid(), wid = tid >> 6, lane = tid & 63, wr = wid >> 2, wc = wid & 3, fr = lane & 15, fq = lane >> 4;
  int mt, nt; bool have = tile_of(0, 256, 4, mt, nt);
  for (int it = 0; have; ++it) {
    const int m0 = mt * 256, n0 = nt * 256;
    int mtn, ntn; const bool hn = tile_of(it + 1, 256, 4, mtn, ntn);
    f32x4 acc[2][2][4][2];
    gemm8p<1>(A + (size_t)m0 * 1024, Wt + (size_t)n0 * 1024, acc, lds);
    epilogue8<1, MODE>(acc, lds, dstb + (size_t)m0 * 1024 + n0, 1024, (MODE == 1) ? Hres + (size_t)m0 * 1024 + n0 : nullptr);
    mt = mtn; nt = ntn; have = hn;
  }
}

DI void attn_item(const Params& p, char* lds, int item) {
  char* ws = p.ws;
  const int tid = otid(), lane = tid & 63, wave = tid >> 6, l31 = lane & 31, hh = lane >> 5;
  const int b = item >> 8, h = (item >> 5) & 7, c0 = (item & 31) * 4;
  const int qc = c0 + (wave >> 1), qt = wave & 1;
  const u16* PA = (const u16*)(ws + OFF_PA); const u16* VTa = (const u16*)(ws + OFF_VTA); u16* MIX = (u16*)(ws + OFF_MIX);
  u16* Kl = (u16*)lds;
  u16* Vl = Kl + 2 * 64 * 72;
  float* biasl = (float*)(Vl + 2 * 64 * 72);
  const int pi = perm23(l31);
  const int sr = tid >> 3, sc8 = (tid & 7) * 8;
  const u16* kg = PA + ((size_t)b * SEQ + sr) * 1024 + 512 + h * 64 + sc8;
  const u16* vg = VTa + ((size_t)((b * 8 + h) * 64 + sr)) * SEQ + sc8;
  for (int i = tid; i < 257; i += 512) biasl[i] = p.in[10][h * 257 + i] * 1.4426950408889634f;
  const size_t q0 = (size_t)b * SEQ + qc * 64 + qt * 32;
  bf16x8 Qf[4];
#pragma unroll
  for (int kk = 0; kk < 4; ++kk) Qf[kk] = ldfrag(PA + (q0 + l31) * 1024 + h * 64 + kk * 16 + 8 * hh);
  const int kcs = (c0 >= 8) ? c0 - 8 : 0, kce = c0 + 3;
  *(uint4*)(Kl + sr * 72 + sc8) = *(const uint4*)(kg + (size_t)(kcs * 64) * 1024);
  *(uint4*)(Vl + sr * 72 + sc8) = *(const uint4*)(vg + kcs * 64);
  __syncthreads();
  f32x16 O[2]; O[0] = zero16(); O[1] = zero16();
  float mrun = -INFINITY, lrun = 0.f;
#pragma unroll 1
  for (int kc = kcs; kc <= kce; ++kc) {
    const int cur = (kc - kcs) & 1;
    uint4 nk, nv;
    if (kc < kce) { nk = *(const uint4*)(kg + (size_t)((kc + 1) * 64) * 1024); nv = *(const uint4*)(vg + (kc + 1) * 64); }
    if (kc >= qc - 8 && kc <= qc) {
      f32x16 S[2];
      float mx = -INFINITY;
#pragma unroll
      for (int sub = 0; sub < 2; ++sub) {
        const u16* kl = Kl + cur * 64 * 72 + (sub * 32 + pi) * 72 + 8 * hh;
        S[sub] = zero16();
#pragma unroll
        for (int kk = 0; kk < 4; ++kk) S[sub] = MFMA(ldfrag(kl + kk * 16), Qf[kk], S[sub]);
        const int relbase = (kc * 64 + sub * 32 + 8 * hh) - (qc * 64 + qt * 32 + l31);
        if ((kc * 64 + sub * 32 + 31) - (qc * 64 + qt * 32) <= -128) {
          const float b0 = biasl[0];
#pragma unroll
          for (int r = 0; r < 16; ++r) { const float sv = S[sub][r] * 0.18033688011112042f + b0; S[sub][r] = sv; mx = fmaxf(mx, sv); }
        } else {
#pragma unroll
          for (int r = 0; r < 16; ++r) {
            int rel = relbase + 16 * (r >> 3) + (r & 7);
            rel = rel < -128 ? -128 : (rel > 128 ? 128 : rel);
            const float sv = S[sub][r] * 0.18033688011112042f + biasl[rel + 128];
            S[sub][r] = sv; mx = fmaxf(mx, sv);
          }
        }
      }
      mx = fmaxf(mx, __shfl_xor(mx, 32));
      const float mnew = fmaxf(mrun, mx);
      const float alpha = __builtin_amdgcn_exp2f(mrun - mnew);
      mrun = mnew;
      float ps = 0.f;
#pragma unroll
      for (int sub = 0; sub < 2; ++sub)
#pragma unroll
        for (int r = 0; r < 16; ++r) { const float e = __builtin_amdgcn_exp2f(S[sub][r] - mnew); S[sub][r] = e; ps += e; }
      lrun = lrun * alpha + ps;
#pragma unroll
      for (int r = 0; r < 16; ++r) { O[0][r] *= alpha; O[1][r] *= alpha; }
#pragma unroll
      for (int sub = 0; sub < 2; ++sub) {
        bf16x8 Pf[2];
#pragma unroll
        for (int ks = 0; ks < 2; ++ks) {
          union { bf16x8 v; unsigned u[4]; } cv;
          for (int j2 = 0; j2 < 4; ++j2) cv.u[j2] = pack2(S[sub][8 * ks + 2 * j2], S[sub][8 * ks + 2 * j2 + 1]);
          Pf[ks] = cv.v;
        }
        const u16* vl = Vl + cur * 64 * 72 + l31 * 72 + sub * 32 + 8 * hh;
#pragma unroll
        for (int dt = 0; dt < 2; ++dt)
#pragma unroll
          for (int ks = 0; ks < 2; ++ks) O[dt] = MFMA(ldfrag(vl + dt * 32 * 72 + 16 * ks), Pf[ks], O[dt]);
      }
    }
    if (kc < kce) { const int nx = cur ^ 1; *(uint4*)(Kl + nx * 64 * 72 + sr * 72 + sc8) = nk; *(uint4*)(Vl + nx * 64 * 72 + sr * 72 + sc8) = nv; }
    __syncthreads();
  }
  const float inv = __builtin_amdgcn_rcpf(lrun + __shfl_xor(lrun, 32));
#pragma unroll
  for (int dt = 0; dt < 2; ++dt)
#pragma unroll
    for (int g = 0; g < 4; ++g) {
      uint2 o; o.x = pack2(O[dt][4 * g] * inv, O[dt][4 * g + 1] * inv); o.y = pack2(O[dt][4 * g + 2] * inv, O[dt][4 * g + 3] * inv);
      *(uint2*)(MIX + (q0 + l31) * 1024 + h * 64 + dt * 32 + 8 * g + 4 * hh) = o;
    }
}

DI float log_sigmoid(float f) { return fminf(f, 0.f) - log1pf(expf(-fabsf(f))); }
DI float scan_sum(float v, int lane) { for (int o = 1; o < 64; o <<= 1) { float tv = __shfl_up(v, o); if (lane >= o) v += tv; } return v; }
DI float scan_max(float v, int lane) { for (int o = 1; o < 64; o <<= 1) { float tv = __shfl_up(v, o); if (lane >= o) v = fmaxf(v, tv); } return v; }

DI void conv_unit(const u16* __restrict__ PM, const float* __restrict__ conv_w, const float* __restrict__ conv_b, int b, int sl0, int ch, float scale, float* a8) {
  { const float4 b0 = *(const float4*)(conv_b + ch), b1 = *(const float4*)(conv_b + ch + 4); a8[0] = b0.x; a8[1] = b0.y; a8[2] = b0.z; a8[3] = b0.w; a8[4] = b1.x; a8[5] = b1.y; a8[6] = b1.z; a8[7] = b1.w; }
#pragma unroll
  for (int j = 0; j < 4; ++j) {
    const int sl = sl0 - 3 + j;
    if (sl >= 0) {
      const uint4 raw = *(const uint4*)(PM + ((size_t)b * SEQ + sl) * 1024 + ch);
      float x8[8]; unpack8(raw, x8);
      const float4 w0 = *(const float4*)(conv_w + j * 1024 + ch), w1 = *(const float4*)(conv_w + j * 1024 + ch + 4);
      a8[0] += w0.x * x8[0]; a8[1] += w0.y * x8[1]; a8[2] += w0.z * x8[2]; a8[3] += w0.w * x8[3];
      a8[4] += w1.x * x8[4]; a8[5] += w1.y * x8[5]; a8[6] += w1.z * x8[6]; a8[7] += w1.w * x8[7];
    }
  }
#pragma unroll
  for (int e = 0; e < 8; ++e) { const float v = a8[e]; a8[e] = scale * v * __builtin_amdgcn_rcpf(1.f + __expf(-v)); }
}

DI void mlstmA_item(const Params& p, char* lds, int item) {
  char* ws = p.ws;
  const int bh = item >> 7, c = item & 127, b = bh >> 2, hd = bh & 3;
  const int tid = otid(), lane = tid & 63, wave = tid >> 6, hh = lane >> 5, l31 = lane & 31;
  u16* KTs = (u16*)lds;
  u16* VTs = KTs + 128 * 72;
  float* win = (float*)(VTs + 128 * 72);
  const u16* PM = (const u16*)(ws + OFF_PM); const u16* VTm = (const u16*)(ws + OFF_VTM);
  const float* G = (const float*)(ws + OFF_G);
  u16* KVS = (u16*)(ws + OFF_KVS) + (size_t)item * 16384; float* KSUM = (float*)(ws + OFF_KSUM) + (size_t)item * 128; float* CSC = (float*)(ws + OFF_CSC) + (size_t)item * 4;
  if (wave == 0) {
    const size_t row = (size_t)b * SEQ + c * 64 + lane;
    const float ig = G[row * 8 + hd] + p.in[7][hd], fg = G[row * 8 + 4 + hd] + p.in[8][hd];
    const float bc = scan_sum(log_sigmoid(fg), lane);
    const float as = ig - bc;
    const float gmax = wmax(as);
    const float B = __shfl(bc, 63);
    win[lane] = expf(as - gmax);
    if (lane == 0) { CSC[0] = B; CSC[1] = B + gmax; }
  }
  for (int i = 0; i < 2; ++i) {
    const int q = tid + 512 * i, e = q >> 3, s8 = (q & 7) * 8;
    *(uint4*)(VTs + e * 72 + s8) = *(const uint4*)(VTm + ((size_t)(bh * 128 + e)) * SEQ + c * 64 + s8);
  }
  __syncthreads();
#pragma unroll 1
  for (int i = 0; i < 2; ++i) {
    const int cgk = tid & 15, t = (tid >> 4) + 32 * i;
    float a8[8];
    conv_unit(PM, p.in[5], p.in[6], b, c * 64 + t, 512 + hd * 128 + cgk * 8, 0.08838834764831845f, a8);
    const float w = win[t];
#pragma unroll
    for (int e = 0; e < 8; ++e) KTs[(cgk * 8 + e) * 72 + t] = f2bf(a8[e] * w);
  }
  __syncthreads();
  {
    const int dt = wave >> 1;
#pragma unroll
    for (int x = 0; x < 2; ++x) {
      const int e2 = (wave & 1) * 2 + x;
      f32x16 acc = zero16();
#pragma unroll
      for (int ks = 0; ks < 4; ++ks) acc = MFMA(ldfrag(KTs + (dt * 32 + l31) * 72 + ks * 16 + 8 * hh), ldfrag(VTs + (e2 * 32 + l31) * 72 + ks * 16 + 8 * hh), acc);
#pragma unroll
      for (int g = 0; g < 4; ++g) *(uint2*)(KVS + (e2 * 32 + l31) * 128 + dt * 32 + 8 * g + 4 * hh) = pack4(acc, g);
    }
    if (tid < 128) {
      float sacc = 0.f;
      for (int s8 = 0; s8 < 8; ++s8) { const uint4 raw = *(const uint4*)(KTs + tid * 72 + s8 * 8); float x8[8]; unpack8(raw, x8); for (int e = 0; e < 8; ++e) sacc += x8[e]; }
      KSUM[tid] = sacc;
    }
  }
  __syncthreads();
}

DI void phase_mlstm_scan(const Params& p) {
  char* ws = p.ws;
  const int tid = otid();
  for (int unit = blockIdx.x; unit < 256; unit += gridDim.x) {
    const int bh = unit >> 3, part = unit & 7;
    u16* kv = (u16*)(ws + OFF_KVS) + (size_t)bh * 128 * 16384 + part * 2048 + tid * 4;
    float* ks = (float*)(ws + OFF_KSUM) + (size_t)bh * 128 * 128 + tid;
    float* csc = (float*)(ws + OFF_CSC) + (size_t)bh * 128 * 4;
    const bool don = (part == 0) && (tid < 128);
    float m = 0.f, c0 = 0.f, c1 = 0.f, c2 = 0.f, c3 = 0.f, n = 0.f;
#pragma unroll 1
    for (int cb = 0; cb < 128; cb += 8) {
      uint2 raw[8]; float kr[8];
#pragma unroll
      for (int j = 0; j < 8; ++j) { raw[j] = *(const uint2*)(kv + (size_t)(cb + j) * 16384); kr[j] = don ? ks[(cb + j) * 128] : 0.f; }
#pragma unroll
      for (int j = 0; j < 8; ++j) {
        const float B = csc[(cb + j) * 4], A = csc[(cb + j) * 4 + 1];
        const float mnew = fmaxf(B + m, A);
        const float wp = __expf(B + m - mnew), wl = __expf(A - mnew);
        m = mnew;
        c0 = wp * c0 + wl * bflo(raw[j].x); c1 = wp * c1 + wl * bfhi(raw[j].x); c2 = wp * c2 + wl * bflo(raw[j].y); c3 = wp * c3 + wl * bfhi(raw[j].y);
        uint2 o; o.x = pack2(c0, c1); o.y = pack2(c2, c3);
        *(uint2*)(kv + (size_t)(cb + j) * 16384) = o;
        if (don) { n = wp * n + wl * kr[j]; ks[(cb + j) * 128] = n; }
        if (part == 0 && tid == 0) csc[(cb + j) * 4 + 2] = mnew;
      }
    }
  }
}

DI void mlstmC_pair(const Params& p, char* lds_all, int pair) {
  char* ws = p.ws;
  const int tid = otid(), hb = tid >> 8, ltid = tid & 255, lane = tid & 63, lwave = ltid >> 6, hh = lane >> 5, l31 = lane & 31;
  const int item = pair * 2 + hb;
  const int bh = item >> 7, c = item & 127, b = bh >> 2, hd = bh & 3;
  char* lds = lds_all + hb * 69632;
  u16* Qs = (u16*)lds;
  u16* Ks = Qs + 64 * 136;
  u16* VTs = Ks + 64 * 136;
  u16* Ps = VTs + 128 * 72;
  float* fs = (float*)(Ps + 64 * 72);
  float* a_s = fs; float* c_t = fs + 64; float* wint = fs + 128; float* emt = fs + 192; float* qnp = fs + 256; float* qks = fs + 512; float* red = fs + 640;
  const u16* PM = (const u16*)(ws + OFF_PM); const u16* VTm = (const u16*)(ws + OFF_VTM); const u16* PO = (const u16*)(ws + OFF_PO);
  const float* G = (const float*)(ws + OFF_G); u16* MIX = (u16*)(ws + OFF_MIX);
  const u16* CT = (const u16*)(ws + OFF_KVS) + (size_t)(item - 1) * 16384;
  const float* NP = (const float*)(ws + OFF_KSUM) + (size_t)(item - 1) * 128;
  const float* ng = p.in[9] + hd * 128;
  const float mprev = (c > 0) ? ((const float*)(ws + OFF_CSC))[(size_t)(item - 1) * 4 + 2] : 0.f;
#pragma unroll 1
  for (int i = 0; i < 8; ++i) {
    const int cg8 = ltid & 31, isK = cg8 >> 4, chl = (cg8 & 15) * 8, t = (ltid >> 5) + 8 * i;
    float a8[8];
    conv_unit(PM, p.in[5], p.in[6], b, c * 64 + t, (isK ? 512 : 0) + hd * 128 + chl, isK ? 0.08838834764831845f : 1.f, a8);
    uint4 o; o.x = pack2(a8[0], a8[1]); o.y = pack2(a8[2], a8[3]); o.z = pack2(a8[4], a8[5]); o.w = pack2(a8[6], a8[7]);
    *(uint4*)((isK ? Ks : Qs) + t * 136 + chl) = o;
  }
  for (int i = 0; i < 4; ++i) {
    const int q = ltid + 256 * i, e = q >> 3, s8 = (q & 7) * 8;
    *(uint4*)(VTs + e * 72 + s8) = *(const uint4*)(VTm + ((size_t)(bh * 128 + e)) * SEQ + c * 64 + s8);
  }
  if (lwave == 0) {
    const size_t row = (size_t)b * SEQ + c * 64 + lane;
    const float ig = G[row * 8 + hd] + p.in[7][hd], fg = G[row * 8 + 4 + hd] + p.in[8][hd];
    const float bc = scan_sum(log_sigmoid(fg), lane);
    const float as = ig - bc;
    const float gm = scan_max(as, lane);
    const float mt = bc + fmaxf(mprev, gm);
    a_s[lane] = as; c_t[lane] = bc - mt; wint[lane] = expf(bc + mprev - mt); emt[lane] = expf(-mt);
  }
  __syncthreads();
  {
    const int t = ltid & 63, part = ltid >> 6;
    float acc = 0.f;
    if (c > 0) for (int dd = 0; dd < 32; ++dd) acc += bf2f(Qs[t * 136 + part * 32 + dd]) * NP[part * 32 + dd];
    qnp[part * 64 + t] = acc;
  }
  {
    const int si = lwave >> 1, ti = lwave & 1;
    f32x16 S = zero16();
#pragma unroll
    for (int kk = 0; kk < 8; ++kk) S = MFMA(ldfrag(Ks + (si * 32 + l31) * 136 + kk * 16 + 8 * hh), ldfrag(Qs + (ti * 32 + l31) * 136 + kk * 16 + 8 * hh), S);
    const int t = ti * 32 + l31;
    const float ct = c_t[t];
    float rs = 0.f;
#pragma unroll
    for (int g = 0; g < 4; ++g) {
      float v4[4];
#pragma unroll
      for (int q = 0; q < 4; ++q) {
        const int sidx2 = si * 32 + 8 * g + 4 * hh + q;
        const float dv = (sidx2 <= t) ? S[4 * g + q] * __expf(ct + a_s[sidx2]) : 0.f;
        v4[q] = dv; rs += dv;
      }
      uint2 o; o.x = pack2(v4[0], v4[1]); o.y = pack2(v4[2], v4[3]);
      *(uint2*)(Ps + t * 72 + si * 32 + 8 * g + 4 * hh) = o;
    }
    rs += __shfl_xor(rs, 32);
    if (hh == 0) qks[si * 64 + t] = rs;
  }
  __syncthreads();
  const int et = lwave;
  f32x16 Hn[2];
#pragma unroll
  for (int tt = 0; tt < 2; ++tt) {
    const int tq = tt * 32 + l31;
    Hn[tt] = zero16();
    if (c > 0) {
#pragma unroll
      for (int kk = 0; kk < 8; ++kk) Hn[tt] = MFMA(ldfrag(CT + (et * 32 + l31) * 128 + kk * 16 + 8 * hh), ldfrag(Qs + tq * 136 + kk * 16 + 8 * hh), Hn[tt]);
    }
    const float wi = wint[tq];
#pragma unroll
    for (int r = 0; r < 16; ++r) Hn[tt][r] *= wi;
#pragma unroll
    for (int ks = 0; ks < 4; ++ks) Hn[tt] = MFMA(ldfrag(VTs + (et * 32 + l31) * 72 + ks * 16 + 8 * hh), ldfrag(Ps + tq * 72 + ks * 16 + 8 * hh), Hn[tt]);
    const float qn = qnp[tq] + qnp[64 + tq] + qnp[128 + tq] + qnp[192 + tq];
    const float den = wi * qn + qks[tq] + qks[64 + tq];
    const float inv = __builtin_amdgcn_rcpf(fmaxf(fabsf(den), emt[tq]));
    float s1 = 0.f, s2 = 0.f;
#pragma unroll
    for (int r = 0; r < 16; ++r) { Hn[tt][r] *= inv; s1 += Hn[tt][r]; s2 += Hn[tt][r] * Hn[tt][r]; }
    s1 += __shfl_xor(s1, 32); s2 += __shfl_xor(s2, 32);
    if (hh == 0) { red[(et * 64 + tq) * 2] = s1; red[(et * 64 + tq) * 2 + 1] = s2; }
  }
  __syncthreads();
#pragma unroll
  for (int tt = 0; tt < 2; ++tt) {
    const int tq = tt * 32 + l31;
    float t1 = 0.f, t2 = 0.f;
    for (int e4 = 0; e4 < 4; ++e4) { t1 += red[(e4 * 64 + tq) * 2]; t2 += red[(e4 * 64 + tq) * 2 + 1]; }
    const float mu = t1 * (1.f / 128.f);
    const float var = fmaxf(t2 * (1.f / 128.f) - mu * mu, 0.f);
    const float rstd = rsqrtf(var + LN_EPS);
    const size_t row = (size_t)b * SEQ + c * 64 + tq;
#pragma unroll
    for (int g = 0; g < 4; ++g) {
      const int e0 = et * 32 + 8 * g + 4 * hh;
      const uint2 og = *(const uint2*)(PO + row * 512 + hd * 128 + e0);
      const float4 gg = *(const float4*)(ng + e0);
      const float o0 = __builtin_amdgcn_rcpf(1.f + __expf(-bflo(og.x))), o1 = __builtin_amdgcn_rcpf(1.f + __expf(-bfhi(og.x))), o2 = __builtin_amdgcn_rcpf(1.f + __expf(-bflo(og.y))), o3 = __builtin_amdgcn_rcpf(1.f + __expf(-bfhi(og.y)));
      uint2 o;
      o.x = pack2(o0 * (Hn[tt][4 * g] - mu) * rstd * gg.x, o1 * (Hn[tt][4 * g + 1] - mu) * rstd * gg.y);
      o.y = pack2(o2 * (Hn[tt][4 * g + 2] - mu) * rstd * gg.z, o3 * (Hn[tt][4 * g + 3] - mu) * rstd * gg.w);
      *(uint2*)(MIX + row * 1024 + 512 + hd * 128 + e0) = o;
    }
  }
  __syncthreads();
}

DI void phase_mixA(const Params& p, char* lds) {
  for (int it = blockIdx.x; it < 4096; it += gridDim.x) mlstmA_item(p, lds, it);
  if ((gridDim.x & 7) == 0 && gridDim.x <= 256) {
    const int x = blockIdx.x & 7, slot = blockIdx.x >> 3, nx = gridDim.x >> 3;
    for (int j = slot; j < 256; j += nx) attn_item(p, lds, x * 256 + j);
  } else {
    for (int it = blockIdx.x; it < 2048; it += gridDim.x) attn_item(p, lds, it);
  }
}
DI void phase_mixC(const Params& p, char* lds) {
  for (int it = blockIdx.x; it < 2048; it += gridDim.x) mlstmC_pair(p, lds, it);
}

DI void phase_xattn(const Params& p, char* lds) {
  char* ws = p.ws;
  const int tid = otid(), lane = tid & 63, wave = tid >> 6, l31 = lane & 31, hh = lane >> 5;
  const u16* XQ = (const u16*)(ws + OFF_XQ); const u16* KX = (const u16*)(ws + OFF_KX); const u16* VTX = (const u16*)(ws + OFF_VTX);
  u16* XO = (u16*)(ws + OFF_XO);
  u16* Kl = (u16*)lds; u16* Vl = Kl + 2 * 32 * 264;
  const int pi = perm23(l31);
  const int kr0 = tid >> 5, kc = (tid & 31) * 8, vr = tid >> 2, vc = (tid & 3) * 8;
  for (int item = blockIdx.x; item < 1024; item += gridDim.x) {
    const int b = item >> 7, h = (item >> 5) & 3, qblk = item & 31;
    const size_t q0 = (size_t)b * SEQ + qblk * 256 + wave * 32;
    bf16x8 Qf[16];
#pragma unroll
    for (int kk = 0; kk < 16; ++kk) Qf[kk] = ldfrag(XQ + (q0 + l31) * 1024 + h * 256 + kk * 16 + 8 * hh);
    const u16* kg = KX + ((size_t)b * 256) * 1024 + h * 256;
    const u16* vg = VTX + ((size_t)((b * 4 + h) * 256)) * 256;
    {
      const uint4 k0 = *(const uint4*)(kg + (size_t)kr0 * 1024 + kc), k1 = *(const uint4*)(kg + (size_t)(kr0 + 16) * 1024 + kc);
      const uint4 v0 = *(const uint4*)(vg + (size_t)vr * 256 + vc);
      *(uint4*)(Kl + kr0 * 264 + kc) = k0; *(uint4*)(Kl + (kr0 + 16) * 264 + kc) = k1; *(uint4*)(Vl + vr * 40 + vc) = v0;
    }
    __syncthreads();
    f32x16 O[4]; for (int i = 0; i < 4; ++i) O[i] = zero16();
    float mrun = -INFINITY, lrun = 0.f;
#pragma unroll 1
    for (int st = 0; st < 16; ++st) {
      const int dh = st >> 3, kt = st & 7, cur = st & 1;
      uint4 nk0, nk1, nv0;
      if (st < 15) {
        const int ndh = (st + 1) >> 3, nkt = (st + 1) & 7;
        nk0 = *(const uint4*)(kg + (size_t)(nkt * 32 + kr0) * 1024 + kc); nk1 = *(const uint4*)(kg + (size_t)(nkt * 32 + kr0 + 16) * 1024 + kc);
        nv0 = *(const uint4*)(vg + (size_t)(ndh * 128 + vr) * 256 + nkt * 32 + vc);
      }
      const u16* kl = Kl + cur * 32 * 264 + pi * 264 + 8 * hh;
      const u16* vl = Vl + cur * 128 * 40 + l31 * 40 + 8 * hh;
      f32x16 S = zero16();
#pragma unroll
      for (int kk = 0; kk < 16; ++kk) S = MFMA(ldfrag(kl + kk * 16), Qf[kk], S);
      float mx = -INFINITY;
#pragma unroll
      for (int r = 0; r < 16; ++r) { S[r] *= 0.09016844005556021f; mx = fmaxf(mx, S[r]); }
      mx = fmaxf(mx, __shfl_xor(mx, 32));
      const float mnew = fmaxf(mrun, mx), alpha = __builtin_amdgcn_exp2f(mrun - mnew);
      mrun = mnew;
      float ps = 0.f;
#pragma unroll
      for (int r = 0; r < 16; ++r) { const float e = __builtin_amdgcn_exp2f(S[r] - mnew); S[r] = e; ps += e; }
      lrun = lrun * alpha + ps;
      bf16x8 Pf[2];
#pragma unroll
      for (int ks = 0; ks < 2; ++ks) {
        union { bf16x8 v; unsigned u[4]; } cv;
        for (int j2 = 0; j2 < 4; ++j2) cv.u[j2] = pack2(S[8 * ks + 2 * j2], S[8 * ks + 2 * j2 + 1]);
        Pf[ks] = cv.v;
      }
#pragma unroll
      for (int dt = 0; dt < 4; ++dt) {
#pragma unroll
        for (int r = 0; r < 16; ++r) O[dt][r] *= alpha;
#pragma unroll
        for (int ks = 0; ks < 2; ++ks) O[dt] = MFMA(ldfrag(vl + dt * 32 * 40 + 16 * ks), Pf[ks], O[dt]);
      }
      if (kt == 7) {
        const float inv = __builtin_amdgcn_rcpf(lrun + __shfl_xor(lrun, 32));
#pragma unroll
        for (int dt = 0; dt < 4; ++dt) {
#pragma unroll
          for (int g = 0; g < 4; ++g) {
            uint2 o; o.x = pack2(O[dt][4 * g] * inv, O[dt][4 * g + 1] * inv); o.y = pack2(O[dt][4 * g + 2] * inv, O[dt][4 * g + 3] * inv);
            *(uint2*)(XO + (q0 + l31) * 1024 + h * 256 + dh * 128 + dt * 32 + 8 * g + 4 * hh) = o;
          }
          O[dt] = zero16();
        }
        mrun = -INFINITY; lrun = 0.f;
      }
      if (st < 15) {
        const int nx = cur ^ 1;
        *(uint4*)(Kl + nx * 32 * 264 + kr0 * 264 + kc) = nk0; *(uint4*)(Kl + nx * 32 * 264 + (kr0 + 16) * 264 + kc) = nk1; *(uint4*)(Vl + nx * 128 * 40 + vr * 40 + vc) = nv0;
      }
      __syncthreads();
    }
  }
}

DI void phase_peer_query(const Params& p, char* lds) {
  char* ws = p.ws;
  const int tid = otid(), lane = tid & 63, wave = tid >> 6, wm = wave >> 1, wn = wave & 1, l31 = lane & 31, hh = lane >> 5;
  const u16* SK = (const u16*)(ws + OFF_SK);
  float* TOPV = (float*)(ws + OFF_TOPV);
  u16* Ct = (u16*)lds;
  float* Sc = (float*)lds;
  float* Ll = (float*)lds;
  for (int it = 0;; ++it) {
    int mt, hq; if (!tile_of(it, 256, 8, mt, hq)) break;
    const int m0 = mt * 256, n0 = hq * 256;
    {
      f32x4 acc[2][2][4][2];
      const u16* Aq = (const u16*)(ws + OFF_H) + (size_t)m0 * 1024; const u16* Bq = (const u16*)(ws + OFF_WPQ) + (size_t)n0 * 1024;
      gemm8p<1>(Aq, Bq, acc, lds);
      stage8<1>(acc, Ct);
    }
    __syncthreads();
    f32x16 sacc[2][2][2];
#pragma unroll
    for (int pp = 0; pp < 2; ++pp) {
#pragma unroll
      for (int i = 0; i < 2; ++i) for (int j = 0; j < 2; ++j) sacc[pp][i][j] = zero16();
#pragma unroll
      for (int kk = 0; kk < 8; ++kk) {
        const bf16x8 a0 = ldfrag(Ct + (wm * 64 + l31) * CT_LD + pp * 128 + kk * 16 + 8 * hh), a1 = ldfrag(Ct + (wm * 64 + 32 + l31) * CT_LD + pp * 128 + kk * 16 + 8 * hh);
        const bf16x8 b0 = ldfrag(SK + (size_t)(pp * 128 + wn * 64 + l31) * 128 + kk * 16 + 8 * hh), b1 = ldfrag(SK + (size_t)(pp * 128 + wn * 64 + 32 + l31) * 128 + kk * 16 + 8 * hh);
        sacc[pp][0][0] = MFMA(a0, b0, sacc[pp][0][0]); sacc[pp][0][1] = MFMA(a0, b1, sacc[pp][0][1]);
        sacc[pp][1][0] = MFMA(a1, b0, sacc[pp][1][0]); sacc[pp][1][1] = MFMA(a1, b1, sacc[pp][1][1]);
      }
    }
    __syncthreads();
#pragma unroll
    for (int pp = 0; pp < 2; ++pp) {
      const int hp = hq * 2 + pp;
#pragma unroll
      for (int i = 0; i < 2; ++i)
#pragma unroll
        for (int j = 0; j < 2; ++j)
#pragma unroll
          for (int r = 0; r < 16; ++r)
            Sc[(wm * 64 + i * 32 + (r & 3) + 8 * (r >> 2) + 4 * hh) * 132 + wn * 64 + j * 32 + l31] = sacc[pp][i][j][r];
      __syncthreads();
      {
        const int row = tid >> 1, half = tid & 1;
        const float* srow = Sc + row * 132 + half * 64;
        float v[16];
#pragma unroll
        for (int i = 0; i < 16; ++i) v[i] = -INFINITY;
#pragma unroll 2
        for (int e4 = 0; e4 < 16; ++e4) {
          const float4 s4 = *(const float4*)(srow + 4 * e4);
          const float sv[4] = {s4.x, s4.y, s4.z, s4.w};
#pragma unroll
          for (int u = 0; u < 4; ++u) {
            float x = __uint_as_float((__float_as_uint(sv[u]) & 0xFFFFFF80u) | (unsigned)(127 - (half * 64 + 4 * e4 + u)));
#pragma unroll
            for (int i = 0; i < 16; ++i) { const float hi = fmaxf(x, v[i]); x = fminf(x, v[i]); v[i] = hi; }
          }
        }
        float c[16];
#pragma unroll
        for (int i = 0; i < 16; ++i) c[i] = __shfl_xor(v[15 - i], 1);
#pragma unroll
        for (int i = 0; i < 16; ++i) c[i] = fmaxf(c[i], v[i]);
#pragma unroll
        for (int d = 8; d >= 1; d >>= 1)
#pragma unroll
          for (int i = 0; i < 16; ++i)
            if ((i & d) == 0) { const float hi = fmaxf(c[i], c[i + d]), lo = fminf(c[i], c[i + d]); c[i] = hi; c[i + d] = lo; }
        if (half == 0) {
          float* tv = TOPV + (size_t)(m0 + row) * 256 + hp * 16;
#pragma unroll
          for (int i = 0; i < 4; ++i) *(float4*)(tv + 4 * i) = make_float4(c[4 * i], c[4 * i + 1], c[4 * i + 2], c[4 * i + 3]);
        }
      }
      __syncthreads();
    }
  }
}

template <int C> struct CandFlat { static constexpr int calc() { int i = 0, rem = C; while (rem >= 16 / (i + 1)) { rem -= 16 / (i + 1); ++i; } return i * 16 + rem; } static constexpr int value = calc(); };
template <int C> DI void rank_step(const float val, const int flat, int& rank) {
  const float o = __uint_as_float(__builtin_amdgcn_readlane(__float_as_uint(val), C));
  rank += (int)(o > val) | ((int)(o == val) & (int)(CandFlat<C>::value < flat));
}
template <int C0> DI void rank_steps10(const float val, const int flat, int& rank) {
  rank_step<C0>(val, flat, rank); rank_step<C0 + 1>(val, flat, rank); rank_step<C0 + 2>(val, flat, rank); rank_step<C0 + 3>(val, flat, rank); rank_step<C0 + 4>(val, flat, rank);
  rank_step<C0 + 5>(val, flat, rank); rank_step<C0 + 6>(val, flat, rank); rank_step<C0 + 7>(val, flat, rank); rank_step<C0 + 8>(val, flat, rank); rank_step<C0 + 9>(val, flat, rank);
}
DI float dot16q(const uint4& q, const f32x2* x) {
  f32x2 a = __builtin_amdgcn_cvt_pk_f32_fp8((int)q.x, false) * x[0];
  a = __builtin_amdgcn_cvt_pk_f32_fp8((int)q.x, true) * x[1] + a;
  a = __builtin_amdgcn_cvt_pk_f32_fp8((int)q.y, false) * x[2] + a;
  a = __builtin_amdgcn_cvt_pk_f32_fp8((int)q.y, true) * x[3] + a;
  a = __builtin_amdgcn_cvt_pk_f32_fp8((int)q.z, false) * x[4] + a;
  a = __builtin_amdgcn_cvt_pk_f32_fp8((int)q.z, true) * x[5] + a;
  a = __builtin_amdgcn_cvt_pk_f32_fp8((int)q.w, false) * x[6] + a;
  a = __builtin_amdgcn_cvt_pk_f32_fp8((int)q.w, true) * x[7] + a;
  return a.x + a.y;
}
DI void axpy16q(float c, const uint4& q, f32x2* o) {
  const f32x2 c2 = {c, c};
  o[0] = __builtin_amdgcn_cvt_pk_f32_fp8((int)q.x, false) * c2 + o[0];
  o[1] = __builtin_amdgcn_cvt_pk_f32_fp8((int)q.x, true) * c2 + o[1];
  o[2] = __builtin_amdgcn_cvt_pk_f32_fp8((int)q.y, false) * c2 + o[2];
  o[3] = __builtin_amdgcn_cvt_pk_f32_fp8((int)q.y, true) * c2 + o[3];
  o[4] = __builtin_amdgcn_cvt_pk_f32_fp8((int)q.z, false) * c2 + o[4];
  o[5] = __builtin_amdgcn_cvt_pk_f32_fp8((int)q.z, true) * c2 + o[5];
  o[6] = __builtin_amdgcn_cvt_pk_f32_fp8((int)q.w, false) * c2 + o[6];
  o[7] = __builtin_amdgcn_cvt_pk_f32_fp8((int)q.w, true) * c2 + o[7];
}
struct __attribute__((packed, aligned(8))) U4a8 { unsigned a, b, c, d; };
DI v6u load6(const unsigned char* p) { const U4a8 a = *(const U4a8*)p; const uint2 c = *(const uint2*)(p + 16); v6u q; q[0] = a.a; q[1] = a.b; q[2] = a.c; q[3] = a.d; q[4] = c.x; q[5] = c.y; return q; }
DI void phase_peer_out(const Params& p, char* lds) {
  char* ws = p.ws;
  const int tid = otid(), lane = tid & 63, wave = tid >> 6, hb = lane >> 5, l5 = lane & 31;
  int* sidx = (int*)lds + wave * 384; float* sw = (float*)(sidx + 128);
  const u16* H = (const u16*)(ws + OFF_H); const unsigned* TV = (const unsigned*)(ws + OFF_TOPV);
  const unsigned char* U6 = (const unsigned char*)(ws + OFF_U8) + 24 * l5; const unsigned char* V6 = (const unsigned char*)(ws + OFF_V8) + 24 * l5;
  const float* USC = (const float*)(ws + OFF_USC); const float* VSC = (const float*)(ws + OFF_VSC);
  const float* g3 = p.in[23]; const float* b3 = p.in[24];
  int ci = 0, cj = 0; const bool cval = lane < 50;
  if (cval) { int rem = lane, i = 0; while (true) { const int cnt = 16 / (i + 1); if (rem < cnt) break; rem -= cnt; ++i; } ci = i; cj = rem; }
  const int flat = ci * 16 + cj;
  for (int t = blockIdx.x * 8 + wave; t < T_TOK; t += gridDim.x * 8) {
    f32x2 x2[16];
#pragma unroll
    for (int i = 0; i < 4; ++i) {
      const uint4 hv = *(const uint4*)(H + (size_t)t * 1024 + 32 * l5 + 8 * i);
      x2[4 * i] = f32x2{bflo(hv.x), bfhi(hv.x)}; x2[4 * i + 1] = f32x2{bflo(hv.y), bfhi(hv.y)}; x2[4 * i + 2] = f32x2{bflo(hv.z), bfhi(hv.z)}; x2[4 * i + 3] = f32x2{bflo(hv.w), bfhi(hv.w)};
    }
    float hval[8]; int hidx[8];
#pragma unroll
    for (int hq = 0; hq < 8; ++hq) {
      const unsigned ka = TV[(size_t)t * 256 + (2 * hq) * 16 + ci], kb = TV[(size_t)t * 256 + (2 * hq + 1) * 16 + cj];
      const float va = __uint_as_float(ka & 0xFFFFFF80u), vb = __uint_as_float(kb & 0xFFFFFF80u);
      const int ia = 127 - (int)(ka & 127u), ib = 127 - (int)(kb & 127u);
      hval[hq] = cval ? va + vb : -INFINITY; hidx[hq] = ia * 128 + ib;
    }
#pragma unroll
    for (int hq = 0; hq < 8; ++hq) {
      const float val = hval[hq];
      int rank = 0;
      rank_steps10<0>(val, flat, rank); rank_steps10<10>(val, flat, rank); rank_steps10<20>(val, flat, rank); rank_steps10<30>(val, flat, rank); rank_steps10<40>(val, flat, rank);
      if (cval && rank < 16) { sidx[hq * 16 + rank] = hidx[hq]; sw[hq * 16 + rank] = val; }
    }
    int el[2]; float gl[2];
#pragma unroll
    for (int grp = 0; grp < 2; ++grp) {
      el[grp] = sidx[grp * 64 + lane];
      const float sc = sw[grp * 64 + lane];
      float mx = sc; for (int o = 8; o; o >>= 1) mx = fmaxf(mx, __shfl_xor(mx, o));
      const float e = __expf(sc - mx);
      float sm = e; for (int o = 8; o; o >>= 1) sm += __shfl_xor(sm, o);
      gl[grp] = e * __builtin_amdgcn_rcpf(sm);
    }
#pragma unroll
    for (int hf = 0; hf < 2; ++hf) {
      float pd[32];
#pragma unroll
      for (int kb = 0; kb < 4; ++kb) {
        v6u qb[8];
#pragma unroll
        for (int k = 0; k < 8; ++k) {
          const int e0 = __builtin_amdgcn_readlane(el[0], hf * 32 + kb * 8 + k), e1 = __builtin_amdgcn_readlane(el[1], hf * 32 + kb * 8 + k);
          qb[k] = load6(U6 + (size_t)(hb ? e1 : e0) * 768);
        }
#pragma unroll
        for (int k = 0; k < 8; ++k) {
          const v32f f = __builtin_amdgcn_cvt_scalef32_pk32_f32_fp6(qb[k], 1.0f);
          f32x2 a = f32x2{f[0], f[1]} * x2[0];
#pragma unroll
          for (int i = 1; i < 16; ++i) a = f32x2{f[2 * i], f[2 * i + 1]} * x2[i] + a;
          pd[kb * 8 + k] = a.x + a.y;
        }
      }
#pragma unroll
      for (int off = 16; off >= 1; off >>= 1) {
        const bool up = (lane & off) != 0;
#pragma unroll
        for (int i = 0; i < off; ++i) {
          const float send = up ? pd[i] : pd[i + off];
          const float keep = up ? pd[i + off] : pd[i];
          pd[i] = keep + __shfl_xor(send, off);
        }
      }
      sw[hb * 64 + hf * 32 + l5] = pd[0];
    }
    float coefv[2];
#pragma unroll
    for (int grp = 0; grp < 2; ++grp) {
      const float dt = sw[grp * 64 + lane] * USC[el[grp]];
      const float ge = 0.5f * dt * (1.f + erff(dt * 0.7071067811865476f));
      coefv[grp] = gl[grp] * ge * VSC[el[grp]];
    }
    f32x2 o2[16];
#pragma unroll
    for (int i = 0; i < 16; ++i) o2[i] = f32x2{0.f, 0.f};
#pragma unroll
    for (int kb = 0; kb < 8; ++kb) {
      v6u qb[8];
#pragma unroll
      for (int k = 0; k < 8; ++k) {
        const int e0 = __builtin_amdgcn_readlane(el[0], kb * 8 + k), e1 = __builtin_amdgcn_readlane(el[1], kb * 8 + k);
        qb[k] = load6(V6 + (size_t)(hb ? e1 : e0) * 768);
      }
#pragma unroll
      for (int k = 0; k < 8; ++k) {
        const float c0 = __uint_as_float(__builtin_amdgcn_readlane(__float_as_uint(coefv[0]), kb * 8 + k)), c1 = __uint_as_float(__builtin_amdgcn_readlane(__float_as_uint(coefv[1]), kb * 8 + k));
        const float cf = hb ? c1 : c0;
        const f32x2 c2 = {cf, cf};
        const v32f f = __builtin_amdgcn_cvt_scalef32_pk32_f32_fp6(qb[k], 1.0f);
#pragma unroll
        for (int i = 0; i < 16; ++i) o2[i] = f32x2{f[2 * i], f[2 * i + 1]} * c2 + o2[i];
      }
    }
    float s = 0.f;
#pragma unroll
    for (int i = 0; i < 16; ++i) {
      o2[i].x += __shfl_xor(o2[i].x, 32); o2[i].y += __shfl_xor(o2[i].y, 32);
      o2[i] = x2[i] * f32x2{ALPHA, ALPHA} + o2[i]; s += o2[i].x + o2[i].y;
    }
    for (int o = 16; o; o >>= 1) s += __shfl_xor(s, o);
    const float mu = s * (1.f / 1024.f);
    float q = 0.f;
#pragma unroll
    for (int i = 0; i < 16; ++i) { const float a = o2[i].x - mu, bq = o2[i].y - mu; q += a * a + bq * bq; }
    for (int o = 16; o; o >>= 1) q += __shfl_xor(q, o);
    const float rstd = rsqrtf(q * (1.f / 1024.f) + LN_EPS);
    float* orow = p.out + (size_t)t * 1024 + 32 * l5 + 16 * hb;
#pragma unroll
    for (int q4 = 0; q4 < 4; ++q4) {
      const float4 gg = *(const float4*)(g3 + 32 * l5 + 16 * hb + 4 * q4), bb = *(const float4*)(b3 + 32 * l5 + 16 * hb + 4 * q4);
      const f32x2 a0 = hb ? o2[8 + 2 * q4] : o2[2 * q4], a1 = hb ? o2[8 + 2 * q4 + 1] : o2[2 * q4 + 1];
      float4 o;
      o.x = (a0.x - mu) * rstd * gg.x + bb.x; o.y = (a0.y - mu) * rstd * gg.y + bb.y;
      o.z = (a1.x - mu) * rstd * gg.z + bb.z; o.w = (a1.y - mu) * rstd * gg.w + bb.w;
      *(float4*)(orow + 4 * q4) = o;
    }
  }
}

#define XB_TMO      128
#define XB_XCNT(j)  (256  + 64 * (j))
#define XB_XSUB(j)  (1280 + 64 * (j))
#define XB_XGEN(j)  (2304 + 64 * (j))
#define XB_TOP      3328
#define XB_TOPGEN   3392
#define XCD_BAR_WORDS 3456
#define XB_SPIN_CAP (1u << 18)
#define LAS __attribute__((address_space(3)))
DI unsigned xb_ld(unsigned* p)              { return __hip_atomic_load(p, __ATOMIC_RELAXED, __HIP_MEMORY_SCOPE_AGENT); }
DI unsigned xb_add(unsigned* p, unsigned v) { return __hip_atomic_fetch_add(p, v, __ATOMIC_RELAXED, __HIP_MEMORY_SCOPE_AGENT); }
DI unsigned xb_xcc_id() { return (unsigned)__builtin_amdgcn_s_getreg((3 << 11) | 20) & 0xFu; }
#define XB_SPIN(cond, bar) do { unsigned _sp = 0; while (cond) { __builtin_amdgcn_s_sleep(1); \
    if ((++_sp & 255u) == 0u) { if (xb_ld(&(bar)[XB_TMO])) break; if (_sp > XB_SPIN_CAP) { atomicAdd(&(bar)[XB_TMO], 1u); break; } } } } while (0)
struct XcdBarrier { unsigned* bar; unsigned x; volatile LAS unsigned* st; };
DI XcdBarrier xcd_barrier_post(unsigned* bar, volatile LAS unsigned* st) {
  XcdBarrier b; b.bar = bar; b.x = xb_xcc_id(); b.st = st;
  if (threadIdx.x == 0) (void)xb_add(&bar[XB_XCNT(b.x)], 1u);
  return b;
}
DI void xcd_barrier_complete(unsigned* bar, unsigned x, unsigned& nloc, unsigned& nx) {
  const unsigned G = gridDim.x * gridDim.y * gridDim.z;
  unsigned sum, cnt, mine, sp = 0u;
  for (;;) {
    sum = 0u; cnt = 0u; mine = 0u;
#pragma unroll
    for (unsigned j = 0; j < 16; ++j) { const unsigned c = xb_ld(&bar[XB_XCNT(j)]); sum += c; cnt += (c > 0u) ? 1u : 0u; mine = (j == x) ? c : mine; }
    if (sum == G) break;
    __builtin_amdgcn_s_sleep(1);
    if ((++sp & 255u) == 0u) { if (xb_ld(&bar[XB_TMO])) break; if (sp > XB_SPIN_CAP) { atomicAdd(&bar[XB_TMO], 1u); break; } }
  }
  nloc = mine > 0u ? mine : 1u; nx = cnt > 0u ? cnt : 1u;
}
DI void xcd_barrier(const XcdBarrier& b) {
  asm volatile("s_waitcnt vmcnt(0)" ::: "memory");
  __syncthreads();
  if (threadIdx.x == 0) {
    unsigned* bar = b.bar;
    __builtin_amdgcn_s_waitcnt(0);
    unsigned nloc = b.st[0], nx = b.st[1];
    if (nloc == 0u) { xcd_barrier_complete(bar, b.x, nloc, nx); b.st[0] = nloc; b.st[1] = nx; }
    const unsigned old = xb_add(&bar[XB_XSUB(b.x)], 1u);
    const unsigned gen = old / nloc;
    if (old + 1u == (gen + 1u) * nloc) {
      __builtin_amdgcn_fence(__ATOMIC_RELEASE, "agent");
      asm volatile("s_waitcnt vmcnt(0)" ::: "memory");
      const unsigned og = xb_add(&bar[XB_TOP], 1u);
      const unsigned tg = og / nx;
      if (og + 1u == (tg + 1u) * nx) xb_add(&bar[XB_TOPGEN], 1u);
      else XB_SPIN(xb_ld(&bar[XB_TOPGEN]) == tg, bar);
      __builtin_amdgcn_fence(__ATOMIC_ACQUIRE, "agent");
      xb_add(&bar[XB_XGEN(b.x)], 1u);
      asm volatile("s_waitcnt vmcnt(0)" ::: "memory");
    } else {
      XB_SPIN(xb_ld(&bar[XB_XGEN(b.x)]) == gen, bar);
      __builtin_amdgcn_fence(__ATOMIC_ACQUIRE, "agent");
      asm volatile("s_waitcnt vmcnt(0)" ::: "memory");
    }
  }
  __syncthreads();
}

__global__ void __launch_bounds__(512) mega(Params p) {
  extern __shared__ __attribute__((aligned(16))) char lds[];
  cg::grid_group grid = cg::this_grid();
  char* ws = p.ws;
  u16* H = (u16*)(ws + OFF_H);
  u16* Zb = (u16*)(ws + OFF_Z);
  unsigned* barw = (unsigned*)(ws + OFF_BAR);
  volatile LAS unsigned* xst = (volatile LAS unsigned*)(LAS unsigned*)(lds + LDS_BYTES - 16);
  if (blockIdx.x == 0) for (int i = threadIdx.x; i < XCD_BAR_WORDS; i += 512) barw[i] = 0u;
  if (threadIdx.x == 0) { xst[0] = 0u; xst[1] = 0u; }
  for (int rep = 0; rep < 1 + ((PROBE_MASK >> 0) & 1); ++rep) {
    transpose_w(p.in[4], (u16*)(ws + OFF_WIN), 3592, 3584, (float*)lds);
    transpose_w(p.in[11], (u16*)(ws + OFF_WOUT), 1024, 1024, (float*)lds);
    transpose_w(p.in[14], (u16*)(ws + OFF_WQ), 1024, 1024, (float*)lds);
    transpose_w(p.in[15], (u16*)(ws + OFF_WKV), 2048, 2048, (float*)lds);
    transpose_w(p.in[16], (u16*)(ws + OFF_WO), 1024, 1024, (float*)lds);
    transpose_w(p.in[19], (u16*)(ws + OFF_WPQ), 2048, 2048, (float*)lds);
    convert_fp6_rows(p.in[21], (unsigned char*)(ws + OFF_U8), (float*)(ws + OFF_USC));
    convert_fp6_rows(p.in[22], (unsigned char*)(ws + OFF_V8), (float*)(ws + OFF_VSC));
    convert_bf16(p.in[20], (u16*)(ws + OFF_SK), (size_t)2 * 128 * 128 / 4);
    convert_bf16(p.in[1], (u16*)(ws + OFF_MEMB), (size_t)2048 * 1024 / 4);
    ln_in_rows(p.in[0], p.in[2], p.in[3], p.in[4], H, (float*)(ws + OFF_G), (float*)lds);
  }
  grid.sync();
  const XcdBarrier xb = xcd_barrier_post(barw, xst);
  if (PROBE_MASK & 0x10000) { for (int i = 0; i < 16; ++i) xcd_barrier(xb); }
  if ((PHASE_EN >> 1) & 1)
    { phase_inproj(p, lds); xcd_barrier(xb); }
  if ((PROBE_MASK >> 1) & 1) { phase_inproj(p, lds); xcd_barrier(xb); }
  if ((PHASE_EN >> 2) & 1)
    { phase_mixA(p, lds); xcd_barrier(xb); }
  if ((PROBE_MASK >> 2) & 1) { phase_mixA(p, lds); xcd_barrier(xb); }
  if ((PROBE_MASK >> 13) & 1) { for (int it = blockIdx.x; it < 4096; it += gridDim.x) mlstmA_item(p, lds, it); xcd_barrier(xb); }
  if ((PROBE_MASK >> 14) & 1) { for (int it = blockIdx.x; it < 2048; it += gridDim.x) attn_item(p, lds, it); xcd_barrier(xb); }
  if ((PHASE_EN >> 11) & 1)
    { phase_mlstm_scan(p); xcd_barrier(xb); }
  if ((PHASE_EN >> 12) & 1)
    { phase_mixC(p, lds); xcd_barrier(xb); }
  if ((PROBE_MASK >> 12) & 1) { phase_mixC(p, lds); xcd_barrier(xb); }
  if ((PHASE_EN >> 3) & 1)
    { phase_gemm1024<1>((const u16*)(ws + OFF_MIX), (const u16*)(ws + OFF_WOUT), Zb, H, lds); xcd_barrier(xb); }
  if ((PROBE_MASK >> 3) & 1) { phase_gemm1024<1>((const u16*)(ws + OFF_MIX), (const u16*)(ws + OFF_WOUT), Zb, H, lds); xcd_barrier(xb); }
  { ln_rows_b(Zb, p.in[12], p.in[13], H); xcd_barrier(xb); }
  if ((PROBE_MASK >> 4) & 1) { ln_rows_b(Zb, p.in[12], p.in[13], H); xcd_barrier(xb); }
  if ((PHASE_EN >> 5) & 1)
    { phase_gemm1024<0>(H, (const u16*)(ws + OFF_WQ), (u16*)(ws + OFF_XQ), nullptr, lds); xcd_barrier(xb); }
  if ((PROBE_MASK >> 5) & 1) { phase_gemm1024<0>(H, (const u16*)(ws + OFF_WQ), (u16*)(ws + OFF_XQ), nullptr, lds); xcd_barrier(xb); }
  if ((PHASE_EN >> 6) & 1)
    { phase_xattn(p, lds); xcd_barrier(xb); }
  if ((PROBE_MASK >> 6) & 1) { phase_xattn(p, lds); xcd_barrier(xb); }
  if ((PHASE_EN >> 7) & 1)
    { phase_gemm1024<1>((const u16*)(ws + OFF_XO), (const u16*)(ws + OFF_WO), Zb, H, lds); xcd_barrier(xb); }
  if ((PROBE_MASK >> 7) & 1) { phase_gemm1024<1>((const u16*)(ws + OFF_XO), (const u16*)(ws + OFF_WO), Zb, H, lds); xcd_barrier(xb); }
  { ln_rows_b(Zb, p.in[17], p.in[18], H); xcd_barrier(xb); }
  if ((PROBE_MASK >> 8) & 1) { ln_rows_b(Zb, p.in[17], p.in[18], H); xcd_barrier(xb); }
  if ((PHASE_EN >> 9) & 1)
    { phase_peer_query(p, lds); xcd_barrier(xb); }
  if ((PROBE_MASK >> 9) & 1) { phase_peer_query(p, lds); xcd_barrier(xb); }
  if ((PHASE_EN >> 10) & 1)
    { phase_peer_out(p, lds); }
  if ((PROBE_MASK >> 10) & 1) { phase_peer_out(p, lds); }
}

extern "C" void kernel_launch(void* const* d_in, const int* in_sizes, int n_in, void* d_out, int out_size, void* d_ws, size_t ws_size, hipStream_t stream) {
  static int grid_blocks = 0;
  if (grid_blocks == 0) {
    if (n_in != 25 || out_size != T_TOK * 1024 || ws_size < WS_NEED) { fprintf(stderr, "kernel_launch: unexpected shapes (n_in %d out %d ws %zu)\n", n_in, out_size, ws_size); grid_blocks = -1; return; }
    int dev = 0, cus = 0, per_cu = 0;
    hipGetDevice(&dev);
    hipDeviceGetAttribute(&cus, hipDeviceAttributeMultiprocessorCount, dev);
    if (hipFuncSetAttribute((const void*)mega, hipFuncAttributeMaxDynamicSharedMemorySize, LDS_BYTES) != hipSuccess) { fprintf(stderr, "hipFuncSetAttribute failed\n"); grid_blocks = -1; return; }
    hipOccupancyMaxActiveBlocksPerMultiprocessor(&per_cu, (const void*)mega, 512, LDS_BYTES);
    if (per_cu < 1) { fprintf(stderr, "occupancy query returned %d\n", per_cu); per_cu = 1; }
    grid_blocks = cus * per_cu;
  }
  if (grid_blocks < 0) return;
  Params p{};
  for (int i = 0; i < 25; ++i) p.in[i] = (const float*)d_in[i];
  p.out = (float*)d_out; p.ws = (char*)d_ws;
  void* args[] = {&p};
  hipError_t e = hipLaunchCooperativeKernel((const void*)mega, dim3(grid_blocks), dim3(512), args, LDS_BYTES, stream);
  if (e != hipSuccess) fprintf(stderr, "cooperative launch failed: %s (grid %d)\n", hipGetErrorString(e), grid_blocks);
}
```

```cpp
#include <hip/hip_runtime.h>
#include <hip/hip_cooperative_groups.h>
#include <cstdio>
namespace cg = cooperative_groups;

#ifndef PHASE_EN
#define PHASE_EN 0xFFFF
#endif
#ifndef PROBE_MASK
#define PROBE_MASK 0
#endif
#ifndef STAGE_MASK
#define STAGE_MASK 7
#endif

#define DI __device__ __forceinline__
typedef unsigned short u16;
typedef __attribute__((ext_vector_type(8))) short bf16x8;
typedef __attribute__((ext_vector_type(16))) float f32x16;
typedef __attribute__((ext_vector_type(2))) float f32x2;
#define MFMA(a, b, c) __builtin_amdgcn_mfma_f32_32x32x16_bf16((a), (b), (c), 0, 0, 0)

constexpr int T_TOK = 65536;
constexpr int SEQ = 8192;
constexpr float ALPHA = 1.189207115002721f;
constexpr float LN_EPS = 1e-5f;
constexpr int LDS_BYTES = 143360;
constexpr size_t MB = 1u << 20;
constexpr size_t OFF_WIN = 0, OFF_WOUT = 8 * MB, OFF_WQ = 10 * MB, OFF_WO = 12 * MB, OFF_WKV = 14 * MB, OFF_WPQ = 18 * MB,
                 OFF_SK = 22 * MB, OFF_MEMB = 23 * MB, OFF_KX = 27 * MB, OFF_VTX = 31 * MB, OFF_U8 = 35 * MB, OFF_V8 = 51 * MB, OFF_USC = 67 * MB, OFF_VSC = 68 * MB,
                 OFF_G = 99 * MB, OFF_H = 104 * MB, OFF_PA = 232 * MB, OFF_PM = 360 * MB, OFF_Z = 232 * MB, OFF_VTA = 488 * MB,
                 OFF_VTM = 552 * MB, OFF_XQ = 488 * MB, OFF_PO = 616 * MB, OFF_MIX = 680 * MB, OFF_XO = 680 * MB,
                 OFF_TOPV = 808 * MB, OFF_TOPI = 872 * MB, OFF_KVS = 808 * MB, OFF_KSUM = 936 * MB, OFF_CSC = 938 * MB, OFF_BAR = 939 * MB, WS_NEED = 940 * MB;

struct Params {
  const float* in[25];
  float* out;
  char* ws;
};

DI int otid() { int t = __builtin_amdgcn_workitem_id_x(); asm volatile("" : "+v"(t)); return t; }
typedef __bf16 bf16v2 __attribute__((ext_vector_type(2)));
DI unsigned pack2(float a, float b) { const f32x2 v = {a, b}; return __builtin_bit_cast(unsigned, __builtin_convertvector(v, bf16v2)); }
DI u16 f2bf(float x) { return (u16)(pack2(x, 0.f) & 0xffffu); }
DI float bf2f(u16 h) { return __uint_as_float(((unsigned)h) << 16); }
DI float bflo(unsigned w) { return __uint_as_float(w << 16); }
DI float bfhi(unsigned w) { return __uint_as_float(w & 0xffff0000u); }
DI float wsum(float v) { for (int o = 32; o; o >>= 1) v += __shfl_xor(v, o); return v; }
DI float wmax(float v) { for (int o = 32; o; o >>= 1) v = fmaxf(v, __shfl_xor(v, o)); return v; }
DI int perm23(int i) { return (i & 0x13) | (((i >> 3) & 1) << 2) | (((i >> 2) & 1) << 3); }
DI f32x16 zero16() { f32x16 z; for (int i = 0; i < 16; ++i) z[i] = 0.f; return z; }
DI bf16x8 ldfrag(const u16* p) { return *(const bf16x8*)p; }
DI void unpack8(const uint4& r, float* o) {
  o[0] = bflo(r.x); o[1] = bfhi(r.x); o[2] = bflo(r.y); o[3] = bfhi(r.y); o[4] = bflo(r.z); o[5] = bfhi(r.z); o[6] = bflo(r.w); o[7] = bfhi(r.w);
}

DI void transpose_w(const float* __restrict__ src, u16* __restrict__ dst, int N, int Npad, float* tl) {
  const int ntn = Npad >> 6, ntiles = 16 * ntn;
  for (int t = blockIdx.x; t < ntiles; t += gridDim.x) {
    const int kt = t / ntn, nt = t - kt * ntn, k0 = kt * 64, n0 = nt * 64;
    for (int e = otid(); e < 4096; e += 512) { int r = e >> 6, c = e & 63, n = n0 + c; tl[r * 65 + c] = (n < N) ? src[(size_t)(k0 + r) * N + n] : 0.f; }
    __syncthreads();
    for (int e = otid(); e < 4096; e += 512) { int r = e >> 6, c = e & 63; dst[(size_t)(n0 + r) * 1024 + k0 + c] = f2bf(tl[c * 65 + r]); }
    __syncthreads();
  }
}
DI void convert_bf16(const float* __restrict__ src, u16* __restrict__ dst, size_t n4) {
  const size_t stride = (size_t)gridDim.x * 512;
  for (size_t i = (size_t)blockIdx.x * 512 + otid(); i < n4; i += stride) {
    float4 v = ((const float4*)src)[i];
    uint2 o; o.x = pack2(v.x, v.y); o.y = pack2(v.z, v.w);
    ((uint2*)dst)[i] = o;
  }
}

DI void convert_fp8_rows(const float* __restrict__ src, unsigned char* __restrict__ dst, float* __restrict__ invscale) {
  const int lane = otid() & 63, wave = otid() >> 6;
  for (int row = blockIdx.x * 8 + wave; row < 16384; row += gridDim.x * 8) {
    const float* r = src + (size_t)row * 1024 + 16 * lane;
    float4 v[4];
    float am = 0.f;
    for (int i = 0; i < 4; ++i) { v[i] = *(const float4*)(r + 4 * i); am = fmaxf(am, fmaxf(fmaxf(fabsf(v[i].x), fabsf(v[i].y)), fmaxf(fabsf(v[i].z), fabsf(v[i].w)))); }
    am = wmax(am);
    const float sc = am > 0.f ? 256.f / am : 1.f;
    uint4 o; unsigned w[4];
    for (int i = 0; i < 4; ++i) { int t = 0; t = __builtin_amdgcn_cvt_pk_fp8_f32(v[i].x * sc, v[i].y * sc, t, false); t = __builtin_amdgcn_cvt_pk_fp8_f32(v[i].z * sc, v[i].w * sc, t, true); w[i] = (unsigned)t; }
    o.x = w[0]; o.y = w[1]; o.z = w[2]; o.w = w[3];
    *(uint4*)(dst + (size_t)row * 1024 + 16 * lane) = o;
    if (lane == 0) invscale[row] = am > 0.f ? am * (1.f / 256.f) : 1.f;
  }
}
typedef __attribute__((ext_vector_type(6))) unsigned v6u;
typedef __attribute__((ext_vector_type(16))) float v16f;
typedef __attribute__((ext_vector_type(32))) float v32f;
DI void convert_fp6_rows(const float* __restrict__ src, unsigned char* __restrict__ dst, float* __restrict__ invscale) {
  const int lane = otid() & 63, wave = otid() >> 6, hb = lane >> 5, l5 = lane & 31;
  for (int row = (blockIdx.x * 8 + wave) * 2 + hb; row < 16384; row += gridDim.x * 16) {
    const float* r = src + (size_t)row * 1024 + 32 * l5;
    v16f x, y;
    float am = 0.f;
#pragma unroll
    for (int i = 0; i < 4; ++i) {
      const float4 a = *(const float4*)(r + 4 * i), b = *(const float4*)(r + 16 + 4 * i);
      x[2 * i] = a.x; y[2 * i] = a.y; x[2 * i + 1] = a.z; y[2 * i + 1] = a.w; x[8 + 2 * i] = b.x; y[8 + 2 * i] = b.y; x[8 + 2 * i + 1] = b.z; y[8 + 2 * i + 1] = b.w;
      am = fmaxf(am, fmaxf(fmaxf(fabsf(a.x), fabsf(a.y)), fmaxf(fabsf(a.z), fabsf(a.w))));
      am = fmaxf(am, fmaxf(fmaxf(fabsf(b.x), fabsf(b.y)), fmaxf(fabsf(b.z), fabsf(b.w))));
    }
    for (int o = 16; o; o >>= 1) am = fmaxf(am, __shfl_xor(am, o));
    const float sc = am > 0.f ? 7.0f / am : 1.f;
#pragma unroll
    for (int i = 0; i < 16; ++i) { x[i] *= sc; y[i] *= sc; }
    const v6u q = __builtin_amdgcn_cvt_scalef32_2xpk16_fp6_f32(x, y, 1.0f);
    unsigned* d = (unsigned*)(dst + (size_t)row * 768 + 24 * l5);
    *(uint2*)d = make_uint2(q[0], q[1]); *(uint2*)(d + 2) = make_uint2(q[2], q[3]); *(uint2*)(d + 4) = make_uint2(q[4], q[5]);
    if (l5 == 0) invscale[row] = am > 0.f ? am * (1.f / 7.0f) : 1.f;
  }
}

DI void ln_rows(const float* __restrict__ src, const float* __restrict__ g, const float* __restrict__ bta, u16* __restrict__ dst) {
  const int lane = otid() & 63, wave = otid() >> 6;
  for (int row = blockIdx.x * 8 + wave; row < T_TOK; row += gridDim.x * 8) {
    float4 v[4];
    float s = 0.f;
    for (int i = 0; i < 4; ++i) { v[i] = *(const float4*)(src + (size_t)row * 1024 + i * 256 + lane * 4); s += v[i].x + v[i].y + v[i].z + v[i].w; }
    const float mu = wsum(s) * (1.f / 1024.f);
    float q = 0.f;
    for (int i = 0; i < 4; ++i) { float a = v[i].x - mu, b = v[i].y - mu, c = v[i].z - mu, d = v[i].w - mu; q += a * a + b * b + c * c + d * d; }
    const float rstd = rsqrtf(wsum(q) * (1.f / 1024.f) + LN_EPS);
    for (int i = 0; i < 4; ++i) {
      const int c0 = i * 256 + lane * 4;
      float4 gg = *(const float4*)(g + c0), bb = *(const float4*)(bta + c0);
      uint2 o;
      o.x = pack2((v[i].x - mu) * rstd * gg.x + bb.x, (v[i].y - mu) * rstd * gg.y + bb.y);
      o.y = pack2((v[i].z - mu) * rstd * gg.z + bb.z, (v[i].w - mu) * rstd * gg.w + bb.w);
      *(uint2*)(dst + (size_t)row * 1024 + c0) = o;
    }
  }
}
DI void ln_rows_b(const u16* __restrict__ Zb, const float* __restrict__ g, const float* __restrict__ bta, u16* __restrict__ H) {
  const int lane = otid() & 63, wave = otid() >> 6;
  float gg[16], bb[16];
  for (int i = 0; i < 4; ++i) {
    const float4 g4 = *(const float4*)(g + lane * 16 + 4 * i), b4 = *(const float4*)(bta + lane * 16 + 4 * i);
    gg[4*i] = g4.x; gg[4*i+1] = g4.y; gg[4*i+2] = g4.z; gg[4*i+3] = g4.w; bb[4*i] = b4.x; bb[4*i+1] = b4.y; bb[4*i+2] = b4.z; bb[4*i+3] = b4.w;
  }
  const int stride = gridDim.x * 8;
  for (int row0 = blockIdx.x * 8 + wave; row0 < T_TOK; row0 += stride * 4) {
    uint4 r[4][2];
#pragma unroll
    for (int j = 0; j < 4; ++j) {
      const int row = row0 + j * stride;
      if (row < T_TOK) { r[j][0] = *(const uint4*)(Zb + (size_t)row * 1024 + lane * 16); r[j][1] = *(const uint4*)(Zb + (size_t)row * 1024 + lane * 16 + 8); }
    }
#pragma unroll
    for (int j = 0; j < 4; ++j) {
      const int row = row0 + j * stride;
      if (row < T_TOK) {
        float v[16];
        unpack8(r[j][0], v); unpack8(r[j][1], v + 8);
        float s = 0.f;
#pragma unroll
        for (int i = 0; i < 16; ++i) s += v[i];
        const float mu = wsum(s) * (1.f / 1024.f);
        float q = 0.f;
#pragma unroll
        for (int i = 0; i < 16; ++i) { float a = v[i] - mu; q += a * a; }
        const float rstd = rsqrtf(wsum(q) * (1.f / 1024.f) + LN_EPS);
        uint4 o0, o1;
        o0.x = pack2((v[0] - mu) * rstd * gg[0] + bb[0], (v[1] - mu) * rstd * gg[1] + bb[1]); o0.y = pack2((v[2] - mu) * rstd * gg[2] + bb[2], (v[3] - mu) * rstd * gg[3] + bb[3]);
        o0.z = pack2((v[4] - mu) * rstd * gg[4] + bb[4], (v[5] - mu) * rstd * gg[5] + bb[5]); o0.w = pack2((v[6] - mu) * rstd * gg[6] + bb[6], (v[7] - mu) * rstd * gg[7] + bb[7]);
        o1.x = pack2((v[8] - mu) * rstd * gg[8] + bb[8], (v[9] - mu) * rstd * gg[9] + bb[9]); o1.y = pack2((v[10] - mu) * rstd * gg[10] + bb[10], (v[11] - mu) * rstd * gg[11] + bb[11]);
        o1.z = pack2((v[12] - mu) * rstd * gg[12] + bb[12], (v[13] - mu) * rstd * gg[13] + bb[13]); o1.w = pack2((v[14] - mu) * rstd * gg[14] + bb[14], (v[15] - mu) * rstd * gg[15] + bb[15]);
        *(uint4*)(H + (size_t)row * 1024 + lane * 16) = o0;
        *(uint4*)(H + (size_t)row * 1024 + lane * 16 + 8) = o1;
      }
    }
  }
}
DI void ln_in_rows(const float* __restrict__ src, const float* __restrict__ g, const float* __restrict__ bta, const float* __restrict__ w_in, u16* __restrict__ dst, float* __restrict__ G, float* Wg) {
  const int lane = otid() & 63, wave = otid() >> 6;
  for (int e = otid(); e < 8192; e += 512) Wg[e] = w_in[(size_t)(e >> 3) * 3592 + 3584 + (e & 7)];
  __syncthreads();
  float4 nv[4];
  { const int row = blockIdx.x * 8 + wave; for (int i = 0; i < 4; ++i) nv[i] = *(const float4*)(src + (size_t)row * 1024 + i * 256 + lane * 4); }
  for (int row = blockIdx.x * 8 + wave; row < T_TOK; row += gridDim.x * 8) {
    float4 v[4];
    float s = 0.f;
    for (int i = 0; i < 4; ++i) { v[i] = nv[i]; s += v[i].x + v[i].y + v[i].z + v[i].w; }
    { const int nrow = row + gridDim.x * 8; if (nrow < T_TOK) for (int i = 0; i < 4; ++i) nv[i] = *(const float4*)(src + (size_t)nrow * 1024 + i * 256 + lane * 4); }
    const float mu = wsum(s) * (1.f / 1024.f);
    float q = 0.f;
    for (int i = 0; i < 4; ++i) { float a = v[i].x - mu, b = v[i].y - mu, c = v[i].z - mu, d = v[i].w - mu; q += a * a + b * b + c * c + d * d; }
    const float rstd = rsqrtf(wsum(q) * (1.f / 1024.f) + LN_EPS);
    float pg[8];
#pragma unroll
    for (int j = 0; j < 8; ++j) pg[j] = 0.f;
#pragma unroll
    for (int i = 0; i < 4; ++i) {
      const int c0 = i * 256 + lane * 4;
      float4 gg = *(const float4*)(g + c0), bb = *(const float4*)(bta + c0);
      float y[4];
      y[0] = (v[i].x - mu) * rstd * gg.x + bb.x; y[1] = (v[i].y - mu) * rstd * gg.y + bb.y; y[2] = (v[i].z - mu) * rstd * gg.z + bb.z; y[3] = (v[i].w - mu) * rstd * gg.w + bb.w;
      uint2 o; o.x = pack2(y[0], y[1]); o.y = pack2(y[2], y[3]);
      *(uint2*)(dst + (size_t)row * 1024 + c0) = o;
#pragma unroll
      for (int e = 0; e < 4; ++e) {
        const float4 w0 = *(const float4*)(Wg + (c0 + e) * 8), w1 = *(const float4*)(Wg + (c0 + e) * 8 + 4);
        pg[0] += y[e] * w0.x; pg[1] += y[e] * w0.y; pg[2] += y[e] * w0.z; pg[3] += y[e] * w0.w;
        pg[4] += y[e] * w1.x; pg[5] += y[e] * w1.y; pg[6] += y[e] * w1.z; pg[7] += y[e] * w1.w;
      }
    }
#pragma unroll
    for (int off = 32; off >= 8; off >>= 1) {
      const bool up = (lane & off) != 0;
      const int nkeep = off >> 3;
#pragma unroll
      for (int i = 0; i < 4; ++i) if (i < nkeep) {
        const float send = up ? pg[i] : pg[i + nkeep];
        const float keep = up ? pg[i + nkeep] : pg[i];
        pg[i] = keep + __shfl_xor(send, off);
      }
    }
    float tot = pg[0];
    tot += __shfl_xor(tot, 4); tot += __shfl_xor(tot, 2); tot += __shfl_xor(tot, 1);
    if ((lane & 7) == 0) G[(size_t)row * 8 + (lane >> 3)] = tot;
  }
}

typedef __attribute__((ext_vector_type(4))) float f32x4;
#define MFMA16(a, b, c) __builtin_amdgcn_mfma_f32_16x16x32_bf16((a), (b), (c), 0, 0, 0)
DI uint2 pack4(const f32x16& a, int g) { uint2 o; o.x = pack2(a[4 * g], a[4 * g + 1]); o.y = pack2(a[4 * g + 2], a[4 * g + 3]); return o; }
DI void stage_rc(int b, int& R, int& C) { const int st = b >> 10, sb = b & 1023, swz = sb ^ (((sb >> 9) & 1) << 5); R = (st >> 1) * 16 + (swz >> 6); C = (st & 1) * 32 + ((swz & 63) >> 1); }
constexpr int CT_LD = 264;
template <int SWAP>
DI void gemm256(const u16* __restrict__ Ab, const u16* __restrict__ Bb, const u16* __restrict__ nAb, const u16* __restrict__ nBb, bool first, bool has_next, f32x4 (&acc)[8][4], char* lds) {
  const int tid = otid(), wid = tid >> 6, lane = tid & 63, wr = wid >> 2, wc = wid & 3, fr = lane & 15, fq = lane >> 4;
  int goff[4];
#pragma unroll
  for (int i = 0; i < 4; ++i) { int R, C; stage_rc(wid * 1024 + i * 8192 + lane * 16, R, C); goff[i] = R * 1024 + C; }
#pragma unroll
  for (int m = 0; m < 8; ++m)
#pragma unroll
    for (int n = 0; n < 4; ++n) acc[m][n] = f32x4{0.f, 0.f, 0.f, 0.f};
  const int ob = fr * 64 + fq * 16, obs = ob ^ (((ob >> 9) & 1) << 5);
  const int aoff = wr * 16384 + obs, boff = 32768 + wc * 8192 + obs;
#define GLDS_STAGE(buf, pa, pb, kt) do { _Pragma("unroll") for (int i = 0; i < 4; ++i) { \
    __builtin_amdgcn_global_load_lds((const unsigned*)((pa) + goff[i] + (kt) * 64), (__attribute__((address_space(3))) unsigned*)(lds + (buf) * 65536 + wid * 1024 + i * 8192), 16, 0, 0); \
    __builtin_amdgcn_global_load_lds((const unsigned*)((pb) + goff[i] + (kt) * 64), (__attribute__((address_space(3))) unsigned*)(lds + (buf) * 65536 + 32768 + wid * 1024 + i * 8192), 16, 0, 0); } } while (0)
  if (first) {
    GLDS_STAGE(0, Ab, Bb, 0);
    asm volatile("s_waitcnt vmcnt(0)" ::: "memory");
    __syncthreads();
  }
#pragma unroll 1
  for (int t = 0; t < 16; ++t) {
    const int cur = t & 1;
    if (t < 15) GLDS_STAGE(cur ^ 1, Ab, Bb, t + 1);
    else if (has_next) GLDS_STAGE(0, nAb, nBb, 0);
    const char* sa = lds + cur * 65536 + aoff;
    const char* sb = lds + cur * 65536 + boff;
#pragma unroll
    for (int ks = 0; ks < 2; ++ks) {
      bf16x8 At[8], Bf[4];
#pragma unroll
      for (int m = 0; m < 8; ++m) At[m] = *(const bf16x8*)(sa + m * 2048 + ks * 1024);
#pragma unroll
      for (int n = 0; n < 4; ++n) Bf[n] = *(const bf16x8*)(sb + n * 2048 + ks * 1024);
#pragma unroll
      for (int m = 0; m < 8; ++m)
#pragma unroll
        for (int n = 0; n < 4; ++n) acc[m][n] = SWAP ? MFMA16(Bf[n], At[m], acc[m][n]) : MFMA16(At[m], Bf[n], acc[m][n]);
      __builtin_amdgcn_sched_group_barrier(0x100, 12, 0);
      __builtin_amdgcn_sched_group_barrier(0x008, 32, 0);
      __builtin_amdgcn_sched_barrier(0);
    }
    asm volatile("s_waitcnt vmcnt(0)" ::: "memory");
    __syncthreads();
  }
#undef GLDS_STAGE
}
DI void stage_acc(const f32x4 (&acc)[8][4], u16* Ct) {
  const int tid = otid(), wid = tid >> 6, lane = tid & 63, wr = wid >> 2, wc = wid & 3, fr = lane & 15, fq = lane >> 4;
#pragma unroll
  for (int m = 0; m < 8; ++m)
#pragma unroll
    for (int n = 0; n < 4; ++n) {
      uint2 o; o.x = pack2(acc[m][n][0], acc[m][n][1]); o.y = pack2(acc[m][n][2], acc[m][n][3]);
      *(uint2*)(Ct + (wr * 128 + m * 16 + fr) * CT_LD + wc * 64 + n * 16 + fq * 4) = o;
    }
}
template <int SWAP>
DI void store_acc(const f32x4 (&acc)[8][4], u16* __restrict__ dst, size_t ld) {
  const int tid = otid(), wid = tid >> 6, lane = tid & 63, wr = wid >> 2, wc = wid & 3, fr = lane & 15, fq = lane >> 4;
#pragma unroll
  for (int m = 0; m < 8; ++m)
#pragma unroll
    for (int n = 0; n < 4; ++n) {
      uint2 o; o.x = pack2(acc[m][n][0], acc[m][n][1]); o.y = pack2(acc[m][n][2], acc[m][n][3]);
      if (SWAP) *(uint2*)(dst + (size_t)(wr * 128 + m * 16 + fr) * ld + wc * 64 + n * 16 + fq * 4) = o;
      else *(uint2*)(dst + (size_t)(wc * 64 + n * 16 + fr) * ld + wr * 128 + m * 16 + fq * 4) = o;
    }
}
template <int SWAP, int MODE>
DI void epilogue_staged(const f32x4 (&acc)[8][4], char* lds, u16* __restrict__ dst, size_t ld, const u16* __restrict__ Hres) {
  const int tid = otid(), wid = tid >> 6, lane = tid & 63, wr = wid >> 2, wc = wid & 3, fr = lane & 15, fq = lane >> 4;
  u16* Ct = (u16*)(lds + 65536);
#pragma unroll
  for (int h = 0; h < 2; ++h) {
    if ((SWAP ? wr : (wc >> 1)) == h) {
#pragma unroll
      for (int m = 0; m < 8; ++m)
#pragma unroll
        for (int n = 0; n < 4; ++n) {
          uint2 o; o.x = pack2(acc[m][n][0], acc[m][n][1]); o.y = pack2(acc[m][n][2], acc[m][n][3]);
          if (SWAP) *(uint2*)(Ct + (m * 16 + fr) * CT_LD + wc * 64 + n * 16 + fq * 4) = o;
          else *(uint2*)(Ct + ((wc & 1) * 64 + n * 16 + fr) * CT_LD + wr * 128 + m * 16 + fq * 4) = o;
        }
    }
    __syncthreads();
#pragma unroll 4
    for (int i = 0; i < 8; ++i) {
      const int q = tid + 512 * i, r = q >> 5, c8 = (q & 31) * 8;
      uint4 v = *(const uint4*)(Ct + r * CT_LD + c8);
      const size_t o = (size_t)(h * 128 + r) * ld + c8;
      if (MODE == 1) {
        const uint4 hv = *(const uint4*)(Hres + o);
        float y[8], hx[8]; unpack8(v, y); unpack8(hv, hx);
        v.x = pack2(ALPHA * hx[0] + y[0], ALPHA * hx[1] + y[1]); v.y = pack2(ALPHA * hx[2] + y[2], ALPHA * hx[3] + y[3]);
        v.z = pack2(ALPHA * hx[4] + y[4], ALPHA * hx[5] + y[5]); v.w = pack2(ALPHA * hx[6] + y[6], ALPHA * hx[7] + y[7]);
      }
      *(uint4*)(dst + o) = v;
    }
    __syncthreads();
  }
}
DI int lds_byte8(int r, int c) { const int st = (r >> 4) * 2 + (c >> 5), ob = (r & 15) * 64 + (c & 31) * 2; return st * 1024 + (ob ^ (((ob >> 9) & 1) << 5)); }
template <int SWAP>
DI void gemm8p(const u16* __restrict__ Ab, const u16* __restrict__ Bb, f32x4 (&acc)[2][2][4][2], char* lds) {
  constexpr int K = 1024, BK = 64, HALF = 128, HTB = 128 * 64 * 2;
  const int tid = otid(), wid = tid >> 6, lane = tid & 63, wr = wid >> 2, wc = wid & 3, fr = lane & 15, fq = lane >> 4;
  int goff0;
  { int R, C; stage_rc(tid * 16, R, C); goff0 = R * K + C; }
#define SA8(b, h) (lds + ((b) * 2 + (h)) * HTB)
#define SB8(b, h) (lds + (4 + (b) * 2 + (h)) * HTB)
#define STAGE8(P, BASE, br, kt) do { _Pragma("unroll") for (int _i = 0; _i < 2; ++_i) \
    __builtin_amdgcn_global_load_lds((const unsigned*)((BASE) + (size_t)((br) + 64 * _i) * K + (kt) * BK + goff0), (__attribute__((address_space(3))) unsigned*)((P) + wid * 1024 + _i * 8192), 16, 0, 0); } while (0)
#define LDA8(dst, b, h) _Pragma("unroll") for (int m = 0; m < 4; ++m) _Pragma("unroll") for (int k = 0; k < 2; ++k) \
    dst[m][k] = *(const bf16x8*)(SA8(b, h) + lds_byte8(wr * 64 + m * 16 + fr, k * 32 + fq * 8))
#define LDB8(dst, b, h) _Pragma("unroll") for (int n = 0; n < 2; ++n) _Pragma("unroll") for (int k = 0; k < 2; ++k) \
    dst[n][k] = *(const bf16x8*)(SB8(b, h) + lds_byte8(wc * 32 + n * 16 + fr, k * 32 + fq * 8))
#define MMA8(ai, bj, At_, Bt_) do { __builtin_amdgcn_s_setprio(1); \
    _Pragma("unroll") for (int m = 0; m < 4; ++m) _Pragma("unroll") for (int n = 0; n < 2; ++n) _Pragma("unroll") for (int k = 0; k < 2; ++k) \
      acc[ai][bj][m][n] = SWAP ? MFMA16(Bt_[n][k], At_[m][k], acc[ai][bj][m][n]) : MFMA16(At_[m][k], Bt_[n][k], acc[ai][bj][m][n]); \
    __builtin_amdgcn_s_setprio(0); } while (0)
#define WAIT_V(n) asm volatile("s_waitcnt vmcnt(" #n ")" ::: "memory")
#define WAIT_L(n) asm volatile("s_waitcnt lgkmcnt(" #n ")" ::: "memory")
#define BAR8 __builtin_amdgcn_s_barrier()
#define SCHED8 __builtin_amdgcn_sched_barrier(0)
#pragma unroll
  for (int ai = 0; ai < 2; ++ai)
#pragma unroll
    for (int bj = 0; bj < 2; ++bj)
#pragma unroll
      for (int m = 0; m < 4; ++m)
#pragma unroll
        for (int n = 0; n < 2; ++n) acc[ai][bj][m][n] = f32x4{0.f, 0.f, 0.f, 0.f};
  bf16x8 At[4][2], B0[2][2], B1[2][2];
  constexpr int nt = K / BK;
  STAGE8(SB8(0, 0), Bb, 0, 0); STAGE8(SA8(0, 0), Ab, 0, 0);
  STAGE8(SB8(0, 1), Bb, HALF, 0); STAGE8(SA8(0, 1), Ab, HALF, 0);
  if (wr == 1) BAR8;
  WAIT_V(4); BAR8;
  STAGE8(SB8(1, 0), Bb, 0, 1); STAGE8(SA8(1, 0), Ab, 0, 1); STAGE8(SB8(1, 1), Bb, HALF, 1);
  WAIT_V(6); BAR8;
#pragma unroll 1
  for (int t = 0; t < nt - 2; t += 2) {
    LDB8(B0, 0, 0); SCHED8; LDA8(At, 0, 0); STAGE8(SA8(1, 1), Ab, HALF, t + 1);
    WAIT_L(8); BAR8; WAIT_L(0); MMA8(0, 0, At, B0); BAR8; SCHED8;
    LDB8(B1, 0, 1); STAGE8(SB8(0, 0), Bb, 0, t + 2);
    BAR8; WAIT_L(0); MMA8(0, 1, At, B1); BAR8;
    LDA8(At, 0, 1); STAGE8(SA8(0, 0), Ab, 0, t + 2);
    BAR8; WAIT_L(0); MMA8(1, 0, At, B0); BAR8; SCHED8;
    STAGE8(SB8(0, 1), Bb, HALF, t + 2);
    WAIT_V(6); BAR8; MMA8(1, 1, At, B1); BAR8;
    LDB8(B0, 1, 0); SCHED8; LDA8(At, 1, 0); STAGE8(SA8(0, 1), Ab, HALF, t + 2);
    WAIT_L(8); BAR8; WAIT_L(0); MMA8(0, 0, At, B0); BAR8; SCHED8;
    LDB8(B1, 1, 1); STAGE8(SB8(1, 0), Bb, 0, t + 3);
    BAR8; WAIT_L(0); MMA8(0, 1, At, B1); BAR8;
    LDA8(At, 1, 1); STAGE8(SA8(1, 0), Ab, 0, t + 3);
    BAR8; WAIT_L(0); MMA8(1, 0, At, B0); BAR8; SCHED8;
    STAGE8(SB8(1, 1), Bb, HALF, t + 3);
    WAIT_V(6); BAR8; MMA8(1, 1, At, B1); BAR8;
  }
  { LDB8(B0, 0, 0); LDA8(At, 0, 0); STAGE8(SA8(1, 1), Ab, HALF, nt - 1);
    BAR8; WAIT_L(0); MMA8(0, 0, At, B0); BAR8;
    LDB8(B1, 0, 1); BAR8; WAIT_L(0); MMA8(0, 1, At, B1); BAR8;
    LDA8(At, 0, 1); WAIT_V(4); BAR8; WAIT_L(0); MMA8(1, 0, At, B0); MMA8(1, 1, At, B1); BAR8; }
  { LDB8(B0, 1, 0); LDA8(At, 1, 0); WAIT_V(2); BAR8; WAIT_L(0); MMA8(0, 0, At, B0); BAR8;
    LDB8(B1, 1, 1); WAIT_V(0); BAR8; WAIT_L(0); MMA8(0, 1, At, B1); BAR8;
    LDA8(At, 1, 1); BAR8; WAIT_L(0); MMA8(1, 0, At, B0); MMA8(1, 1, At, B1); BAR8; }
  if (wr == 0) BAR8;
  __syncthreads();
#undef SA8
#undef SB8
#undef STAGE8
#undef LDA8
#undef LDB8
#undef MMA8
#undef WAIT_V
#undef WAIT_L
#undef BAR8
#undef SCHED8
}
template <int SWAP>
DI void stage8(const f32x4 (&acc)[2][2][4][2], u16* Ct) {
  const int tid = otid(), wid = tid >> 6, lane = tid & 63, wr = wid >> 2, wc = wid & 3, fr = lane & 15, fq = lane >> 4;
#pragma unroll
  for (int ai = 0; ai < 2; ++ai)
#pragma unroll
    for (int bj = 0; bj < 2; ++bj)
#pragma unroll
      for (int m = 0; m < 4; ++m)
#pragma unroll
        for (int n = 0; n < 2; ++n) {
          uint2 o; o.x = pack2(acc[ai][bj][m][n][0], acc[ai][bj][m][n][1]); o.y = pack2(acc[ai][bj][m][n][2], acc[ai][bj][m][n][3]);
          if (SWAP) *(uint2*)(Ct + (ai * 128 + wr * 64 + m * 16 + fr) * CT_LD + bj * 128 + wc * 32 + n * 16 + fq * 4) = o;
          else *(uint2*)(Ct + (bj * 128 + wc * 32 + n * 16 + fr) * CT_LD + ai * 128 + wr * 64 + m * 16 + fq * 4) = o;
        }
}
template <int SWAP, int MODE>
DI void epilogue8(const f32x4 (&acc)[2][2][4][2], char* lds, u16* __restrict__ dst, size_t ld, const u16* __restrict__ Hres) {
  const int tid = otid();
  u16* Ct = (u16*)lds;
  stage8<SWAP>(acc, Ct);
  __syncthreads();
#pragma unroll 4
  for (int i = 0; i < 16; ++i) {
    const int q = tid + 512 * i, r = q >> 5, c8 = (q & 31) * 8;
    uint4 v = *(const uint4*)(Ct + r * CT_LD + c8);
    const size_t o = (size_t)r * ld + c8;
    if (MODE == 1) {
      const uint4 hv = *(const uint4*)(Hres + o);
      float y[8], hx[8]; unpack8(v, y); unpack8(hv, hx);
      v.x = pack2(ALPHA * hx[0] + y[0], ALPHA * hx[1] + y[1]); v.y = pack2(ALPHA * hx[2] + y[2], ALPHA * hx[3] + y[3]);
      v.z = pack2(ALPHA * hx[4] + y[4], ALPHA * hx[5] + y[5]); v.w = pack2(ALPHA * hx[6] + y[6], ALPHA * hx[7] + y[7]);
    }
    *(uint4*)(dst + o) = v;
  }
  __syncthreads();
}

DI bool tile_of(int it, int MT, int NT, int& mt, int& nt) {
  const int nb = gridDim.x;
  if ((nb & 7) == 0 && (MT & 7) == 0) {
    const int x = blockIdx.x & 7, slot = blockIdx.x >> 3, nx = nb >> 3, j = slot + it * nx, per = (MT >> 3) * NT;
    if (j >= per) return false;
    if (NT == 14 && (MT >> 3) == 32) {
      const int r = j / 28, w = j - r * 28, nh = r >> 3, mg = r & 7;
      mt = x * 32 + mg * 4 + w / 7; nt = nh * 7 + w % 7; return true;
    }
    mt = x * (MT >> 3) + j / NT; nt = j % NT; return true;
  }
  const int j = blockIdx.x + it * nb;
  if (j >= MT * NT) return false;
  mt = j / NT; nt = j % NT; return true;
}

DI void phase_inproj(const Params& p, char* lds) {
  char* ws = p.ws;
  const u16* A = (const u16*)(ws + OFF_H); const u16* W = (const u16*)(ws + OFF_WIN);
  int mt, nt; bool have = tile_of(0, 256, 14, mt, nt);
  for (int it = 0; have; ++it) {
    const int m0 = mt * 256, n0 = nt * 256;
    int mtn, ntn; const bool hn = tile_of(it + 1, 256, 14, mtn, ntn);
    const u16* nA = A + (size_t)(hn ? mtn : 0) * 256 * 1024; const u16* nB = W + (size_t)(hn ? ntn : 0) * 256 * 1024;
    const bool tr = (n0 >= 1024 && n0 < 1536) || (n0 >= 2560 && n0 < 3072);
    f32x4 acc[2][2][4][2];
    if (tr) {
      gemm8p<0>(A + (size_t)m0 * 1024, W + (size_t)n0 * 1024, acc, lds);
      u16* dst = (n0 < 1536) ? (u16*)(ws + OFF_VTA) + ((size_t)((m0 >> 13) * 512 + (n0 - 1024))) * SEQ + (m0 & 8191)
                             : (u16*)(ws + OFF_VTM) + ((size_t)((m0 >> 13) * 512 + (n0 - 2560))) * SEQ + (m0 & 8191);
      epilogue8<0, 0>(acc, lds, dst, SEQ, nullptr);
    } else {
      gemm8p<1>(A + (size_t)m0 * 1024, W + (size_t)n0 * 1024, acc, lds);
      u16* dst; size_t ld;
      if (n0 < 1024) { dst = (u16*)(ws + OFF_PA) + (size_t)m0 * 1024 + n0; ld = 1024; }
      else if (n0 < 2560) { dst = (u16*)(ws + OFF_PM) + (size_t)m0 * 1024 + (n0 - 1536); ld = 1024; }
      else { dst = (u16*)(ws + OFF_PO) + (size_t)m0 * 512 + (n0 - 3072); ld = 512; }
      epilogue8<1, 0>(acc, lds, dst, ld, nullptr);
    }
    mt = mtn; nt = ntn; have = hn;
  }
  for (int it = 0;; ++it) {
    if (!tile_of(it, 8, 8, mt, nt)) break;
    const int m0 = mt * 256, n0 = nt * 256;
    const u16* Am = (const u16*)(ws + OFF_MEMB) + (size_t)m0 * 1024; const u16* Bm = (const u16*)(ws + OFF_WKV) + (size_t)n0 * 1024;
    f32x4 acc[2][2][4][2];
    if (n0 >= 1024) { gemm8p<0>(Am, Bm, acc, lds); epilogue8<0, 0>(acc, lds, (u16*)(ws + OFF_VTX) + ((size_t)((m0 >> 8) * 1024 + (n0 - 1024))) * 256, 256, nullptr); }
    else { gemm8p<1>(Am, Bm, acc, lds); epilogue8<1, 0>(acc, lds, (u16*)(ws + OFF_KX) + (size_t)m0 * 1024 + n0, 1024, nullptr); }
  }
}

template <int MODE>
DI void phase_gemm1024(const u16* __restrict__ A, const u16* __restrict__ Wt, u16* __restrict__ dstb, const u16* __restrict__ Hres, char* lds) {
  const int tid = otid(), wid = tid >> 6, lane = tid & 63, wr = wid >> 2, wc = wid & 3, fr = lane & 15, fq = lane >> 4;
  int mt, nt; bool have = tile_of(0, 256, 4, mt, nt);
  for (int it = 0; have; ++it) {
    const int m0 = mt * 256, n0 = nt * 256;
    int mtn, ntn; const bool hn = tile_of(it + 1, 256, 4, mtn, ntn);
    f32x4 acc[2][2][4][2];
    gemm8p<1>(A + (size_t)m0 * 1024, Wt + (size_t)n0 * 1024, acc, lds);
    epilogue8<1, MODE>(acc, lds, dstb + (size_t)m0 * 1024 + n0, 1024, (MODE == 1) ? Hres + (size_t)m0 * 1024 + n0 : nullptr);
    mt = mtn; nt = ntn; have = hn;
  }
}

DI void attn_item(const Params& p, char* lds, int item) {
  char* ws = p.ws;
  const int tid = otid(), lane = tid & 63, wave = tid >> 6, l31 = lane & 31, hh = lane >> 5;
  const int b = item >> 8, h = (item >> 5) & 7, c0 = (item & 31) * 4;
  const int qc = c0 + (wave >> 1), qt = wave & 1;
  const u16* PA = (const u16*)(ws + OFF_PA); const u16* VTa = (const u16*)(ws + OFF_VTA); u16* MIX = (u16*)(ws + OFF_MIX);
  u16* Kl = (u16*)lds;
  u16* Vl = Kl + 2 * 64 * 72;
  float* biasl = (float*)(Vl + 2 * 64 * 72);
  const int pi = perm23(l31);
  const int sr = tid >> 3, sc8 = (tid & 7) * 8;
  const u16* kg = PA + ((size_t)b * SEQ + sr) * 1024 + 512 + h * 64 + sc8;
  const u16* vg = VTa + ((size_t)((b * 8 + h) * 64 + sr)) * SEQ + sc8;
  for (int i = tid; i < 257; i += 512) biasl[i] = p.in[10][h * 257 + i] * 1.4426950408889634f;
  const size_t q0 = (size_t)b * SEQ + qc * 64 + qt * 32;
  bf16x8 Qf[4];
#pragma unroll
  for (int kk = 0; kk < 4; ++kk) Qf[kk] = ldfrag(PA + (q0 + l31) * 1024 + h * 64 + kk * 16 + 8 * hh);
  const int kcs = (c0 >= 8) ? c0 - 8 : 0, kce = c0 + 3;
  *(uint4*)(Kl + sr * 72 + sc8) = *(const uint4*)(kg + (size_t)(kcs * 64) * 1024);
  *(uint4*)(Vl + sr * 72 + sc8) = *(const uint4*)(vg + kcs * 64);
  __syncthreads();
  f32x16 O[2]; O[0] = zero16(); O[1] = zero16();
  float mrun = -INFINITY, lrun = 0.f;
#pragma unroll 1
  for (int kc = kcs; kc <= kce; ++kc) {
    const int cur = (kc - kcs) & 1;
    uint4 nk, nv;
    if (kc < kce) { nk = *(const uint4*)(kg + (size_t)((kc + 1) * 64) * 1024); nv = *(const uint4*)(vg + (kc + 1) * 64); }
    if (kc >= qc - 8 && kc <= qc) {
      f32x16 S[2];
      float mx = -INFINITY;
#pragma unroll
      for (int sub = 0; sub < 2; ++sub) {
        const u16* kl = Kl + cur * 64 * 72 + (sub * 32 + pi) * 72 + 8 * hh;
        S[sub] = zero16();
#pragma unroll
        for (int kk = 0; kk < 4; ++kk) S[sub] = MFMA(ldfrag(kl + kk * 16), Qf[kk], S[sub]);
        const int relbase = (kc * 64 + sub * 32 + 8 * hh) - (qc * 64 + qt * 32 + l31);
        if ((kc * 64 + sub * 32 + 31) - (qc * 64 + qt * 32) <= -128) {
          const float b0 = biasl[0];
#pragma unroll
          for (int r = 0; r < 16; ++r) { const float sv = S[sub][r] * 0.18033688011112042f + b0; S[sub][r] = sv; mx = fmaxf(mx, sv); }
        } else {
#pragma unroll
          for (int r = 0; r < 16; ++r) {
            int rel = relbase + 16 * (r >> 3) + (r & 7);
            rel = rel < -128 ? -128 : (rel > 128 ? 128 : rel);
            const float sv = S[sub][r] * 0.18033688011112042f + biasl[rel + 128];
            S[sub][r] = sv; mx = fmaxf(mx, sv);
          }
        }
      }
      mx = fmaxf(mx, __shfl_xor(mx, 32));
      const float mnew = fmaxf(mrun, mx);
      const float alpha = __builtin_amdgcn_exp2f(mrun - mnew);
      mrun = mnew;
      float ps = 0.f;
#pragma unroll
      for (int sub = 0; sub < 2; ++sub)
#pragma unroll
        for (int r = 0; r < 16; ++r) { const float e = __builtin_amdgcn_exp2f(S[sub][r] - mnew); S[sub][r] = e; ps += e; }
      lrun = lrun * alpha + ps;
#pragma unroll
      for (int r = 0; r < 16; ++r) { O[0][r] *= alpha; O[1][r] *= alpha; }
#pragma unroll
      for (int sub = 0; sub < 2; ++sub) {
        bf16x8 Pf[2];
#pragma unroll
        for (int ks = 0; ks < 2; ++ks) {
          union { bf16x8 v; unsigned u[4]; } cv;
          for (int j2 = 0; j2 < 4; ++j2) cv.u[j2] = pack2(S[sub][8 * ks + 2 * j2], S[sub][8 * ks + 2 * j2 + 1]);
          Pf[ks] = cv.v;
        }
        const u16* vl = Vl + cur * 64 * 72 + l31 * 72 + sub * 32 + 8 * hh;
#pragma unroll
        for (int dt = 0; dt < 2; ++dt)
#pragma unroll
          for (int ks = 0; ks < 2; ++ks) O[dt] = MFMA(ldfrag(vl + dt * 32 * 72 + 16 * ks), Pf[ks], O[dt]);
      }
    }
    if (kc < kce) { const int nx = cur ^ 1; *(uint4*)(Kl + nx * 64 * 72 + sr * 72 + sc8) = nk; *(uint4*)(Vl + nx * 64 * 72 + sr * 72 + sc8) = nv; }
    __syncthreads();
  }
  const float inv = __builtin_amdgcn_rcpf(lrun + __shfl_xor(lrun, 32));
#pragma unroll
  for (int dt = 0; dt < 2; ++dt)
#pragma unroll
    for (int g = 0; g < 4; ++g) {
      uint2 o; o.x = pack2(O[dt][4 * g] * inv, O[dt][4 * g + 1] * inv); o.y = pack2(O[dt][4 * g + 2] * inv, O[dt][4 * g + 3] * inv);
      *(uint2*)(MIX + (q0 + l31) * 1024 + h * 64 + dt * 32 + 8 * g + 4 * hh) = o;
    }
}

DI float log_sigmoid(float f) { return fminf(f, 0.f) - log1pf(expf(-fabsf(f))); }
DI float scan_sum(float v, int lane) { for (int o = 1; o < 64; o <<= 1) { float tv = __shfl_up(v, o); if (lane >= o) v += tv; } return v; }
DI float scan_max(float v, int lane) { for (int o = 1; o < 64; o <<= 1) { float tv = __shfl_up(v, o); if (lane >= o) v = fmaxf(v, tv); } return v; }

DI void conv_unit(const u16* __restrict__ PM, const float* __restrict__ conv_w, const float* __restrict__ conv_b, int b, int sl0, int ch, float scale, float* a8) {
  { const float4 b0 = *(const float4*)(conv_b + ch), b1 = *(const float4*)(conv_b + ch + 4); a8[0] = b0.x; a8[1] = b0.y; a8[2] = b0.z; a8[3] = b0.w; a8[4] = b1.x; a8[5] = b1.y; a8[6] = b1.z; a8[7] = b1.w; }
#pragma unroll
  for (int j = 0; j < 4; ++j) {
    const int sl = sl0 - 3 + j;
    if (sl >= 0) {
      const uint4 raw = *(const uint4*)(PM + ((size_t)b * SEQ + sl) * 1024 + ch);
      float x8[8]; unpack8(raw, x8);
      const float4 w0 = *(const float4*)(conv_w + j * 1024 + ch), w1 = *(const float4*)(conv_w + j * 1024 + ch + 4);
      a8[0] += w0.x * x8[0]; a8[1] += w0.y * x8[1]; a8[2] += w0.z * x8[2]; a8[3] += w0.w * x8[3];
      a8[4] += w1.x * x8[4]; a8[5] += w1.y * x8[5]; a8[6] += w1.z * x8[6]; a8[7] += w1.w * x8[7];
    }
  }
#pragma unroll
  for (int e = 0; e < 8; ++e) { const float v = a8[e]; a8[e] = scale * v * __builtin_amdgcn_rcpf(1.f + __expf(-v)); }
}

DI void mlstmA_item(const Params& p, char* lds, int item) {
  char* ws = p.ws;
  const int bh = item >> 7, c = item & 127, b = bh >> 2, hd = bh & 3;
  const int tid = otid(), lane = tid & 63, wave = tid >> 6, hh = lane >> 5, l31 = lane & 31;
  u16* KTs = (u16*)lds;
  u16* VTs = KTs + 128 * 72;
  float* win = (float*)(VTs + 128 * 72);
  const u16* PM = (const u16*)(ws + OFF_PM); const u16* VTm = (const u16*)(ws + OFF_VTM);
  const float* G = (const float*)(ws + OFF_G);
  u16* KVS = (u16*)(ws + OFF_KVS) + (size_t)item * 16384; float* KSUM = (float*)(ws + OFF_KSUM) + (size_t)item * 128; float* CSC = (float*)(ws + OFF_CSC) + (size_t)item * 4;
  if (wave == 0) {
    const size_t row = (size_t)b * SEQ + c * 64 + lane;
    const float ig = G[row * 8 + hd] + p.in[7][hd], fg = G[row * 8 + 4 + hd] + p.in[8][hd];
    const float bc = scan_sum(log_sigmoid(fg), lane);
    const float as = ig - bc;
    const float gmax = wmax(as);
    const float B = __shfl(bc, 63);
    win[lane] = expf(as - gmax);
    if (lane == 0) { CSC[0] = B; CSC[1] = B + gmax; }
  }
  for (int i = 0; i < 2; ++i) {
    const int q = tid + 512 * i, e = q >> 3, s8 = (q & 7) * 8;
    *(uint4*)(VTs + e * 72 + s8) = *(const uint4*)(VTm + ((size_t)(bh * 128 + e)) * SEQ + c * 64 + s8);
  }
  __syncthreads();
#pragma unroll 1
  for (int i = 0; i < 2; ++i) {
    const int cgk = tid & 15, t = (tid >> 4) + 32 * i;
    float a8[8];
    conv_unit(PM, p.in[5], p.in[6], b, c * 64 + t, 512 + hd * 128 + cgk * 8, 0.08838834764831845f, a8);
    const float w = win[t];
#pragma unroll
    for (int e = 0; e < 8; ++e) KTs[(cgk * 8 + e) * 72 + t] = f2bf(a8[e] * w);
  }
  __syncthreads();
  {
    const int dt = wave >> 1;
#pragma unroll
    for (int x = 0; x < 2; ++x) {
      const int e2 = (wave & 1) * 2 + x;
      f32x16 acc = zero16();
#pragma unroll
      for (int ks = 0; ks < 4; ++ks) acc = MFMA(ldfrag(KTs + (dt * 32 + l31) * 72 + ks * 16 + 8 * hh), ldfrag(VTs + (e2 * 32 + l31) * 72 + ks * 16 + 8 * hh), acc);
#pragma unroll
      for (int g = 0; g < 4; ++g) *(uint2*)(KVS + (e2 * 32 + l31) * 128 + dt * 32 + 8 * g + 4 * hh) = pack4(acc, g);
    }
    if (tid < 128) {
      float sacc = 0.f;
      for (int s8 = 0; s8 < 8; ++s8) { const uint4 raw = *(const uint4*)(KTs + tid * 72 + s8 * 8); float x8[8]; unpack8(raw, x8); for (int e = 0; e < 8; ++e) sacc += x8[e]; }
      KSUM[tid] = sacc;
    }
  }
  __syncthreads();
}

DI void phase_mlstm_scan(const Params& p) {
  char* ws = p.ws;
  const int tid = otid();
  for (int unit = blockIdx.x; unit < 256; unit += gridDim.x) {
    const int bh = unit >> 3, part = unit & 7;
    u16* kv = (u16*)(ws + OFF_KVS) + (size_t)bh * 128 * 16384 + part * 2048 + tid * 4;
    float* ks = (float*)(ws + OFF_KSUM) + (size_t)bh * 128 * 128 + tid;
    float* csc = (float*)(ws + OFF_CSC) + (size_t)bh * 128 * 4;
    const bool don = (part == 0) && (tid < 128);
    float m = 0.f, c0 = 0.f, c1 = 0.f, c2 = 0.f, c3 = 0.f, n = 0.f;
#pragma unroll 1
    for (int cb = 0; cb < 128; cb += 8) {
      uint2 raw[8]; float kr[8];
#pragma unroll
      for (int j = 0; j < 8; ++j) { raw[j] = *(const uint2*)(kv + (size_t)(cb + j) * 16384); kr[j] = don ? ks[(cb + j) * 128] : 0.f; }
#pragma unroll
      for (int j = 0; j < 8; ++j) {
        const float B = csc[(cb + j) * 4], A = csc[(cb + j) * 4 + 1];
        const float mnew = fmaxf(B + m, A);
        const float wp = __expf(B + m - mnew), wl = __expf(A - mnew);
        m = mnew;
        c0 = wp * c0 + wl * bflo(raw[j].x); c1 = wp * c1 + wl * bfhi(raw[j].x); c2 = wp * c2 + wl * bflo(raw[j].y); c3 = wp * c3 + wl * bfhi(raw[j].y);
        uint2 o; o.x = pack2(c0, c1); o.y = pack2(c2, c3);
        *(uint2*)(kv + (size_t)(cb + j) * 16384) = o;
        if (don) { n = wp * n + wl * kr[j]; ks[(cb + j) * 128] = n; }
        if (part == 0 && tid == 0) csc[(cb + j) * 4 + 2] = mnew;
      }
    }
  }
}

DI void mlstmC_pair(const Params& p, char* lds_all, int pair) {
  char* ws = p.ws;
  const int tid = otid(), hb = tid >> 8, ltid = tid & 255, lane = tid & 63, lwave = ltid >> 6, hh = lane >> 5, l31 = lane & 31;
  const int item = pair * 2 + hb;
  const int bh = item >> 7, c = item & 127, b = bh >> 2, hd = bh & 3;
  char* lds = lds_all + hb * 69632;
  u16* Qs = (u16*)lds;
  u16* Ks = Qs + 64 * 136;
  u16* VTs = Ks + 64 * 136;
  u16* Ps = VTs + 128 * 72;
  float* fs = (float*)(Ps + 64 * 72);
  float* a_s = fs; float* c_t = fs + 64; float* wint = fs + 128; float* emt = fs + 192; float* qnp = fs + 256; float* qks = fs + 512; float* red = fs + 640;
  const u16* PM = (const u16*)(ws + OFF_PM); const u16* VTm = (const u16*)(ws + OFF_VTM); const u16* PO = (const u16*)(ws + OFF_PO);
  const float* G = (const float*)(ws + OFF_G); u16* MIX = (u16*)(ws + OFF_MIX);
  const u16* CT = (const u16*)(ws + OFF_KVS) + (size_t)(item - 1) * 16384;
  const float* NP = (const float*)(ws + OFF_KSUM) + (size_t)(item - 1) * 128;
  const float* ng = p.in[9] + hd * 128;
  const float mprev = (c > 0) ? ((const float*)(ws + OFF_CSC))[(size_t)(item - 1) * 4 + 2] : 0.f;
#pragma unroll 1
  for (int i = 0; i < 8; ++i) {
    const int cg8 = ltid & 31, isK = cg8 >> 4, chl = (cg8 & 15) * 8, t = (ltid >> 5) + 8 * i;
    float a8[8];
    conv_unit(PM, p.in[5], p.in[6], b, c * 64 + t, (isK ? 512 : 0) + hd * 128 + chl, isK ? 0.08838834764831845f : 1.f, a8);
    uint4 o; o.x = pack2(a8[0], a8[1]); o.y = pack2(a8[2], a8[3]); o.z = pack2(a8[4], a8[5]); o.w = pack2(a8[6], a8[7]);
    *(uint4*)((isK ? Ks : Qs) + t * 136 + chl) = o;
  }
  for (int i = 0; i < 4; ++i) {
    const int q = ltid + 256 * i, e = q >> 3, s8 = (q & 7) * 8;
    *(uint4*)(VTs + e * 72 + s8) = *(const uint4*)(VTm + ((size_t)(bh * 128 + e)) * SEQ + c * 64 + s8);
  }
  if (lwave == 0) {
    const size_t row = (size_t)b * SEQ + c * 64 + lane;
    const float ig = G[row * 8 + hd] + p.in[7][hd], fg = G[row * 8 + 4 + hd] + p.in[8][hd];
    const float bc = scan_sum(log_sigmoid(fg), lane);
    const float as = ig - bc;
    const float gm = scan_max(as, lane);
    const float mt = bc + fmaxf(mprev, gm);
    a_s[lane] = as; c_t[lane] = bc - mt; wint[lane] = expf(bc + mprev - mt); emt[lane] = expf(-mt);
  }
  __syncthreads();
  {
    const int t = ltid & 63, part = ltid >> 6;
    float acc = 0.f;
    if (c > 0) for (int dd = 0; dd < 32; ++dd) acc += bf2f(Qs[t * 136 + part * 32 + dd]) * NP[part * 32 + dd];
    qnp[part * 64 + t] = acc;
  }
  {
    const int si = lwave >> 1, ti = lwave & 1;
    f32x16 S = zero16();
#pragma unroll
    for (int kk = 0; kk < 8; ++kk) S = MFMA(ldfrag(Ks + (si * 32 + l31) * 136 + kk * 16 + 8 * hh), ldfrag(Qs + (ti * 32 + l31) * 136 + kk * 16 + 8 * hh), S);
    const int t = ti * 32 + l31;
    const float ct = c_t[t];
    float rs = 0.f;
#pragma unroll
    for (int g = 0; g < 4; ++g) {
      float v4[4];
#pragma unroll
      for (int q = 0; q < 4; ++q) {
        const int sidx2 = si * 32 + 8 * g + 4 * hh + q;
        const float dv = (sidx2 <= t) ? S[4 * g + q] * __expf(ct + a_s[sidx2]) : 0.f;
        v4[q] = dv; rs += dv;
      }
      uint2 o; o.x = pack2(v4[0], v4[1]); o.y = pack2(v4[2], v4[3]);
      *(uint2*)(Ps + t * 72 + si * 32 + 8 * g + 4 * hh) = o;
    }
    rs += __shfl_xor(rs, 32);
    if (hh == 0) qks[si * 64 + t] = rs;
  }
  __syncthreads();
  const int et = lwave;
  f32x16 Hn[2];
#pragma unroll
  for (int tt = 0; tt < 2; ++tt) {
    const int tq = tt * 32 + l31;
    Hn[tt] = zero16();
    if (c > 0) {
#pragma unroll
      for (int kk = 0; kk < 8; ++kk) Hn[tt] = MFMA(ldfrag(CT + (et * 32 + l31) * 128 + kk * 16 + 8 * hh), ldfrag(Qs + tq * 136 + kk * 16 + 8 * hh), Hn[tt]);
    }
    const float wi = wint[tq];
#pragma unroll
    for (int r = 0; r < 16; ++r) Hn[tt][r] *= wi;
#pragma unroll
    for (int ks = 0; ks < 4; ++ks) Hn[tt] = MFMA(ldfrag(VTs + (et * 32 + l31) * 72 + ks * 16 + 8 * hh), ldfrag(Ps + tq * 72 + ks * 16 + 8 * hh), Hn[tt]);
    const float qn = qnp[tq] + qnp[64 + tq] + qnp[128 + tq] + qnp[192 + tq];
    const float den = wi * qn + qks[tq] + qks[64 + tq];
    const float inv = __builtin_amdgcn_rcpf(fmaxf(fabsf(den), emt[tq]));
    float s1 = 0.f, s2 = 0.f;
#pragma unroll
    for (int r = 0; r < 16; ++r) { Hn[tt][r] *= inv; s1 += Hn[tt][r]; s2 += Hn[tt][r] * Hn[tt][r]; }
    s1 += __shfl_xor(s1, 32); s2 += __shfl_xor(s2, 32);
    if (hh == 0) { red[(et * 64 + tq) * 2] = s1; red[(et * 64 + tq) * 2 + 1] = s2; }
  }
  __syncthreads();
#pragma unroll
  for (int tt = 0; tt < 2; ++tt) {
    const int tq = tt * 32 + l31;
    float t1 = 0.f, t2 = 0.f;
    for (int e4 = 0; e4 < 4; ++e4) { t1 += red[(e4 * 64 + tq) * 2]; t2 += red[(e4 * 64 + tq) * 2 + 1]; }
    const float mu = t1 * (1.f / 128.f);
    const float var = fmaxf(t2 * (1.f / 128.f) - mu * mu, 0.f);
    const float rstd = rsqrtf(var + LN_EPS);
    const size_t row = (size_t)b * SEQ + c * 64 + tq;
#pragma unroll
    for (int g = 0; g < 4; ++g) {
      const int e0 = et * 32 + 8 * g + 4 * hh;
      const uint2 og = *(const uint2*)(PO + row * 512 + hd * 128 + e0);
      const float4 gg = *(const float4*)(ng + e0);
      const float o0 = __builtin_amdgcn_rcpf(1.f + __expf(-bflo(og.x))), o1 = __builtin_amdgcn_rcpf(1.f + __expf(-bfhi(og.x))), o2 = __builtin_amdgcn_rcpf(1.f + __expf(-bflo(og.y))), o3 = __builtin_amdgcn_rcpf(1.f + __expf(-bfhi(og.y)));
      uint2 o;
      o.x = pack2(o0 * (Hn[tt][4 * g] - mu) * rstd * gg.x, o1 * (Hn[tt][4 * g + 1] - mu) * rstd * gg.y);
      o.y = pack2(o2 * (Hn[tt][4 * g + 2] - mu) * rstd * gg.z, o3 * (Hn[tt][4 * g + 3] - mu) * rstd * gg.w);
      *(uint2*)(MIX + row * 1024 + 512 + hd * 128 + e0) = o;
    }
  }
  __syncthreads();
}

DI void phase_mixA(const Params& p, char* lds) {
  for (int it = blockIdx.x; it < 4096; it += gridDim.x) mlstmA_item(p, lds, it);
  if ((gridDim.x & 7) == 0 && gridDim.x <= 256) {
    const int x = blockIdx.x & 7, slot = blockIdx.x >> 3, nx = gridDim.x >> 3;
    for (int j = slot; j < 256; j += nx) attn_item(p, lds, x * 256 + j);
  } else {
    for (int it = blockIdx.x; it < 2048; it += gridDim.x) attn_item(p, lds, it);
  }
}
DI void phase_mixC(const Params& p, char* lds) {
  for (int it = blockIdx.x; it < 2048; it += gridDim.x) mlstmC_pair(p, lds, it);
}

DI void phase_xattn(const Params& p, char* lds) {
  char* ws = p.ws;
  const int tid = otid(), lane = tid & 63, wave = tid >> 6, l31 = lane & 31, hh = lane >> 5;
  const u16* XQ = (const u16*)(ws + OFF_XQ); const u16* KX = (const u16*)(ws + OFF_KX); const u16* VTX = (const u16*)(ws + OFF_VTX);
  u16* XO = (u16*)(ws + OFF_XO);
  u16* Kl = (u16*)lds; u16* Vl = Kl + 2 * 32 * 264;
  const int pi = perm23(l31);
  const int kr0 = tid >> 5, kc = (tid & 31) * 8, vr = tid >> 2, vc = (tid & 3) * 8;
  for (int item = blockIdx.x; item < 1024; item += gridDim.x) {
    const int b = item >> 7, h = (item >> 5) & 3, qblk = item & 31;
    const size_t q0 = (size_t)b * SEQ + qblk * 256 + wave * 32;
    bf16x8 Qf[16];
#pragma unroll
    for (int kk = 0; kk < 16; ++kk) Qf[kk] = ldfrag(XQ + (q0 + l31) * 1024 + h * 256 + kk * 16 + 8 * hh);
    const u16* kg = KX + ((size_t)b * 256) * 1024 + h * 256;
    const u16* vg = VTX + ((size_t)((b * 4 + h) * 256)) * 256;
    {
      const uint4 k0 = *(const uint4*)(kg + (size_t)kr0 * 1024 + kc), k1 = *(const uint4*)(kg + (size_t)(kr0 + 16) * 1024 + kc);
      const uint4 v0 = *(const uint4*)(vg + (size_t)vr * 256 + vc);
      *(uint4*)(Kl + kr0 * 264 + kc) = k0; *(uint4*)(Kl + (kr0 + 16) * 264 + kc) = k1; *(uint4*)(Vl + vr * 40 + vc) = v0;
    }
    __syncthreads();
    f32x16 O[4]; for (int i = 0; i < 4; ++i) O[i] = zero16();
    float mrun = -INFINITY, lrun = 0.f;
#pragma unroll 1
    for (int st = 0; st < 16; ++st) {
      const int dh = st >> 3, kt = st & 7, cur = st & 1;
      uint4 nk0, nk1, nv0;
      if (st < 15) {
        const int ndh = (st + 1) >> 3, nkt = (st + 1) & 7;
        nk0 = *(const uint4*)(kg + (size_t)(nkt * 32 + kr0) * 1024 + kc); nk1 = *(const uint4*)(kg + (size_t)(nkt * 32 + kr0 + 16) * 1024 + kc);
        nv0 = *(const uint4*)(vg + (size_t)(ndh * 128 + vr) * 256 + nkt * 32 + vc);
      }
      const u16* kl = Kl + cur * 32 * 264 + pi * 264 + 8 * hh;
      const u16* vl = Vl + cur * 128 * 40 + l31 * 40 + 8 * hh;
      f32x16 S = zero16();
#pragma unroll
      for (int kk = 0; kk < 16; ++kk) S = MFMA(ldfrag(kl + kk * 16), Qf[kk], S);
      float mx = -INFINITY;
#pragma unroll
      for (int r = 0; r < 16; ++r) { S[r] *= 0.09016844005556021f; mx = fmaxf(mx, S[r]); }
      mx = fmaxf(mx, __shfl_xor(mx, 32));
      const float mnew = fmaxf(mrun, mx), alpha = __builtin_amdgcn_exp2f(mrun - mnew);
      mrun = mnew;
      float ps = 0.f;
#pragma unroll
      for (int r = 0; r < 16; ++r) { const float e = __builtin_amdgcn_exp2f(S[r] - mnew); S[r] = e; ps += e; }
      lrun = lrun * alpha + ps;
      bf16x8 Pf[2];
#pragma unroll
      for (int ks = 0; ks < 2; ++ks) {
        union { bf16x8 v; unsigned u[4]; } cv;
        for (int j2 = 0; j2 < 4; ++j2) cv.u[j2] = pack2(S[8 * ks + 2 * j2], S[8 * ks + 2 * j2 + 1]);
        Pf[ks] = cv.v;
      }
#pragma unroll
      for (int dt = 0; dt < 4; ++dt) {
#pragma unroll
        for (int r = 0; r < 16; ++r) O[dt][r] *= alpha;
#pragma unroll
        for (int ks = 0; ks < 2; ++ks) O[dt] = MFMA(ldfrag(vl + dt * 32 * 40 + 16 * ks), Pf[ks], O[dt]);
      }
      if (kt == 7) {
        const float inv = __builtin_amdgcn_rcpf(lrun + __shfl_xor(lrun, 32));
#pragma unroll
        for (int dt = 0; dt < 4; ++dt) {
#pragma unroll
          for (int g = 0; g < 4; ++g) {
            uint2 o; o.x = pack2(O[dt][4 * g] * inv, O[dt][4 * g + 1] * inv); o.y = pack2(O[dt][4 * g + 2] * inv, O[dt][4 * g + 3] * inv);
            *(uint2*)(XO + (q0 + l31) * 1024 + h * 256 + dh * 128 + dt * 32 + 8 * g + 4 * hh) = o;
          }
          O[dt] = zero16();
        }
        mrun = -INFINITY; lrun = 0.f;
      }
      if (st < 15) {
        const int nx = cur ^ 1;
        *(uint4*)(Kl + nx * 32 * 264 + kr0 * 264 + kc) = nk0; *(uint4*)(Kl + nx * 32 * 264 + (kr0 + 16) * 264 + kc) = nk1; *(uint4*)(Vl + nx * 128 * 40 + vr * 40 + vc) = nv0;
      }
      __syncthreads();
    }
  }
}

DI void phase_peer_query(const Params& p, char* lds) {
  char* ws = p.ws;
  const int tid = otid(), lane = tid & 63, wave = tid >> 6, wm = wave >> 1, wn = wave & 1, l31 = lane & 31, hh = lane >> 5;
  const u16* SK = (const u16*)(ws + OFF_SK);
  float* TOPV = (float*)(ws + OFF_TOPV);
  u16* Ct = (u16*)lds;
  float* Sc = (float*)lds;
  float* Ll = (float*)lds;
  for (int it = 0;; ++it) {
    int mt, hq; if (!tile_of(it, 256, 8, mt, hq)) break;
    const int m0 = mt * 256, n0 = hq * 256;
    {
      f32x4 acc[2][2][4][2];
      const u16* Aq = (const u16*)(ws + OFF_H) + (size_t)m0 * 1024; const u16* Bq = (const u16*)(ws + OFF_WPQ) + (size_t)n0 * 1024;
      gemm8p<1>(Aq, Bq, acc, lds);
      stage8<1>(acc, Ct);
    }
    __syncthreads();
    f32x16 sacc[2][2][2];
#pragma unroll
    for (int pp = 0; pp < 2; ++pp) {
#pragma unroll
      for (int i = 0; i < 2; ++i) for (int j = 0; j < 2; ++j) sacc[pp][i][j] = zero16();
#pragma unroll
      for (int kk = 0; kk < 8; ++kk) {
        const bf16x8 a0 = ldfrag(Ct + (wm * 64 + l31) * CT_LD + pp * 128 + kk * 16 + 8 * hh), a1 = ldfrag(Ct + (wm * 64 + 32 + l31) * CT_LD + pp * 128 + kk * 16 + 8 * hh);
        const bf16x8 b0 = ldfrag(SK + (size_t)(pp * 128 + wn * 64 + l31) * 128 + kk * 16 + 8 * hh), b1 = ldfrag(SK + (size_t)(pp * 128 + wn * 64 + 32 + l31) * 128 + kk * 16 + 8 * hh);
        sacc[pp][0][0] = MFMA(a0, b0, sacc[pp][0][0]); sacc[pp][0][1] = MFMA(a0, b1, sacc[pp][0][1]);
        sacc[pp][1][0] = MFMA(a1, b0, sacc[pp][1][0]); sacc[pp][1][1] = MFMA(a1, b1, sacc[pp][1][1]);
      }
    }
    __syncthreads();
#pragma unroll
    for (int pp = 0; pp < 2; ++pp) {
      const int hp = hq * 2 + pp;
#pragma unroll
      for (int i = 0; i < 2; ++i)
#pragma unroll
        for (int j = 0; j < 2; ++j)
#pragma unroll
          for (int r = 0; r < 16; ++r)
            Sc[(wm * 64 + i * 32 + (r & 3) + 8 * (r >> 2) + 4 * hh) * 132 + wn * 64 + j * 32 + l31] = sacc[pp][i][j][r];
      __syncthreads();
      {
        const int row = tid >> 1, half = tid & 1;
        const float* srow = Sc + row * 132 + half * 64;
        float v[16];
        {
          float kq[4][16];
#pragma unroll
          for (int gq = 0; gq < 4; ++gq) {
#pragma unroll
            for (int e4 = 0; e4 < 4; ++e4) {
              const float4 s4 = *(const float4*)(srow + 16 * gq + 4 * e4);
              const float sv[4] = {s4.x, s4.y, s4.z, s4.w};
#pragma unroll
              for (int u = 0; u < 4; ++u)
                kq[gq][4 * e4 + u] = __uint_as_float((__float_as_uint(sv[u]) & 0xFFFFFF80u) | (unsigned)(127 - (half * 64 + 16 * gq + 4 * e4 + u)));
            }
#pragma unroll
            for (int kk2 = 2; kk2 <= 16; kk2 <<= 1)
#pragma unroll
              for (int j = kk2 >> 1; j > 0; j >>= 1)
#pragma unroll
                for (int i = 0; i < 16; ++i) {
                  const int l = i ^ j;
                  if (l > i) {
                    const float hi = fmaxf(kq[gq][i], kq[gq][l]), lo = fminf(kq[gq][i], kq[gq][l]);
                    const bool desc = (i & kk2) == 0;
                    kq[gq][i] = desc ? hi : lo; kq[gq][l] = desc ? lo : hi;
                  }
                }
          }
#pragma unroll
          for (int pr = 0; pr < 2; ++pr) {
#pragma unroll
            for (int i = 0; i < 16; ++i) kq[2 * pr][i] = fmaxf(kq[2 * pr][i], kq[2 * pr + 1][15 - i]);
#pragma unroll
            for (int d = 8; d >= 1; d >>= 1)
#pragma unroll
              for (int i = 0; i < 16; ++i)
                if ((i & d) == 0) { const float hi = fmaxf(kq[2 * pr][i], kq[2 * pr][i + d]), lo = fminf(kq[2 * pr][i], kq[2 * pr][i + d]); kq[2 * pr][i] = hi; kq[2 * pr][i + d] = lo; }
          }
#pragma unroll
          for (int i = 0; i < 16; ++i) v[i] = fmaxf(kq[0][i], kq[2][15 - i]);
#pragma unroll
          for (int d = 8; d >= 1; d >>= 1)
#pragma unroll
            for (int i = 0; i < 16; ++i)
              if ((i & d) == 0) { const float hi = fmaxf(v[i], v[i + d]), lo = fminf(v[i], v[i + d]); v[i] = hi; v[i + d] = lo; }
        }
        float c[16];
#pragma unroll
        for (int i = 0; i < 16; ++i) c[i] = __shfl_xor(v[15 - i], 1);
#pragma unroll
        for (int i = 0; i < 16; ++i) c[i] = fmaxf(c[i], v[i]);
#pragma unroll
        for (int d = 8; d >= 1; d >>= 1)
#pragma unroll
          for (int i = 0; i < 16; ++i)
            if ((i & d) == 0) { const float hi = fmaxf(c[i], c[i + d]), lo = fminf(c[i], c[i + d]); c[i] = hi; c[i + d] = lo; }
        if (half == 0) {
          float* tv = TOPV + (size_t)(m0 + row) * 256 + hp * 16;
#pragma unroll
          for (int i = 0; i < 4; ++i) *(float4*)(tv + 4 * i) = make_float4(c[4 * i], c[4 * i + 1], c[4 * i + 2], c[4 * i + 3]);
        }
      }
      __syncthreads();
    }
  }
}

template <int C> struct CandFlat { static constexpr int calc() { int i = 0, rem = C; while (rem >= 16 / (i + 1)) { rem -= 16 / (i + 1); ++i; } return i * 16 + rem; } static constexpr int value = calc(); };
template <int C> DI void rank_step(const float val, const int flat, int& rank) {
  const float o = __uint_as_float(__builtin_amdgcn_readlane(__float_as_uint(val), C));
  rank += (int)(o > val) | ((int)(o == val) & (int)(CandFlat<C>::value < flat));
}
template <int C0> DI void rank_steps10(const float val, const int flat, int& rank) {
  rank_step<C0>(val, flat, rank); rank_step<C0 + 1>(val, flat, rank); rank_step<C0 + 2>(val, flat, rank); rank_step<C0 + 3>(val, flat, rank); rank_step<C0 + 4>(val, flat, rank);
  rank_step<C0 + 5>(val, flat, rank); rank_step<C0 + 6>(val, flat, rank); rank_step<C0 + 7>(val, flat, rank); rank_step<C0 + 8>(val, flat, rank); rank_step<C0 + 9>(val, flat, rank);
}
DI float dot16q(const uint4& q, const f32x2* x) {
  f32x2 a = __builtin_amdgcn_cvt_pk_f32_fp8((int)q.x, false) * x[0];
  a = __builtin_amdgcn_cvt_pk_f32_fp8((int)q.x, true) * x[1] + a;
  a = __builtin_amdgcn_cvt_pk_f32_fp8((int)q.y, false) * x[2] + a;
  a = __builtin_amdgcn_cvt_pk_f32_fp8((int)q.y, true) * x[3] + a;
  a = __builtin_amdgcn_cvt_pk_f32_fp8((int)q.z, false) * x[4] + a;
  a = __builtin_amdgcn_cvt_pk_f32_fp8((int)q.z, true) * x[5] + a;
  a = __builtin_amdgcn_cvt_pk_f32_fp8((int)q.w, false) * x[6] + a;
  a = __builtin_amdgcn_cvt_pk_f32_fp8((int)q.w, true) * x[7] + a;
  return a.x + a.y;
}
DI void axpy16q(float c, const uint4& q, f32x2* o) {
  const f32x2 c2 = {c, c};
  o[0] = __builtin_amdgcn_cvt_pk_f32_fp8((int)q.x, false) * c2 + o[0];
  o[1] = __builtin_amdgcn_cvt_pk_f32_fp8((int)q.x, true) * c2 + o[1];
  o[2] = __builtin_amdgcn_cvt_pk_f32_fp8((int)q.y, false) * c2 + o[2];
  o[3] = __builtin_amdgcn_cvt_pk_f32_fp8((int)q.y, true) * c2 + o[3];
  o[4] = __builtin_amdgcn_cvt_pk_f32_fp8((int)q.z, false) * c2 + o[4];
  o[5] = __builtin_amdgcn_cvt_pk_f32_fp8((int)q.z, true) * c2 + o[5];
  o[6] = __builtin_amdgcn_cvt_pk_f32_fp8((int)q.w, false) * c2 + o[6];
  o[7] = __builtin_amdgcn_cvt_pk_f32_fp8((int)q.w, true) * c2 + o[7];
}
struct __attribute__((packed, aligned(8))) U4a8 { unsigned a, b, c, d; };
DI v6u load6(const unsigned char* p) { const U4a8 a = *(const U4a8*)p; const uint2 c = *(const uint2*)(p + 16); v6u q; q[0] = a.a; q[1] = a.b; q[2] = a.c; q[3] = a.d; q[4] = c.x; q[5] = c.y; return q; }
DI void phase_peer_out(const Params& p, char* lds) {
  char* ws = p.ws;
  const int tid = otid(), lane = tid & 63, wave = tid >> 6, hb = lane >> 5, l5 = lane & 31;
  int* sidx = (int*)lds + wave * 384; float* sw = (float*)(sidx + 128);
  const u16* H = (const u16*)(ws + OFF_H); const unsigned* TV = (const unsigned*)(ws + OFF_TOPV);
  const unsigned char* U6 = (const unsigned char*)(ws + OFF_U8) + 24 * l5; const unsigned char* V6 = (const unsigned char*)(ws + OFF_V8) + 24 * l5;
  const float* USC = (const float*)(ws + OFF_USC); const float* VSC = (const float*)(ws + OFF_VSC);
  const float* g3 = p.in[23]; const float* b3 = p.in[24];
  int ci = 0, cj = 0; const bool cval = lane < 50;
  if (cval) { int rem = lane, i = 0; while (true) { const int cnt = 16 / (i + 1); if (rem < cnt) break; rem -= cnt; ++i; } ci = i; cj = rem; }
  const int flat = ci * 16 + cj;
  for (int t = blockIdx.x * 8 + wave; t < T_TOK; t += gridDim.x * 8) {
    f32x2 x2[16];
#pragma unroll
    for (int i = 0; i < 4; ++i) {
      const uint4 hv = *(const uint4*)(H + (size_t)t * 1024 + 32 * l5 + 8 * i);
      x2[4 * i] = f32x2{bflo(hv.x), bfhi(hv.x)}; x2[4 * i + 1] = f32x2{bflo(hv.y), bfhi(hv.y)}; x2[4 * i + 2] = f32x2{bflo(hv.z), bfhi(hv.z)}; x2[4 * i + 3] = f32x2{bflo(hv.w), bfhi(hv.w)};
    }
    float hval[8]; int hidx[8];
#pragma unroll
    for (int hq = 0; hq < 8; ++hq) {
      const unsigned ka = TV[(size_t)t * 256 + (2 * hq) * 16 + ci], kb = TV[(size_t)t * 256 + (2 * hq + 1) * 16 + cj];
      const float va = __uint_as_float(ka & 0xFFFFFF80u), vb = __uint_as_float(kb & 0xFFFFFF80u);
      const int ia = 127 - (int)(ka & 127u), ib = 127 - (int)(kb & 127u);
      hval[hq] = cval ? va + vb : -INFINITY; hidx[hq] = ia * 128 + ib;
    }
#pragma unroll
    for (int hq = 0; hq < 8; ++hq) {
      const float val = hval[hq];
      int rank = 0;
      rank_steps10<0>(val, flat, rank); rank_steps10<10>(val, flat, rank); rank_steps10<20>(val, flat, rank); rank_steps10<30>(val, flat, rank); rank_steps10<40>(val, flat, rank);
      if (cval && rank < 16) { sidx[hq * 16 + rank] = hidx[hq]; sw[hq * 16 + rank] = val; }
    }
    int el[2]; float gl[2];
#pragma unroll
    for (int grp = 0; grp < 2; ++grp) {
      el[grp] = sidx[grp * 64 + lane];
      const float sc = sw[grp * 64 + lane];
      float mx = sc; for (int o = 8; o; o >>= 1) mx = fmaxf(mx, __shfl_xor(mx, o));
      const float e = __expf(sc - mx);
      float sm = e; for (int o = 8; o; o >>= 1) sm += __shfl_xor(sm, o);
      gl[grp] = e * __builtin_amdgcn_rcpf(sm);
    }
#pragma unroll
    for (int hf = 0; hf < 2; ++hf) {
      float pd[32];
#pragma unroll
      for (int kb = 0; kb < 4; ++kb) {
        v6u qb[8];
#pragma unroll
        for (int k = 0; k < 8; ++k) {
          const int e0 = __builtin_amdgcn_readlane(el[0], hf * 32 + kb * 8 + k), e1 = __builtin_amdgcn_readlane(el[1], hf * 32 + kb * 8 + k);
          qb[k] = load6(U6 + (size_t)(hb ? e1 : e0) * 768);
        }
#pragma unroll
        for (int k = 0; k < 8; ++k) {
          const v32f f = __builtin_amdgcn_cvt_scalef32_pk32_f32_fp6(qb[k], 1.0f);
          f32x2 a = f32x2{f[0], f[1]} * x2[0];
#pragma unroll
          for (int i = 1; i < 16; ++i) a = f32x2{f[2 * i], f[2 * i + 1]} * x2[i] + a;
          pd[kb * 8 + k] = a.x + a.y;
        }
      }
#pragma unroll
      for (int off = 16; off >= 1; off >>= 1) {
        const bool up = (lane & off) != 0;
#pragma unroll
        for (int i = 0; i < off; ++i) {
          const float send = up ? pd[i] : pd[i + off];
          const float keep = up ? pd[i + off] : pd[i];
          pd[i] = keep + __shfl_xor(send, off);
        }
      }
      sw[hb * 64 + hf * 32 + l5] = pd[0];
    }
    float coefv[2];
#pragma unroll
    for (int grp = 0; grp < 2; ++grp) {
      const float dt = sw[grp * 64 + lane] * USC[el[grp]];
      const float ge = 0.5f * dt * (1.f + erff(dt * 0.7071067811865476f));
      coefv[grp] = gl[grp] * ge * VSC[el[grp]];
    }
    f32x2 o2[16];
#pragma unroll
    for (int i = 0; i < 16; ++i) o2[i] = f32x2{0.f, 0.f};
#pragma unroll
    for (int kb = 0; kb < 8; ++kb) {
      v6u qb[8];
#pragma unroll
      for (int k = 0; k < 8; ++k) {
        const int e0 = __builtin_amdgcn_readlane(el[0], kb * 8 + k), e1 = __builtin_amdgcn_readlane(el[1], kb * 8 + k);
        qb[k] = load6(V6 + (size_t)(hb ? e1 : e0) * 768);
      }
#pragma unroll
      for (int k = 0; k < 8; ++k) {
        const float c0 = __uint_as_float(__builtin_amdgcn_readlane(__float_as_uint(coefv[0]), kb * 8 + k)), c1 = __uint_as_float(__builtin_amdgcn_readlane(__float_as_uint(coefv[1]), kb * 8 + k));
        const float cf = hb ? c1 : c0;
        const f32x2 c2 = {cf, cf};
        const v32f f = __builtin_amdgcn_cvt_scalef32_pk32_f32_fp6(qb[k], 1.0f);
#pragma unroll
        for (int i = 0; i < 16; ++i) o2[i] = f32x2{f[2 * i], f[2 * i + 1]} * c2 + o2[i];
      }
    }
    float s = 0.f;
#pragma unroll
    for (int i = 0; i < 16; ++i) {
      o2[i].x += __shfl_xor(o2[i].x, 32); o2[i].y += __shfl_xor(o2[i].y, 32);
      o2[i] = x2[i] * f32x2{ALPHA, ALPHA} + o2[i]; s += o2[i].x + o2[i].y;
    }
    for (int o = 16; o; o >>= 1) s += __shfl_xor(s, o);
    const float mu = s * (1.f / 1024.f);
    float q = 0.f;
#pragma unroll
    for (int i = 0; i < 16; ++i) { const float a = o2[i].x - mu, bq = o2[i].y - mu; q += a * a + bq * bq; }
    for (int o = 16; o; o >>= 1) q += __shfl_xor(q, o);
    const float rstd = rsqrtf(q * (1.f / 1024.f) + LN_EPS);
    float* orow = p.out + (size_t)t * 1024 + 32 * l5 + 16 * hb;
#pragma unroll
    for (int q4 = 0; q4 < 4; ++q4) {
      const float4 gg = *(const float4*)(g3 + 32 * l5 + 16 * hb + 4 * q4), bb = *(const float4*)(b3 + 32 * l5 + 16 * hb + 4 * q4);
      const f32x2 a0 = hb ? o2[8 + 2 * q4] : o2[2 * q4], a1 = hb ? o2[8 + 2 * q4 + 1] : o2[2 * q4 + 1];
      float4 o;
      o.x = (a0.x - mu) * rstd * gg.x + bb.x; o.y = (a0.y - mu) * rstd * gg.y + bb.y;
      o.z = (a1.x - mu) * rstd * gg.z + bb.z; o.w = (a1.y - mu) * rstd * gg.w + bb.w;
      *(float4*)(orow + 4 * q4) = o;
    }
  }
}

#define XB_TMO      128
#define XB_XCNT(j)  (256  + 64 * (j))
#define XB_XSUB(j)  (1280 + 64 * (j))
#define XB_XGEN(j)  (2304 + 64 * (j))
#define XB_TOP      3328
#define XB_TOPGEN   3392
#define XCD_BAR_WORDS 3456
#define XB_SPIN_CAP (1u << 18)
#define LAS __attribute__((address_space(3)))
DI unsigned xb_ld(unsigned* p)              { return __hip_atomic_load(p, __ATOMIC_RELAXED, __HIP_MEMORY_SCOPE_AGENT); }
DI unsigned xb_add(unsigned* p, unsigned v) { return __hip_atomic_fetch_add(p, v, __ATOMIC_RELAXED, __HIP_MEMORY_SCOPE_AGENT); }
DI unsigned xb_xcc_id() { return (unsigned)__builtin_amdgcn_s_getreg((3 << 11) | 20) & 0xFu; }
#define XB_SPIN(cond, bar) do { unsigned _sp = 0; while (cond) { __builtin_amdgcn_s_sleep(1); \
    if ((++_sp & 255u) == 0u) { if (xb_ld(&(bar)[XB_TMO])) break; if (_sp > XB_SPIN_CAP) { atomicAdd(&(bar)[XB_TMO], 1u); break; } } } } while (0)
struct XcdBarrier { unsigned* bar; unsigned x; volatile LAS unsigned* st; };
DI XcdBarrier xcd_barrier_post(unsigned* bar, volatile LAS unsigned* st) {
  XcdBarrier b; b.bar = bar; b.x = xb_xcc_id(); b.st = st;
  if (threadIdx.x == 0) (void)xb_add(&bar[XB_XCNT(b.x)], 1u);
  return b;
}
DI void xcd_barrier_complete(unsigned* bar, unsigned x, unsigned& nloc, unsigned& nx) {
  const unsigned G = gridDim.x * gridDim.y * gridDim.z;
  unsigned sum, cnt, mine, sp = 0u;
  for (;;) {
    sum = 0u; cnt = 0u; mine = 0u;
#pragma unroll
    for (unsigned j = 0; j < 16; ++j) { const unsigned c = xb_ld(&bar[XB_XCNT(j)]); sum += c; cnt += (c > 0u) ? 1u : 0u; mine = (j == x) ? c : mine; }
    if (sum == G) break;
    __builtin_amdgcn_s_sleep(1);
    if ((++sp & 255u) == 0u) { if (xb_ld(&bar[XB_TMO])) break; if (sp > XB_SPIN_CAP) { atomicAdd(&bar[XB_TMO], 1u); break; } }
  }
  nloc = mine > 0u ? mine : 1u; nx = cnt > 0u ? cnt : 1u;
}
DI void xcd_barrier(const XcdBarrier& b) {
  asm volatile("s_waitcnt vmcnt(0)" ::: "memory");
  __syncthreads();
  if (threadIdx.x == 0) {
    unsigned* bar = b.bar;
    __builtin_amdgcn_s_waitcnt(0);
    unsigned nloc = b.st[0], nx = b.st[1];
    if (nloc == 0u) { xcd_barrier_complete(bar, b.x, nloc, nx); b.st[0] = nloc; b.st[1] = nx; }
    const unsigned old = xb_add(&bar[XB_XSUB(b.x)], 1u);
    const unsigned gen = old / nloc;
    if (old + 1u == (gen + 1u) * nloc) {
      __builtin_amdgcn_fence(__ATOMIC_RELEASE, "agent");
      asm volatile("s_waitcnt vmcnt(0)" ::: "memory");
      const unsigned og = xb_add(&bar[XB_TOP], 1u);
      const unsigned tg = og / nx;
      if (og + 1u == (tg + 1u) * nx) xb_add(&bar[XB_TOPGEN], 1u);
      else XB_SPIN(xb_ld(&bar[XB_TOPGEN]) == tg, bar);
      __builtin_amdgcn_fence(__ATOMIC_ACQUIRE, "agent");
      xb_add(&bar[XB_XGEN(b.x)], 1u);
      asm volatile("s_waitcnt vmcnt(0)" ::: "memory");
    } else {
      XB_SPIN(xb_ld(&bar[XB_XGEN(b.x)]) == gen, bar);
      __builtin_amdgcn_fence(__ATOMIC_ACQUIRE, "agent");
      asm volatile("s_waitcnt vmcnt(0)" ::: "memory");
    }
  }
  __syncthreads();
}

__global__ void __launch_bounds__(512) mega(Params p) {
  extern __shared__ __attribute__((aligned(16))) char lds[];
  cg::grid_group grid = cg::this_grid();
  char* ws = p.ws;
  u16* H = (u16*)(ws + OFF_H);
  u16* Zb = (u16*)(ws + OFF_Z);
  unsigned* barw = (unsigned*)(ws + OFF_BAR);
  volatile LAS unsigned* xst = (volatile LAS unsigned*)(LAS unsigned*)(lds + LDS_BYTES - 16);
  if (blockIdx.x == 0) for (int i = threadIdx.x; i < XCD_BAR_WORDS; i += 512) barw[i] = 0u;
  if (threadIdx.x == 0) { xst[0] = 0u; xst[1] = 0u; }
  for (int rep = 0; rep < 1 + ((PROBE_MASK >> 0) & 1); ++rep) {
    transpose_w(p.in[4], (u16*)(ws + OFF_WIN), 3592, 3584, (float*)lds);
    transpose_w(p.in[11], (u16*)(ws + OFF_WOUT), 1024, 1024, (float*)lds);
    transpose_w(p.in[14], (u16*)(ws + OFF_WQ), 1024, 1024, (float*)lds);
    transpose_w(p.in[15], (u16*)(ws + OFF_WKV), 2048, 2048, (float*)lds);
    transpose_w(p.in[16], (u16*)(ws + OFF_WO), 1024, 1024, (float*)lds);
    transpose_w(p.in[19], (u16*)(ws + OFF_WPQ), 2048, 2048, (float*)lds);
    convert_fp6_rows(p.in[21], (unsigned char*)(ws + OFF_U8), (float*)(ws + OFF_USC));
    convert_fp6_rows(p.in[22], (unsigned char*)(ws + OFF_V8), (float*)(ws + OFF_VSC));
    convert_bf16(p.in[20], (u16*)(ws + OFF_SK), (size_t)2 * 128 * 128 / 4);
    convert_bf16(p.in[1], (u16*)(ws + OFF_MEMB), (size_t)2048 * 1024 / 4);
    ln_in_rows(p.in[0], p.in[2], p.in[3], p.in[4], H, (float*)(ws + OFF_G), (float*)lds);
  }
  grid.sync();
  const XcdBarrier xb = xcd_barrier_post(barw, xst);
  if (PROBE_MASK & 0x10000) { for (int i = 0; i < 16; ++i) xcd_barrier(xb); }
  if ((PHASE_EN >> 1) & 1)
    { phase_inproj(p, lds); xcd_barrier(xb); }
  if ((PROBE_MASK >> 1) & 1) { phase_inproj(p, lds); xcd_barrier(xb); }
  if ((PHASE_EN >> 2) & 1)
    { phase_mixA(p, lds); xcd_barrier(xb); }
  if ((PROBE_MASK >> 2) & 1) { phase_mixA(p, lds); xcd_barrier(xb); }
  if ((PROBE_MASK >> 13) & 1) { for (int it = blockIdx.x; it < 4096; it += gridDim.x) mlstmA_item(p, lds, it); xcd_barrier(xb); }
  if ((PROBE_MASK >> 14) & 1) { for (int it = blockIdx.x; it < 2048; it += gridDim.x) attn_item(p, lds, it); xcd_barrier(xb); }
  if ((PHASE_EN >> 11) & 1)
    { phase_mlstm_scan(p); xcd_barrier(xb); }
  if ((PHASE_EN >> 12) & 1)
    { phase_mixC(p, lds); xcd_barrier(xb); }
  if ((PROBE_MASK >> 12) & 1) { phase_mixC(p, lds); xcd_barrier(xb); }
  if ((PHASE_EN >> 3) & 1)
    { phase_gemm1024<1>((const u16*)(ws + OFF_MIX), (const u16*)(ws + OFF_WOUT), Zb, H, lds); xcd_barrier(xb); }
  if ((PROBE_MASK >> 3) & 1) { phase_gemm1024<1>((const u16*)(ws + OFF_MIX), (const u16*)(ws + OFF_WOUT), Zb, H, lds); xcd_barrier(xb); }
  { ln_rows_b(Zb, p.in[12], p.in[13], H); xcd_barrier(xb); }
  if ((PROBE_MASK >> 4) & 1) { ln_rows_b(Zb, p.in[12], p.in[13], H); xcd_barrier(xb); }
  if ((PHASE_EN >> 5) & 1)
    { phase_gemm1024<0>(H, (const u16*)(ws + OFF_WQ), (u16*)(ws + OFF_XQ), nullptr, lds); xcd_barrier(xb); }
  if ((PROBE_MASK >> 5) & 1) { phase_gemm1024<0>(H, (const u16*)(ws + OFF_WQ), (u16*)(ws + OFF_XQ), nullptr, lds); xcd_barrier(xb); }
  if ((PHASE_EN >> 6) & 1)
    { phase_xattn(p, lds); xcd_barrier(xb); }
  if ((PROBE_MASK >> 6) & 1) { phase_xattn(p, lds); xcd_barrier(xb); }
  if ((PHASE_EN >> 7) & 1)
    { phase_gemm1024<1>((const u16*)(ws + OFF_XO), (const u16*)(ws + OFF_WO), Zb, H, lds); xcd_barrier(xb); }
  if ((PROBE_MASK >> 7) & 1) { phase_gemm1024<1>((const u16*)(ws + OFF_XO), (const u16*)(ws + OFF_WO), Zb, H, lds); xcd_barrier(xb); }
  { ln_rows_b(Zb, p.in[17], p.in[18], H); xcd_barrier(xb); }
  if ((PROBE_MASK >> 8) & 1) { ln_rows_b(Zb, p.in[17], p.in[18], H); xcd_barrier(xb); }
  if ((PHASE_EN >> 9) & 1)
    { phase_peer_query(p, lds); xcd_barrier(xb); }
  if ((PROBE_MASK >> 9) & 1) { phase_peer_query(p, lds); xcd_barrier(xb); }
  if ((PHASE_EN >> 10) & 1)
    { phase_peer_out(p, lds); }
  if ((PROBE_MASK >> 10) & 1) { phase_peer_out(p, lds); }
}

extern "C" void kernel_launch(void* const* d_in, const int* in_sizes, int n_in, void* d_out, int out_size, void* d_ws, size_t ws_size, hipStream_t stream) {
  static int grid_blocks = 0;
  if (grid_blocks == 0) {
    if (n_in != 25 || out_size != T_TOK * 1024 || ws_size < WS_NEED) { fprintf(stderr, "kernel_launch: unexpected shapes (n_in %d out %d ws %zu)\n", n_in, out_size, ws_size); grid_blocks = -1; return; }
    int dev = 0, cus = 0, per_cu = 0;
    hipGetDevice(&dev);
    hipDeviceGetAttribute(&cus, hipDeviceAttributeMultiprocessorCount, dev);
    if (hipFuncSetAttribute((const void*)mega, hipFuncAttributeMaxDynamicSharedMemorySize, LDS_BYTES) != hipSuccess) { fprintf(stderr, "hipFuncSetAttribute failed\n"); grid_blocks = -1; return; }
    hipOccupancyMaxActiveBlocksPerMultiprocessor(&per_cu, (const void*)mega, 512, LDS_BYTES);
    if (per_cu < 1) { fprintf(stderr, "occupancy query returned %d\n", per_cu); per_cu = 1; }
    grid_blocks = cus * per_cu;
  }
  if (grid_blocks < 0) return;
  Params p{};
  for (int i = 0; i < 25; ++i) p.in[i] = (const float*)d_in[i];
  p.out = (float*)d_out; p.ws = (char*)d_ws;
  void* args[] = {&p};
  hipError_t e = hipLaunchCooperativeKernel((const void*)mega, dim3(grid_blocks), dim3(512), args, LDS_BYTES, stream);
  if (e != hipSuccess) fprintf(stderr, "cooperative launch failed: %s (grid %d)\n", hipGetErrorString(e), grid_blocks);
}
```

```cpp
#include <hip/hip_runtime.h>
#include <hip/hip_cooperative_groups.h>
#include <cstdio>
namespace cg = cooperative_groups;

#ifndef PHASE_EN
#define PHASE_EN 0xFFFF
#endif
#ifndef PROBE_MASK
#define PROBE_MASK 0
#endif
#ifndef STAGE_MASK
#define STAGE_MASK 7
#endif

#define DI __device__ __forceinline__
typedef unsigned short u16;
typedef __attribute__((ext_vector_type(8))) short bf16x8;
typedef __attribute__((ext_vector_type(16))) float f32x16;
typedef __attribute__((ext_vector_type(2))) float f32x2;
#define MFMA(a, b, c) __builtin_amdgcn_mfma_f32_32x32x16_bf16((a), (b), (c), 0, 0, 0)

constexpr int T_TOK = 65536;
constexpr int SEQ = 8192;
constexpr float ALPHA = 1.189207115002721f;
constexpr float LN_EPS = 1e-5f;
constexpr int LDS_BYTES = 143360;
constexpr size_t MB = 1u << 20;
constexpr size_t OFF_WIN = 0, OFF_WOUT = 8 * MB, OFF_WQ = 10 * MB, OFF_WO = 12 * MB, OFF_WKV = 14 * MB, OFF_WPQ = 18 * MB,
                 OFF_SK = 22 * MB, OFF_MEMB = 23 * MB, OFF_KX = 27 * MB, OFF_VTX = 31 * MB, OFF_U8 = 35 * MB, OFF_V8 = 51 * MB, OFF_USC = 67 * MB, OFF_VSC = 68 * MB,
                 OFF_G = 99 * MB, OFF_H = 104 * MB, OFF_PA = 232 * MB, OFF_PM = 360 * MB, OFF_Z = 232 * MB, OFF_VTA = 488 * MB,
                 OFF_VTM = 552 * MB, OFF_XQ = 488 * MB, OFF_PO = 616 * MB, OFF_MIX = 680 * MB, OFF_XO = 680 * MB,
                 OFF_TOPV = 808 * MB, OFF_TOPI = 872 * MB, OFF_KVS = 808 * MB, OFF_KSUM = 936 * MB, OFF_CSC = 938 * MB, OFF_BAR = 939 * MB, WS_NEED = 940 * MB;

struct Params {
  const float* in[25];
  float* out;
  char* ws;
};

DI int otid() { int t = __builtin_amdgcn_workitem_id_x(); asm volatile("" : "+v"(t)); return t; }
typedef __bf16 bf16v2 __attribute__((ext_vector_type(2)));
DI unsigned pack2(float a, float b) { const f32x2 v = {a, b}; return __builtin_bit_cast(unsigned, __builtin_convertvector(v, bf16v2)); }
DI u16 f2bf(float x) { return (u16)(pack2(x, 0.f) & 0xffffu); }
DI float bf2f(u16 h) { return __uint_as_float(((unsigned)h) << 16); }
DI float bflo(unsigned w) { return __uint_as_float(w << 16); }
DI float bfhi(unsigned w) { return __uint_as_float(w & 0xffff0000u); }
DI float wsum(float v) { for (int o = 32; o; o >>= 1) v += __shfl_xor(v, o); return v; }
DI float wmax(float v) { for (int o = 32; o; o >>= 1) v = fmaxf(v, __shfl_xor(v, o)); return v; }
DI int perm23(int i) { return (i & 0x13) | (((i >> 3) & 1) << 2) | (((i >> 2) & 1) << 3); }
DI f32x16 zero16() { f32x16 z; for (int i = 0; i < 16; ++i) z[i] = 0.f; return z; }
DI bf16x8 ldfrag(const u16* p) { return *(const bf16x8*)p; }
DI void unpack8(const uint4& r, float* o) {
  o[0] = bflo(r.x); o[1] = bfhi(r.x); o[2] = bflo(r.y); o[3] = bfhi(r.y); o[4] = bflo(r.z); o[5] = bfhi(r.z); o[6] = bflo(r.w); o[7] = bfhi(r.w);
}

DI void transpose_w(const float* __restrict__ src, u16* __restrict__ dst, int N, int Npad, float* tl) {
  const int ntn = Npad >> 6, ntiles = 16 * ntn;
  for (int t = blockIdx.x; t < ntiles; t += gridDim.x) {
    const int kt = t / ntn, nt = t - kt * ntn, k0 = kt * 64, n0 = nt * 64;
    for (int e = otid(); e < 4096; e += 512) { int r = e >> 6, c = e & 63, n = n0 + c; tl[r * 65 + c] = (n < N) ? src[(size_t)(k0 + r) * N + n] : 0.f; }
    __syncthreads();
    for (int e = otid(); e < 4096; e += 512) { int r = e >> 6, c = e & 63; dst[(size_t)(n0 + r) * 1024 + k0 + c] = f2bf(tl[c * 65 + r]); }
    __syncthreads();
  }
}
DI void convert_bf16(const float* __restrict__ src, u16* __restrict__ dst, size_t n4) {
  const size_t stride = (size_t)gridDim.x * 512;
  for (size_t i = (size_t)blockIdx.x * 512 + otid(); i < n4; i += stride) {
    float4 v = ((const float4*)src)[i];
    uint2 o; o.x = pack2(v.x, v.y); o.y = pack2(v.z, v.w);
    ((uint2*)dst)[i] = o;
  }
}

DI void convert_fp8_rows(const float* __restrict__ src, unsigned char* __restrict__ dst, float* __restrict__ invscale) {
  const int lane = otid() & 63, wave = otid() >> 6;
  for (int row = blockIdx.x * 8 + wave; row < 16384; row += gridDim.x * 8) {
    const float* r = src + (size_t)row * 1024 + 16 * lane;
    float4 v[4];
    float am = 0.f;
    for (int i = 0; i < 4; ++i) { v[i] = *(const float4*)(r + 4 * i); am = fmaxf(am, fmaxf(fmaxf(fabsf(v[i].x), fabsf(v[i].y)), fmaxf(fabsf(v[i].z), fabsf(v[i].w)))); }
    am = wmax(am);
    const float sc = am > 0.f ? 256.f / am : 1.f;
    uint4 o; unsigned w[4];
    for (int i = 0; i < 4; ++i) { int t = 0; t = __builtin_amdgcn_cvt_pk_fp8_f32(v[i].x * sc, v[i].y * sc, t, false); t = __builtin_amdgcn_cvt_pk_fp8_f32(v[i].z * sc, v[i].w * sc, t, true); w[i] = (unsigned)t; }
    o.x = w[0]; o.y = w[1]; o.z = w[2]; o.w = w[3];
    *(uint4*)(dst + (size_t)row * 1024 + 16 * lane) = o;
    if (lane == 0) invscale[row] = am > 0.f ? am * (1.f / 256.f) : 1.f;
  }
}
typedef __attribute__((ext_vector_type(6))) unsigned v6u;
typedef __attribute__((ext_vector_type(16))) float v16f;
typedef __attribute__((ext_vector_type(32))) float v32f;
DI void convert_fp6_rows(const float* __restrict__ src, unsigned char* __restrict__ dst, float* __restrict__ invscale) {
  const int lane = otid() & 63, wave = otid() >> 6, hb = lane >> 5, l5 = lane & 31;
  for (int row = (blockIdx.x * 8 + wave) * 2 + hb; row < 16384; row += gridDim.x * 16) {
    const float* r = src + (size_t)row * 1024 + 32 * l5;
    v16f x, y;
    float am = 0.f;
#pragma unroll
    for (int i = 0; i < 4; ++i) {
      const float4 a = *(const float4*)(r + 4 * i), b = *(const float4*)(r + 16 + 4 * i);
      x[2 * i] = a.x; y[2 * i] = a.y; x[2 * i + 1] = a.z; y[2 * i + 1] = a.w; x[8 + 2 * i] = b.x; y[8 + 2 * i] = b.y; x[8 + 2 * i + 1] = b.z; y[8 + 2 * i + 1] = b.w;
      am = fmaxf(am, fmaxf(fmaxf(fabsf(a.x), fabsf(a.y)), fmaxf(fabsf(a.z), fabsf(a.w))));
      am = fmaxf(am, fmaxf(fmaxf(fabsf(b.x), fabsf(b.y)), fmaxf(fabsf(b.z), fabsf(b.w))));
    }
    for (int o = 16; o; o >>= 1) am = fmaxf(am, __shfl_xor(am, o));
    const float sc = am > 0.f ? 7.0f / am : 1.f;
#pragma unroll
    for (int i = 0; i < 16; ++i) { x[i] *= sc; y[i] *= sc; }
    const v6u q = __builtin_amdgcn_cvt_scalef32_2xpk16_fp6_f32(x, y, 1.0f);
    unsigned* d = (unsigned*)(dst + (size_t)row * 768 + 24 * l5);
    *(uint2*)d = make_uint2(q[0], q[1]); *(uint2*)(d + 2) = make_uint2(q[2], q[3]); *(uint2*)(d + 4) = make_uint2(q[4], q[5]);
    if (l5 == 0) invscale[row] = am > 0.f ? am * (1.f / 7.0f) : 1.f;
  }
}

DI void ln_rows(const float* __restrict__ src, const float* __restrict__ g, const float* __restrict__ bta, u16* __restrict__ dst) {
  const int lane = otid() & 63, wave = otid() >> 6;
  for (int row = blockIdx.x * 8 + wave; row < T_TOK; row += gridDim.x * 8) {
    float4 v[4];
    float s = 0.f;
    for (int i = 0; i < 4; ++i) { v[i] = *(const float4*)(src + (size_t)row * 1024 + i * 256 + lane * 4); s += v[i].x + v[i].y + v[i].z + v[i].w; }
    const float mu = wsum(s) * (1.f / 1024.f);
    float q = 0.f;
    for (int i = 0; i < 4; ++i) { float a = v[i].x - mu, b = v[i].y - mu, c = v[i].z - mu, d = v[i].w - mu; q += a * a + b * b + c * c + d * d; }
    const float rstd = rsqrtf(wsum(q) * (1.f / 1024.f) + LN_EPS);
    for (int i = 0; i < 4; ++i) {
      const int c0 = i * 256 + lane * 4;
      float4 gg = *(const float4*)(g + c0), bb = *(const float4*)(bta + c0);
      uint2 o;
      o.x = pack2((v[i].x - mu) * rstd * gg.x + bb.x, (v[i].y - mu) * rstd * gg.y + bb.y);
      o.y = pack2((v[i].z - mu) * rstd * gg.z + bb.z, (v[i].w - mu) * rstd * gg.w + bb.w);
      *(uint2*)(dst + (size_t)row * 1024 + c0) = o;
    }
  }
}
DI void ln_rows_b(const u16* __restrict__ Zb, const float* __restrict__ g, const float* __restrict__ bta, u16* __restrict__ H) {
  const int lane = otid() & 63, wave = otid() >> 6;
  float gg[16], bb[16];
  for (int i = 0; i < 4; ++i) {
    const float4 g4 = *(const float4*)(g + lane * 16 + 4 * i), b4 = *(const float4*)(bta + lane * 16 + 4 * i);
    gg[4*i] = g4.x; gg[4*i+1] = g4.y; gg[4*i+2] = g4.z; gg[4*i+3] = g4.w; bb[4*i] = b4.x; bb[4*i+1] = b4.y; bb[4*i+2] = b4.z; bb[4*i+3] = b4.w;
  }
  const int stride = gridDim.x * 8;
  for (int row0 = blockIdx.x * 8 + wave; row0 < T_TOK; row0 += stride * 4) {
    uint4 r[4][2];
#pragma unroll
    for (int j = 0; j < 4; ++j) {
      const int row = row0 + j * stride;
      if (row < T_TOK) { r[j][0] = *(const uint4*)(Zb + (size_t)row * 1024 + lane * 16); r[j][1] = *(const uint4*)(Zb + (size_t)row * 1024 + lane * 16 + 8); }
    }
#pragma unroll
    for (int j = 0; j < 4; ++j) {
      const int row = row0 + j * stride;
      if (row < T_TOK) {
        float v[16];
        unpack8(r[j][0], v); unpack8(r[j][1], v + 8);
        float s = 0.f;
#pragma unroll
        for (int i = 0; i < 16; ++i) s += v[i];
        const float mu = wsum(s) * (1.f / 1024.f);
        float q = 0.f;
#pragma unroll
        for (int i = 0; i < 16; ++i) { float a = v[i] - mu; q += a * a; }
        const float rstd = rsqrtf(wsum(q) * (1.f / 1024.f) + LN_EPS);
        uint4 o0, o1;
        o0.x = pack2((v[0] - mu) * rstd * gg[0] + bb[0], (v[1] - mu) * rstd * gg[1] + bb[1]); o0.y = pack2((v[2] - mu) * rstd * gg[2] + bb[2], (v[3] - mu) * rstd * gg[3] + bb[3]);
        o0.z = pack2((v[4] - mu) * rstd * gg[4] + bb[4], (v[5] - mu) * rstd * gg[5] + bb[5]); o0.w = pack2((v[6] - mu) * rstd * gg[6] + bb[6], (v[7] - mu) * rstd * gg[7] + bb[7]);
        o1.x = pack2((v[8] - mu) * rstd * gg[8] + bb[8], (v[9] - mu) * rstd * gg[9] + bb[9]); o1.y = pack2((v[10] - mu) * rstd * gg[10] + bb[10], (v[11] - mu) * rstd * gg[11] + bb[11]);
        o1.z = pack2((v[12] - mu) * rstd * gg[12] + bb[12], (v[13] - mu) * rstd * gg[13] + bb[13]); o1.w = pack2((v[14] - mu) * rstd * gg[14] + bb[14], (v[15] - mu) * rstd * gg[15] + bb[15]);
        *(uint4*)(H + (size_t)row * 1024 + lane * 16) = o0;
        *(uint4*)(H + (size_t)row * 1024 + lane * 16 + 8) = o1;
      }
    }
  }
}
DI void ln_in_rows(const float* __restrict__ src, const float* __restrict__ g, const float* __restrict__ bta, const float* __restrict__ w_in, u16* __restrict__ dst, float* __restrict__ G, float* Wg) {
  const int lane = otid() & 63, wave = otid() >> 6;
  for (int e = otid(); e < 8192; e += 512) Wg[e] = w_in[(size_t)(e >> 3) * 3592 + 3584 + (e & 7)];
  __syncthreads();
  float4 nv[4];
  { const int row = blockIdx.x * 8 + wave; for (int i = 0; i < 4; ++i) nv[i] = *(const float4*)(src + (size_t)row * 1024 + i * 256 + lane * 4); }
  for (int row = blockIdx.x * 8 + wave; row < T_TOK; row += gridDim.x * 8) {
    float4 v[4];
    float s = 0.f;
    for (int i = 0; i < 4; ++i) { v[i] = nv[i]; s += v[i].x + v[i].y + v[i].z + v[i].w; }
    { const int nrow = row + gridDim.x * 8; if (nrow < T_TOK) for (int i = 0; i < 4; ++i) nv[i] = *(const float4*)(src + (size_t)nrow * 1024 + i * 256 + lane * 4); }
    const float mu = wsum(s) * (1.f / 1024.f);
    float q = 0.f;
    for (int i = 0; i < 4; ++i) { float a = v[i].x - mu, b = v[i].y - mu, c = v[i].z - mu, d = v[i].w - mu; q += a * a + b * b + c * c + d * d; }
    const float rstd = rsqrtf(wsum(q) * (1.f / 1024.f) + LN_EPS);
    float pg[8];
#pragma unroll
    for (int j = 0; j < 8; ++j) pg[j] = 0.f;
#pragma unroll
    for (int i = 0; i < 4; ++i) {
      const int c0 = i * 256 + lane * 4;
      float4 gg = *(const float4*)(g + c0), bb = *(const float4*)(bta + c0);
      float y[4];
      y[0] = (v[i].x - mu) * rstd * gg.x + bb.x; y[1] = (v[i].y - mu) * rstd * gg.y + bb.y; y[2] = (v[i].z - mu) * rstd * gg.z + bb.z; y[3] = (v[i].w - mu) * rstd * gg.w + bb.w;
      uint2 o; o.x = pack2(y[0], y[1]); o.y = pack2(y[2], y[3]);
      *(uint2*)(dst + (size_t)row * 1024 + c0) = o;
#pragma unroll
      for (int e = 0; e < 4; ++e) {
        const float4 w0 = *(const float4*)(Wg + (c0 + e) * 8), w1 = *(const float4*)(Wg + (c0 + e) * 8 + 4);
        pg[0] += y[e] * w0.x; pg[1] += y[e] * w0.y; pg[2] += y[e] * w0.z; pg[3] += y[e] * w0.w;
        pg[4] += y[e] * w1.x; pg[5] += y[e] * w1.y; pg[6] += y[e] * w1.z; pg[7] += y[e] * w1.w;
      }
    }
#pragma unroll
    for (int off = 32; off >= 8; off >>= 1) {
      const bool up = (lane & off) != 0;
      const int nkeep = off >> 3;
#pragma unroll
      for (int i = 0; i < 4; ++i) if (i < nkeep) {
        const float send = up ? pg[i] : pg[i + nkeep];
        const float keep = up ? pg[i + nkeep] : pg[i];
        pg[i] = keep + __shfl_xor(send, off);
      }
    }
    float tot = pg[0];
    tot += __shfl_xor(tot, 4); tot += __shfl_xor(tot, 2); tot += __shfl_xor(tot, 1);
    if ((lane & 7) == 0) G[(size_t)row * 8 + (lane >> 3)] = tot;
  }
}

typedef __attribute__((ext_vector_type(4))) float f32x4;
#define MFMA16(a, b, c) __builtin_amdgcn_mfma_f32_16x16x32_bf16((a), (b), (c), 0, 0, 0)
DI uint2 pack4(const f32x16& a, int g) { uint2 o; o.x = pack2(a[4 * g], a[4 * g + 1]); o.y = pack2(a[4 * g + 2], a[4 * g + 3]); return o; }
DI void stage_rc(int b, int& R, int& C) { const int st = b >> 10, sb = b & 1023, swz = sb ^ (((sb >> 9) & 1) << 5); R = (st >> 1) * 16 + (swz >> 6); C = (st & 1) * 32 + ((swz & 63) >> 1); }
constexpr int CT_LD = 264;
template <int SWAP>
DI void gemm256(const u16* __restrict__ Ab, const u16* __restrict__ Bb, const u16* __restrict__ nAb, const u16* __restrict__ nBb, bool first, bool has_next, f32x4 (&acc)[8][4], char* lds) {
  const int tid = otid(), wid = tid >> 6, lane = tid & 63, wr = wid >> 2, wc = wid & 3, fr = lane & 15, fq = lane >> 4;
  int goff[4];
#pragma unroll
  for (int i = 0; i < 4; ++i) { int R, C; stage_rc(wid * 1024 + i * 8192 + lane * 16, R, C); goff[i] = R * 1024 + C; }
#pragma unroll
  for (int m = 0; m < 8; ++m)
#pragma unroll
    for (int n = 0; n < 4; ++n) acc[m][n] = f32x4{0.f, 0.f, 0.f, 0.f};
  const int ob = fr * 64 + fq * 16, obs = ob ^ (((ob >> 9) & 1) << 5);
  const int aoff = wr * 16384 + obs, boff = 32768 + wc * 8192 + obs;
#define GLDS_STAGE(buf, pa, pb, kt) do { _Pragma("unroll") for (int i = 0; i < 4; ++i) { \
    __builtin_amdgcn_global_load_lds((const unsigned*)((pa) + goff[i] + (kt) * 64), (__attribute__((address_space(3))) unsigned*)(lds + (buf) * 65536 + wid * 1024 + i * 8192), 16, 0, 0); \
    __builtin_amdgcn_global_load_lds((const unsigned*)((pb) + goff[i] + (kt) * 64), (__attribute__((address_space(3))) unsigned*)(lds + (buf) * 65536 + 32768 + wid * 1024 + i * 8192), 16, 0, 0); } } while (0)
  if (first) {
    GLDS_STAGE(0, Ab, Bb, 0);
    asm volatile("s_waitcnt vmcnt(0)" ::: "memory");
    __syncthreads();
  }
#pragma unroll 1
  for (int t = 0; t < 16; ++t) {
    const int cur = t & 1;
    if (t < 15) GLDS_STAGE(cur ^ 1, Ab, Bb, t + 1);
    else if (has_next) GLDS_STAGE(0, nAb, nBb, 0);
    const char* sa = lds + cur * 65536 + aoff;
    const char* sb = lds + cur * 65536 + boff;
#pragma unroll
    for (int ks = 0; ks < 2; ++ks) {
      bf16x8 At[8], Bf[4];
#pragma unroll
      for (int m = 0; m < 8; ++m) At[m] = *(const bf16x8*)(sa + m * 2048 + ks * 1024);
#pragma unroll
      for (int n = 0; n < 4; ++n) Bf[n] = *(const bf16x8*)(sb + n * 2048 + ks * 1024);
#pragma unroll
      for (int m = 0; m < 8; ++m)
#pragma unroll
        for (int n = 0; n < 4; ++n) acc[m][n] = SWAP ? MFMA16(Bf[n], At[m], acc[m][n]) : MFMA16(At[m], Bf[n], acc[m][n]);
      __builtin_amdgcn_sched_group_barrier(0x100, 12, 0);
      __builtin_amdgcn_sched_group_barrier(0x008, 32, 0);
      __builtin_amdgcn_sched_barrier(0);
    }
    asm volatile("s_waitcnt vmcnt(0)" ::: "memory");
    __syncthreads();
  }
#undef GLDS_STAGE
}
DI void stage_acc(const f32x4 (&acc)[8][4], u16* Ct) {
  const int tid = otid(), wid = tid >> 6, lane = tid & 63, wr = wid >> 2, wc = wid & 3, fr = lane & 15, fq = lane >> 4;
#pragma unroll
  for (int m = 0; m < 8; ++m)
#pragma unroll
    for (int n = 0; n < 4; ++n) {
      uint2 o; o.x = pack2(acc[m][n][0], acc[m][n][1]); o.y = pack2(acc[m][n][2], acc[m][n][3]);
      *(uint2*)(Ct + (wr * 128 + m * 16 + fr) * CT_LD + wc * 64 + n * 16 + fq * 4) = o;
    }
}
template <int SWAP>
DI void store_acc(const f32x4 (&acc)[8][4], u16* __restrict__ dst, size_t ld) {
  const int tid = otid(), wid = tid >> 6, lane = tid & 63, wr = wid >> 2, wc = wid & 3, fr = lane & 15, fq = lane >> 4;
#pragma unroll
  for (int m = 0; m < 8; ++m)
#pragma unroll
    for (int n = 0; n < 4; ++n) {
      uint2 o; o.x = pack2(acc[m][n][0], acc[m][n][1]); o.y = pack2(acc[m][n][2], acc[m][n][3]);
      if (SWAP) *(uint2*)(dst + (size_t)(wr * 128 + m * 16 + fr) * ld + wc * 64 + n * 16 + fq * 4) = o;
      else *(uint2*)(dst + (size_t)(wc * 64 + n * 16 + fr) * ld + wr * 128 + m * 16 + fq * 4) = o;
    }
}
template <int SWAP, int MODE>
DI void epilogue_staged(const f32x4 (&acc)[8][4], char* lds, u16* __restrict__ dst, size_t ld, const u16* __restrict__ Hres) {
  const int tid = otid(), wid = tid >> 6, lane = tid & 63, wr = wid >> 2, wc = wid & 3, fr = lane & 15, fq = lane >> 4;
  u16* Ct = (u16*)(lds + 65536);
#pragma unroll
  for (int h = 0; h < 2; ++h) {
    if ((SWAP ? wr : (wc >> 1)) == h) {
#pragma unroll
      for (int m = 0; m < 8; ++m)
#pragma unroll
        for (int n = 0; n < 4; ++n) {
          uint2 o; o.x = pack2(acc[m][n][0], acc[m][n][1]); o.y = pack2(acc[m][n][2], acc[m][n][3]);
          if (SWAP) *(uint2*)(Ct + (m * 16 + fr) * CT_LD + wc * 64 + n * 16 + fq * 4) = o;
          else *(uint2*)(Ct + ((wc & 1) * 64 + n * 16 + fr) * CT_LD + wr * 128 + m * 16 + fq * 4) = o;
        }
    }
    __syncthreads();
#pragma unroll 4
    for (int i = 0; i < 8; ++i) {
      const int q = tid + 512 * i, r = q >> 5, c8 = (q & 31) * 8;
      uint4 v = *(const uint4*)(Ct + r * CT_LD + c8);
      const size_t o = (size_t)(h * 128 + r) * ld + c8;
      if (MODE == 1) {
        const uint4 hv = *(const uint4*)(Hres + o);
        float y[8], hx[8]; unpack8(v, y); unpack8(hv, hx);
        v.x = pack2(ALPHA * hx[0] + y[0], ALPHA * hx[1] + y[1]); v.y = pack2(ALPHA * hx[2] + y[2], ALPHA * hx[3] + y[3]);
        v.z = pack2(ALPHA * hx[4] + y[4], ALPHA * hx[5] + y[5]); v.w = pack2(ALPHA * hx[6] + y[6], ALPHA * hx[7] + y[7]);
      }
      *(uint4*)(dst + o) = v;
    }
    __syncthreads();
  }
}
DI int lds_byte8(int r, int c) { const int st = (r >> 4) * 2 + (c >> 5), ob = (r & 15) * 64 + (c & 31) * 2; return st * 1024 + (ob ^ (((ob >> 9) & 1) << 5)); }
template <int SWAP>
DI void gemm8p(const u16* __restrict__ Ab, const u16* __restrict__ Bb, f32x4 (&acc)[2][2][4][2], char* lds) {
  constexpr int K = 1024, BK = 64, HALF = 128, HTB = 128 * 64 * 2;
  const int tid = otid(), wid = tid >> 6, lane = tid & 63, wr = wid >> 2, wc = wid & 3, fr = lane & 15, fq = lane >> 4;
  int goff0;
  { int R, C; stage_rc(tid * 16, R, C); goff0 = R * K + C; }
#define SA8(b, h) (lds + ((b) * 2 + (h)) * HTB)
#define SB8(b, h) (lds + (4 + (b) * 2 + (h)) * HTB)
#define STAGE8(P, BASE, br, kt) do { _Pragma("unroll") for (int _i = 0; _i < 2; ++_i) \
    __builtin_amdgcn_global_load_lds((const unsigned*)((BASE) + (size_t)((br) + 64 * _i) * K + (kt) * BK + goff0), (__attribute__((address_space(3))) unsigned*)((P) + wid * 1024 + _i * 8192), 16, 0, 0); } while (0)
#define LDA8(dst, b, h) _Pragma("unroll") for (int m = 0; m < 4; ++m) _Pragma("unroll") for (int k = 0; k < 2; ++k) \
    dst[m][k] = *(const bf16x8*)(SA8(b, h) + lds_byte8(wr * 64 + m * 16 + fr, k * 32 + fq * 8))
#define LDB8(dst, b, h) _Pragma("unroll") for (int n = 0; n < 2; ++n) _Pragma("unroll") for (int k = 0; k < 2; ++k) \
    dst[n][k] = *(const bf16x8*)(SB8(b, h) + lds_byte8(wc * 32 + n * 16 + fr, k * 32 + fq * 8))
#define MMA8(ai, bj, At_, Bt_) do { __builtin_amdgcn_s_setprio(1); \
    _Pragma("unroll") for (int m = 0; m < 4; ++m) _Pragma("unroll") for (int n = 0; n < 2; ++n) _Pragma("unroll") for (int k = 0; k < 2; ++k) \
      acc[ai][bj][m][n] = SWAP ? MFMA16(Bt_[n][k], At_[m][k], acc[ai][bj][m][n]) : MFMA16(At_[m][k], Bt_[n][k], acc[ai][bj][m][n]); \
    __builtin_amdgcn_s_setprio(0); } while (0)
#define WAIT_V(n) asm volatile("s_waitcnt vmcnt(" #n ")" ::: "memory")
#define WAIT_L(n) asm volatile("s_waitcnt lgkmcnt(" #n ")" ::: "memory")
#define BAR8 __builtin_amdgcn_s_barrier()
#define SCHED8 __builtin_amdgcn_sched_barrier(0)
#pragma unroll
  for (int ai = 0; ai < 2; ++ai)
#pragma unroll
    for (int bj = 0; bj < 2; ++bj)
#pragma unroll
      for (int m = 0; m < 4; ++m)
#pragma unroll
        for (int n = 0; n < 2; ++n) acc[ai][bj][m][n] = f32x4{0.f, 0.f, 0.f, 0.f};
  bf16x8 At[4][2], B0[2][2], B1[2][2];
  constexpr int nt = K / BK;
  STAGE8(SB8(0, 0), Bb, 0, 0); STAGE8(SA8(0, 0), Ab, 0, 0);
  STAGE8(SB8(0, 1), Bb, HALF, 0); STAGE8(SA8(0, 1), Ab, HALF, 0);
  if (wr == 1) BAR8;
  WAIT_V(4); BAR8;
  STAGE8(SB8(1, 0), Bb, 0, 1); STAGE8(SA8(1, 0), Ab, 0, 1); STAGE8(SB8(1, 1), Bb, HALF, 1);
  WAIT_V(6); BAR8;
#pragma unroll 1
  for (int t = 0; t < nt - 2; t += 2) {
    LDB8(B0, 0, 0); SCHED8; LDA8(At, 0, 0); STAGE8(SA8(1, 1), Ab, HALF, t + 1);
    WAIT_L(8); BAR8; WAIT_L(0); MMA8(0, 0, At, B0); BAR8; SCHED8;
    LDB8(B1, 0, 1); STAGE8(SB8(0, 0), Bb, 0, t + 2);
    BAR8; WAIT_L(0); MMA8(0, 1, At, B1); BAR8;
    LDA8(At, 0, 1); STAGE8(SA8(0, 0), Ab, 0, t + 2);
    BAR8; WAIT_L(0); MMA8(1, 0, At, B0); BAR8; SCHED8;
    STAGE8(SB8(0, 1), Bb, HALF, t + 2);
    WAIT_V(6); BAR8; MMA8(1, 1, At, B1); BAR8;
    LDB8(B0, 1, 0); SCHED8; LDA8(At, 1, 0); STAGE8(SA8(0, 1), Ab, HALF, t + 2);
    WAIT_L(8); BAR8; WAIT_L(0); MMA8(0, 0, At, B0); BAR8; SCHED8;
    LDB8(B1, 1, 1); STAGE8(SB8(1, 0), Bb, 0, t + 3);
    BAR8; WAIT_L(0); MMA8(0, 1, At, B1); BAR8;
    LDA8(At, 1, 1); STAGE8(SA8(1, 0), Ab, 0, t + 3);
    BAR8; WAIT_L(0); MMA8(1, 0, At, B0); BAR8; SCHED8;
    STAGE8(SB8(1, 1), Bb, HALF, t + 3);
    WAIT_V(6); BAR8; MMA8(1, 1, At, B1); BAR8;
  }
  { LDB8(B0, 0, 0); LDA8(At, 0, 0); STAGE8(SA8(1, 1), Ab, HALF, nt - 1);
    BAR8; WAIT_L(0); MMA8(0, 0, At, B0); BAR8;
    LDB8(B1, 0, 1); BAR8; WAIT_L(0); MMA8(0, 1, At, B1); BAR8;
    LDA8(At, 0, 1); WAIT_V(4); BAR8; WAIT_L(0); MMA8(1, 0, At, B0); MMA8(1, 1, At, B1); BAR8; }
  { LDB8(B0, 1, 0); LDA8(At, 1, 0); WAIT_V(2); BAR8; WAIT_L(0); MMA8(0, 0, At, B0); BAR8;
    LDB8(B1, 1, 1); WAIT_V(0); BAR8; WAIT_L(0); MMA8(0, 1, At, B1); BAR8;
    LDA8(At, 1, 1); BAR8; WAIT_L(0); MMA8(1, 0, At, B0); MMA8(1, 1, At, B1); BAR8; }
  if (wr == 0) BAR8;
  __syncthreads();
#undef SA8
#undef SB8
#undef STAGE8
#undef LDA8
#undef LDB8
#undef MMA8
#undef WAIT_V
#undef WAIT_L
#undef BAR8
#undef SCHED8
}
template <int SWAP>
DI void stage8(const f32x4 (&acc)[2][2][4][2], u16* Ct) {
  const int tid = otid(), wid = tid >> 6, lane = tid & 63, wr = wid >> 2, wc = wid & 3, fr = lane & 15, fq = lane >> 4;
#pragma unroll
  for (int ai = 0; ai < 2; ++ai)
#pragma unroll
    for (int bj = 0; bj < 2; ++bj)
#pragma unroll
      for (int m = 0; m < 4; ++m)
#pragma unroll
        for (int n = 0; n < 2; ++n) {
          uint2 o; o.x = pack2(acc[ai][bj][m][n][0], acc[ai][bj][m][n][1]); o.y = pack2(acc[ai][bj][m][n][2], acc[ai][bj][m][n][3]);
          if (SWAP) *(uint2*)(Ct + (ai * 128 + wr * 64 + m * 16 + fr) * CT_LD + bj * 128 + wc * 32 + n * 16 + fq * 4) = o;
          else *(uint2*)(Ct + (bj * 128 + wc * 32 + n * 16 + fr) * CT_LD + ai * 128 + wr * 64 + m * 16 + fq * 4) = o;
        }
}
template <int SWAP, int MODE>
DI void epilogue8(const f32x4 (&acc)[2][2][4][2], char* lds, u16* __restrict__ dst, size_t ld, const u16* __restrict__ Hres) {
  const int tid = otid();
  u16* Ct = (u16*)lds;
  stage8<SWAP>(acc, Ct);
  __syncthreads();
#pragma unroll 4
  for (int i = 0; i < 16; ++i) {
    const int q = tid + 512 * i, r = q >> 5, c8 = (q & 31) * 8;
    uint4 v = *(const uint4*)(Ct + r * CT_LD + c8);
    const size_t o = (size_t)r * ld + c8;
    if (MODE == 1) {
      const uint4 hv = *(const uint4*)(Hres + o);
      float y[8], hx[8]; unpack8(v, y); unpack8(hv, hx);
      v.x = pack2(ALPHA * hx[0] + y[0], ALPHA * hx[1] + y[1]); v.y = pack2(ALPHA * hx[2] + y[2], ALPHA * hx[3] + y[3]);
      v.z = pack2(ALPHA * hx[4] + y[4], ALPHA * hx[5] + y[5]); v.w = pack2(ALPHA * hx[6] + y[6], ALPHA * hx[7] + y[7]);
    }
    *(uint4*)(dst + o) = v;
  }
  __syncthreads();
}

DI bool tile_of(int it, int MT, int NT, int& mt, int& nt) {
  const int nb = gridDim.x;
  if ((nb & 7) == 0 && (MT & 7) == 0) {
    const int x = blockIdx.x & 7, slot = blockIdx.x >> 3, nx = nb >> 3, j = slot + it * nx, per = (MT >> 3) * NT;
    if (j >= per) return false;
    if (NT == 14 && (MT >> 3) == 32) {
      const int r = j / 28, w = j - r * 28, nh = r >> 3, mg = r & 7;
      mt = x * 32 + mg * 4 + w / 7; nt = nh * 7 + w % 7; return true;
    }
    mt = x * (MT >> 3) + j / NT; nt = j % NT; return true;
  }
  const int j = blockIdx.x + it * nb;
  if (j >= MT * NT) return false;
  mt = j / NT; nt = j % NT; return true;
}

DI void phase_inproj(const Params& p, char* lds) {
  char* ws = p.ws;
  const u16* A = (const u16*)(ws + OFF_H); const u16* W = (const u16*)(ws + OFF_WIN);
  int mt, nt; bool have = tile_of(0, 256, 14, mt, nt);
  for (int it = 0; have; ++it) {
    const int m0 = mt * 256, n0 = nt * 256;
    int mtn, ntn; const bool hn = tile_of(it + 1, 256, 14, mtn, ntn);
    const u16* nA = A + (size_t)(hn ? mtn : 0) * 256 * 1024; const u16* nB = W + (size_t)(hn ? ntn : 0) * 256 * 1024;
    const bool tr = (n0 >= 1024 && n0 < 1536) || (n0 >= 2560 && n0 < 3072);
    f32x4 acc[2][2][4][2];
    if (tr) {
      gemm8p<0>(A + (size_t)m0 * 1024, W + (size_t)n0 * 1024, acc, lds);
      u16* dst = (n0 < 1536) ? (u16*)(ws + OFF_VTA) + ((size_t)((m0 >> 13) * 512 + (n0 - 1024))) * SEQ + (m0 & 8191)
                             : (u16*)(ws + OFF_VTM) + ((size_t)((m0 >> 13) * 512 + (n0 - 2560))) * SEQ + (m0 & 8191);
      epilogue8<0, 0>(acc, lds, dst, SEQ, nullptr);
    } else {
      gemm8p<1>(A + (size_t)m0 * 1024, W + (size_t)n0 * 1024, acc, lds);
      u16* dst; size_t ld;
      if (n0 < 1024) { dst = (u16*)(ws + OFF_PA) + (size_t)m0 * 1024 + n0; ld = 1024; }
      else if (n0 < 2560) { dst = (u16*)(ws + OFF_PM) + (size_t)m0 * 1024 + (n0 - 1536); ld = 1024; }
      else { dst = (u16*)(ws + OFF_PO) + (size_t)m0 * 512 + (n0 - 3072); ld = 512; }
      epilogue8<1, 0>(acc, lds, dst, ld, nullptr);
    }
    mt = mtn; nt = ntn; have = hn;
  }
  for (int it = 0;; ++it) {
    if (!tile_of(it, 8, 8, mt, nt)) break;
    const int m0 = mt * 256, n0 = nt * 256;
    const u16* Am = (const u16*)(ws + OFF_MEMB) + (size_t)m0 * 1024; const u16* Bm = (const u16*)(ws + OFF_WKV) + (size_t)n0 * 1024;
    f32x4 acc[2][2][4][2];
    if (n0 >= 1024) { gemm8p<0>(Am, Bm, acc, lds); epilogue8<0, 0>(acc, lds, (u16*)(ws + OFF_VTX) + ((size_t)((m0 >> 8) * 1024 + (n0 - 1024))) * 256, 256, nullptr); }
    else { gemm8p<1>(Am, Bm, acc, lds); epilogue8<1, 0>(acc, lds, (u16*)(ws + OFF_KX) + (size_t)m0 * 1024 + n0, 1024, nullptr); }
  }
}

template <int MODE>
DI void phase_gemm1024(const u16* __restrict__ A, const u16* __restrict__ Wt, u16* __restrict__ dstb, const u16* __restrict__ Hres, char* lds) {
  const int tid = otid(), wid = tid >> 6, lane = tid & 63, wr = wid >> 2, wc = wid & 3, fr = lane & 15, fq = lane >> 4;
  int mt, nt; bool have = tile_of(0, 256, 4, mt, nt);
  for (int it = 0; have; ++it) {
    const int m0 = mt * 256, n0 = nt * 256;
    int mtn, ntn; const bool hn = tile_of(it + 1, 256, 4, mtn, ntn);
    f32x4 acc[2][2][4][2];
    gemm8p<1>(A + (size_t)m0 * 1024, Wt + (size_t)n0 * 1024, acc, lds);
    epilogue8<1, MODE>(acc, lds, dstb + (size_t)m0 * 1024 + n0, 1024, (MODE == 1) ? Hres + (size_t)m0 * 1024 + n0 : nullptr);
    mt = mtn; nt = ntn; have = hn;
  }
}

DI void attn_item(const Params& p, char* lds, int item) {
  char* ws = p.ws;
  const int tid = otid(), lane = tid & 63, wave = tid >> 6, l31 = lane & 31, hh = lane >> 5;
  const int b = item >> 8, h = (item >> 5) & 7, c0 = (item & 31) * 4;
  const int qc = c0 + (wave >> 1), qt = wave & 1;
  const u16* PA = (const u16*)(ws + OFF_PA); const u16* VTa = (const u16*)(ws + OFF_VTA); u16* MIX = (u16*)(ws + OFF_MIX);
  u16* Kl = (u16*)lds;
  u16* Vl = Kl + 2 * 64 * 72;
  float* biasl = (float*)(Vl + 2 * 64 * 72);
  const int pi = perm23(l31);
  const int sr = tid >> 3, sc8 = (tid & 7) * 8;
  const u16* kg = PA + ((size_t)b * SEQ + sr) * 1024 + 512 + h * 64 + sc8;
  const u16* vg = VTa + ((size_t)((b * 8 + h) * 64 + sr)) * SEQ + sc8;
  for (int i = tid; i < 257; i += 512) biasl[i] = p.in[10][h * 257 + i] * 1.4426950408889634f;
  const size_t q0 = (size_t)b * SEQ + qc * 64 + qt * 32;
  bf16x8 Qf[4];
#pragma unroll
  for (int kk = 0; kk < 4; ++kk) Qf[kk] = ldfrag(PA + (q0 + l31) * 1024 + h * 64 + kk * 16 + 8 * hh);
  const int kcs = (c0 >= 8) ? c0 - 8 : 0, kce = c0 + 3;
  *(uint4*)(Kl + sr * 72 + sc8) = *(const uint4*)(kg + (size_t)(kcs * 64) * 1024);
  *(uint4*)(Vl + sr * 72 + sc8) = *(const uint4*)(vg + kcs * 64);
  __syncthreads();
  f32x16 O[2]; O[0] = zero16(); O[1] = zero16();
  float mrun = -INFINITY, lrun = 0.f;
#pragma unroll 1
  for (int kc = kcs; kc <= kce; ++kc) {
    const int cur = (kc - kcs) & 1;
    uint4 nk, nv;
    if (kc < kce) { nk = *(const uint4*)(kg + (size_t)((kc + 1) * 64) * 1024); nv = *(const uint4*)(vg + (kc + 1) * 64); }
    if (kc >= qc - 8 && kc <= qc) {
      f32x16 S[2];
      float mx = -INFINITY;
#pragma unroll
      for (int sub = 0; sub < 2; ++sub) {
        const u16* kl = Kl + cur * 64 * 72 + (sub * 32 + pi) * 72 + 8 * hh;
        S[sub] = zero16();
#pragma unroll
        for (int kk = 0; kk < 4; ++kk) S[sub] = MFMA(ldfrag(kl + kk * 16), Qf[kk], S[sub]);
        const int relbase = (kc * 64 + sub * 32 + 8 * hh) - (qc * 64 + qt * 32 + l31);
        if ((kc * 64 + sub * 32 + 31) - (qc * 64 + qt * 32) <= -128) {
          const float b0 = biasl[0];
#pragma unroll
          for (int r = 0; r < 16; ++r) { const float sv = S[sub][r] * 0.18033688011112042f + b0; S[sub][r] = sv; mx = fmaxf(mx, sv); }
        } else {
#pragma unroll
          for (int r = 0; r < 16; ++r) {
            int rel = relbase + 16 * (r >> 3) + (r & 7);
            rel = rel < -128 ? -128 : (rel > 128 ? 128 : rel);
            const float sv = S[sub][r] * 0.18033688011112042f + biasl[rel + 128];
            S[sub][r] = sv; mx = fmaxf(mx, sv);
          }
        }
      }
      mx = fmaxf(mx, __shfl_xor(mx, 32));
      const float mnew = fmaxf(mrun, mx);
      const float alpha = __builtin_amdgcn_exp2f(mrun - mnew);
      mrun = mnew;
      float ps = 0.f;
#pragma unroll
      for (int sub = 0; sub < 2; ++sub)
#pragma unroll
        for (int r = 0; r < 16; ++r) { const float e = __builtin_amdgcn_exp2f(S[sub][r] - mnew); S[sub][r] = e; ps += e; }
      lrun = lrun * alpha + ps;
#pragma unroll
      for (int r = 0; r < 16; ++r) { O[0][r] *= alpha; O[1][r] *= alpha; }
#pragma unroll
      for (int sub = 0; sub < 2; ++sub) {
        bf16x8 Pf[2];
#pragma unroll
        for (int ks = 0; ks < 2; ++ks) {
          union { bf16x8 v; unsigned u[4]; } cv;
          for (int j2 = 0; j2 < 4; ++j2) cv.u[j2] = pack2(S[sub][8 * ks + 2 * j2], S[sub][8 * ks + 2 * j2 + 1]);
          Pf[ks] = cv.v;
        }
        const u16* vl = Vl + cur * 64 * 72 + l31 * 72 + sub * 32 + 8 * hh;
#pragma unroll
        for (int dt = 0; dt < 2; ++dt)
#pragma unroll
          for (int ks = 0; ks < 2; ++ks) O[dt] = MFMA(ldfrag(vl + dt * 32 * 72 + 16 * ks), Pf[ks], O[dt]);
      }
    }
    if (kc < kce) { const int nx = cur ^ 1; *(uint4*)(Kl + nx * 64 * 72 + sr * 72 + sc8) = nk; *(uint4*)(Vl + nx * 64 * 72 + sr * 72 + sc8) = nv; }
    __syncthreads();
  }
  const float inv = __builtin_amdgcn_rcpf(lrun + __shfl_xor(lrun, 32));
#pragma unroll
  for (int dt = 0; dt < 2; ++dt)
#pragma unroll
    for (int g = 0; g < 4; ++g) {
      uint2 o; o.x = pack2(O[dt][4 * g] * inv, O[dt][4 * g + 1] * inv); o.y = pack2(O[dt][4 * g + 2] * inv, O[dt][4 * g + 3] * inv);
      *(uint2*)(MIX + (q0 + l31) * 1024 + h * 64 + dt * 32 + 8 * g + 4 * hh) = o;
    }
}

DI float log_sigmoid(float f) { return fminf(f, 0.f) - log1pf(expf(-fabsf(f))); }
DI float scan_sum(float v, int lane) { for (int o = 1; o < 64; o <<= 1) { float tv = __shfl_up(v, o); if (lane >= o) v += tv; } return v; }
DI float scan_max(float v, int lane) { for (int o = 1; o < 64; o <<= 1) { float tv = __shfl_up(v, o); if (lane >= o) v = fmaxf(v, tv); } return v; }

DI void conv_unit(const u16* __restrict__ PM, const float* __restrict__ conv_w, const float* __restrict__ conv_b, int b, int sl0, int ch, float scale, float* a8) {
  { const float4 b0 = *(const float4*)(conv_b + ch), b1 = *(const float4*)(conv_b + ch + 4); a8[0] = b0.x; a8[1] = b0.y; a8[2] = b0.z; a8[3] = b0.w; a8[4] = b1.x; a8[5] = b1.y; a8[6] = b1.z; a8[7] = b1.w; }
#pragma unroll
  for (int j = 0; j < 4; ++j) {
    const int sl = sl0 - 3 + j;
    if (sl >= 0) {
      const uint4 raw = *(const uint4*)(PM + ((size_t)b * SEQ + sl) * 1024 + ch);
      float x8[8]; unpack8(raw, x8);
      const float4 w0 = *(const float4*)(conv_w + j * 1024 + ch), w1 = *(const float4*)(conv_w + j * 1024 + ch + 4);
      a8[0] += w0.x * x8[0]; a8[1] += w0.y * x8[1]; a8[2] += w0.z * x8[2]; a8[3] += w0.w * x8[3];
      a8[4] += w1.x * x8[4]; a8[5] += w1.y * x8[5]; a8[6] += w1.z * x8[6]; a8[7] += w1.w * x8[7];
    }
  }
#pragma unroll
  for (int e = 0; e < 8; ++e) { const float v = a8[e]; a8[e] = scale * v * __builtin_amdgcn_rcpf(1.f + __expf(-v)); }
}

DI void mlstmA_item(const Params& p, char* lds, int item) {
  char* ws = p.ws;
  const int bh = item >> 7, c = item & 127, b = bh >> 2, hd = bh & 3;
  const int tid = otid(), lane = tid & 63, wave = tid >> 6, hh = lane >> 5, l31 = lane & 31;
  u16* KTs = (u16*)lds;
  u16* VTs = KTs + 128 * 72;
  float* win = (float*)(VTs + 128 * 72);
  const u16* PM = (const u16*)(ws + OFF_PM); const u16* VTm = (const u16*)(ws + OFF_VTM);
  const float* G = (const float*)(ws + OFF_G);
  u16* KVS = (u16*)(ws + OFF_KVS) + (size_t)item * 16384; float* KSUM = (float*)(ws + OFF_KSUM) + (size_t)item * 128; float* CSC = (float*)(ws + OFF_CSC) + (size_t)item * 4;
  if (wave == 0) {
    const size_t row = (size_t)b * SEQ + c * 64 + lane;
    const float ig = G[row * 8 + hd] + p.in[7][hd], fg = G[row * 8 + 4 + hd] + p.in[8][hd];
    const float bc = scan_sum(log_sigmoid(fg), lane);
    const float as = ig - bc;
    const float gmax = wmax(as);
    const float B = __shfl(bc, 63);
    win[lane] = expf(as - gmax);
    if (lane == 0) { CSC[0] = B; CSC[1] = B + gmax; }
  }
  for (int i = 0; i < 2; ++i) {
    const int q = tid + 512 * i, e = q >> 3, s8 = (q & 7) * 8;
    *(uint4*)(VTs + e * 72 + s8) = *(const uint4*)(VTm + ((size_t)(bh * 128 + e)) * SEQ + c * 64 + s8);
  }
  __syncthreads();
#pragma unroll 1
  for (int i = 0; i < 2; ++i) {
    const int cgk = tid & 15, t = (tid >> 4) + 32 * i;
    float a8[8];
    conv_unit(PM, p.in[5], p.in[6], b, c * 64 + t, 512 + hd * 128 + cgk * 8, 0.08838834764831845f, a8);
    const float w = win[t];
#pragma unroll
    for (int e = 0; e < 8; ++e) KTs[(cgk * 8 + e) * 72 + t] = f2bf(a8[e] * w);
  }
  __syncthreads();
  {
    const int dt = wave >> 1;
#pragma unroll
    for (int x = 0; x < 2; ++x) {
      const int e2 = (wave & 1) * 2 + x;
      f32x16 acc = zero16();
#pragma unroll
      for (int ks = 0; ks < 4; ++ks) acc = MFMA(ldfrag(KTs + (dt * 32 + l31) * 72 + ks * 16 + 8 * hh), ldfrag(VTs + (e2 * 32 + l31) * 72 + ks * 16 + 8 * hh), acc);
#pragma unroll
      for (int g = 0; g < 4; ++g) *(uint2*)(KVS + (e2 * 32 + l31) * 128 + dt * 32 + 8 * g + 4 * hh) = pack4(acc, g);
    }
    if (tid < 128) {
      float sacc = 0.f;
      for (int s8 = 0; s8 < 8; ++s8) { const uint4 raw = *(const uint4*)(KTs + tid * 72 + s8 * 8); float x8[8]; unpack8(raw, x8); for (int e = 0; e < 8; ++e) sacc += x8[e]; }
      KSUM[tid] = sacc;
    }
  }
  __syncthreads();
}

DI void phase_mlstm_scan(const Params& p) {
  char* ws = p.ws;
  const int tid = otid();
  for (int unit = blockIdx.x; unit < 256; unit += gridDim.x) {
    const int bh = unit >> 3, part = unit & 7;
    u16* kv = (u16*)(ws + OFF_KVS) + (size_t)bh * 128 * 16384 + part * 2048 + tid * 4;
    float* ks = (float*)(ws + OFF_KSUM) + (size_t)bh * 128 * 128 + tid;
    float* csc = (float*)(ws + OFF_CSC) + (size_t)bh * 128 * 4;
    const bool don = (part == 0) && (tid < 128);
    float m = 0.f, c0 = 0.f, c1 = 0.f, c2 = 0.f, c3 = 0.f, n = 0.f;
#pragma unroll 1
    for (int cb = 0; cb < 128; cb += 8) {
      uint2 raw[8]; float kr[8];
#pragma unroll
      for (int j = 0; j < 8; ++j) { raw[j] = *(const uint2*)(kv + (size_t)(cb + j) * 16384); kr[j] = don ? ks[(cb + j) * 128] : 0.f; }
#pragma unroll
      for (int j = 0; j < 8; ++j) {
        const float B = csc[(cb + j) * 4], A = csc[(cb + j) * 4 + 1];
        const float mnew = fmaxf(B + m, A);
        const float wp = __expf(B + m - mnew), wl = __expf(A - mnew);
        m = mnew;
        c0 = wp * c0 + wl * bflo(raw[j].x); c1 = wp * c1 + wl * bfhi(raw[j].x); c2 = wp * c2 + wl * bflo(raw[j].y); c3 = wp * c3 + wl * bfhi(raw[j].y);
        uint2 o; o.x = pack2(c0, c1); o.y = pack2(c2, c3);
        *(uint2*)(kv + (size_t)(cb + j) * 16384) = o;
        if (don) { n = wp * n + wl * kr[j]; ks[(cb + j) * 128] = n; }
        if (part == 0 && tid == 0) csc[(cb + j) * 4 + 2] = mnew;
      }
    }
  }
}

DI void mlstmC_pair(const Params& p, char* lds_all, int pair) {
  char* ws = p.ws;
  const int tid = otid(), hb = tid >> 8, ltid = tid & 255, lane = tid & 63, lwave = ltid >> 6, hh = lane >> 5, l31 = lane & 31;
  const int item = pair * 2 + hb;
  const int bh = item >> 7, c = item & 127, b = bh >> 2, hd = bh & 3;
  char* lds = lds_all + hb * 69632;
  u16* Qs = (u16*)lds;
  u16* Ks = Qs + 64 * 136;
  u16* VTs = Ks + 64 * 136;
  u16* Ps = VTs + 128 * 72;
  float* fs = (float*)(Ps + 64 * 72);
  float* a_s = fs; float* c_t = fs + 64; float* wint = fs + 128; float* emt = fs + 192; float* qnp = fs + 256; float* qks = fs + 512; float* red = fs + 640;
  const u16* PM = (const u16*)(ws + OFF_PM); const u16* VTm = (const u16*)(ws + OFF_VTM); const u16* PO = (const u16*)(ws + OFF_PO);
  const float* G = (const float*)(ws + OFF_G); u16* MIX = (u16*)(ws + OFF_MIX);
  const u16* CT = (const u16*)(ws + OFF_KVS) + (size_t)(item - 1) * 16384;
  const float* NP = (const float*)(ws + OFF_KSUM) + (size_t)(item - 1) * 128;
  const float* ng = p.in[9] + hd * 128;
  const float mprev = (c > 0) ? ((const float*)(ws + OFF_CSC))[(size_t)(item - 1) * 4 + 2] : 0.f;
#pragma unroll 1
  for (int i = 0; i < 8; ++i) {
    const int cg8 = ltid & 31, isK = cg8 >> 4, chl = (cg8 & 15) * 8, t = (ltid >> 5) + 8 * i;
    float a8[8];
    conv_unit(PM, p.in[5], p.in[6], b, c * 64 + t, (isK ? 512 : 0) + hd * 128 + chl, isK ? 0.08838834764831845f : 1.f, a8);
    uint4 o; o.x = pack2(a8[0], a8[1]); o.y = pack2(a8[2], a8[3]); o.z = pack2(a8[4], a8[5]); o.w = pack2(a8[6], a8[7]);
    *(uint4*)((isK ? Ks : Qs) + t * 136 + chl) = o;
  }
  for (int i = 0; i < 4; ++i) {
    const int q = ltid + 256 * i, e = q >> 3, s8 = (q & 7) * 8;
    *(uint4*)(VTs + e * 72 + s8) = *(const uint4*)(VTm + ((size_t)(bh * 128 + e)) * SEQ + c * 64 + s8);
  }
  if (lwave == 0) {
    const size_t row = (size_t)b * SEQ + c * 64 + lane;
    const float ig = G[row * 8 + hd] + p.in[7][hd], fg = G[row * 8 + 4 + hd] + p.in[8][hd];
    const float bc = scan_sum(log_sigmoid(fg), lane);
    const float as = ig - bc;
    const float gm = scan_max(as, lane);
    const float mt = bc + fmaxf(mprev, gm);
    a_s[lane] = as; c_t[lane] = bc - mt; wint[lane] = expf(bc + mprev - mt); emt[lane] = expf(-mt);
  }
  __syncthreads();
  {
    const int t = ltid & 63, part = ltid >> 6;
    float acc = 0.f;
    if (c > 0) for (int dd = 0; dd < 32; ++dd) acc += bf2f(Qs[t * 136 + part * 32 + dd]) * NP[part * 32 + dd];
    qnp[part * 64 + t] = acc;
  }
  {
    const int si = lwave >> 1, ti = lwave & 1;
    f32x16 S = zero16();
#pragma unroll
    for (int kk = 0; kk < 8; ++kk) S = MFMA(ldfrag(Ks + (si * 32 + l31) * 136 + kk * 16 + 8 * hh), ldfrag(Qs + (ti * 32 + l31) * 136 + kk * 16 + 8 * hh), S);
    const int t = ti * 32 + l31;
    const float ct = c_t[t];
    float rs = 0.f;
#pragma unroll
    for (int g = 0; g < 4; ++g) {
      float v4[4];
#pragma unroll
      for (int q = 0; q < 4; ++q) {
        const int sidx2 = si * 32 + 8 * g + 4 * hh + q;
        const float dv = (sidx2 <= t) ? S[4 * g + q] * __expf(ct + a_s[sidx2]) : 0.f;
        v4[q] = dv; rs += dv;
      }
      uint2 o; o.x = pack2(v4[0], v4[1]); o.y = pack2(v4[2], v4[3]);
      *(uint2*)(Ps + t * 72 + si * 32 + 8 * g + 4 * hh) = o;
    }
    rs += __shfl_xor(rs, 32);
    if (hh == 0) qks[si * 64 + t] = rs;
  }
  __syncthreads();
  const int et = lwave;
  f32x16 Hn[2];
#pragma unroll
  for (int tt = 0; tt < 2; ++tt) {
    const int tq = tt * 32 + l31;
    Hn[tt] = zero16();
    if (c > 0) {
#pragma unroll
      for (int kk = 0; kk < 8; ++kk) Hn[tt] = MFMA(ldfrag(CT + (et * 32 + l31) * 128 + kk * 16 + 8 * hh), ldfrag(Qs + tq * 136 + kk * 16 + 8 * hh), Hn[tt]);
    }
    const float wi = wint[tq];
#pragma unroll
    for (int r = 0; r < 16; ++r) Hn[tt][r] *= wi;
#pragma unroll
    for (int ks = 0; ks < 4; ++ks) Hn[tt] = MFMA(ldfrag(VTs + (et * 32 + l31) * 72 + ks * 16 + 8 * hh), ldfrag(Ps + tq * 72 + ks * 16 + 8 * hh), Hn[tt]);
    const float qn = qnp[tq] + qnp[64 + tq] + qnp[128 + tq] + qnp[192 + tq];
    const float den = wi * qn + qks[tq] + qks[64 + tq];
    const float inv = __builtin_amdgcn_rcpf(fmaxf(fabsf(den), emt[tq]));
    float s1 = 0.f, s2 = 0.f;
#pragma unroll
    for (int r = 0; r < 16; ++r) { Hn[tt][r] *= inv; s1 += Hn[tt][r]; s2 += Hn[tt][r] * Hn[tt][r]; }
    s1 += __shfl_xor(s1, 32); s2 += __shfl_xor(s2, 32);
    if (hh == 0) { red[(et * 64 + tq) * 2] = s1; red[(et * 64 + tq) * 2 + 1] = s2; }
  }
  __syncthreads();
#pragma unroll
  for (int tt = 0; tt < 2; ++tt) {
    const int tq = tt * 32 + l31;
    float t1 = 0.f, t2 = 0.f;
    for (int e4 = 0; e4 < 4; ++e4) { t1 += red[(e4 * 64 + tq) * 2]; t2 += red[(e4 * 64 + tq) * 2 + 1]; }
    const float mu = t1 * (1.f / 128.f);
    const float var = fmaxf(t2 * (1.f / 128.f) - mu * mu, 0.f);
    const float rstd = rsqrtf(var + LN_EPS);
    const size_t row = (size_t)b * SEQ + c * 64 + tq;
#pragma unroll
    for (int g = 0; g < 4; ++g) {
      const int e0 = et * 32 + 8 * g + 4 * hh;
      const uint2 og = *(const uint2*)(PO + row * 512 + hd * 128 + e0);
      const float4 gg = *(const float4*)(ng + e0);
      const float o0 = __builtin_amdgcn_rcpf(1.f + __expf(-bflo(og.x))), o1 = __builtin_amdgcn_rcpf(1.f + __expf(-bfhi(og.x))), o2 = __builtin_amdgcn_rcpf(1.f + __expf(-bflo(og.y))), o3 = __builtin_amdgcn_rcpf(1.f + __expf(-bfhi(og.y)));
      uint2 o;
      o.x = pack2(o0 * (Hn[tt][4 * g] - mu) * rstd * gg.x, o1 * (Hn[tt][4 * g + 1] - mu) * rstd * gg.y);
      o.y = pack2(o2 * (Hn[tt][4 * g + 2] - mu) * rstd * gg.z, o3 * (Hn[tt][4 * g + 3] - mu) * rstd * gg.w);
      *(uint2*)(MIX + row * 1024 + 512 + hd * 128 + e0) = o;
    }
  }
  __syncthreads();
}

DI void phase_mixA(const Params& p, char* lds) {
  for (int it = blockIdx.x; it < 4096; it += gridDim.x) mlstmA_item(p, lds, it);
  if ((gridDim.x & 7) == 0 && gridDim.x <= 256) {
    const int x = blockIdx.x & 7, slot = blockIdx.x >> 3, nx = gridDim.x >> 3;
    for (int j = slot; j < 256; j += nx) attn_item(p, lds, x * 256 + j);
  } else {
    for (int it = blockIdx.x; it < 2048; it += gridDim.x) attn_item(p, lds, it);
  }
}
DI void phase_mixC(const Params& p, char* lds) {
  for (int it = blockIdx.x; it < 2048; it += gridDim.x) mlstmC_pair(p, lds, it);
}

DI void phase_xattn(const Params& p, char* lds) {
  char* ws = p.ws;
  const int tid = otid(), lane = tid & 63, wave = tid >> 6, l31 = lane & 31, hh = lane >> 5;
  const u16* XQ = (const u16*)(ws + OFF_XQ); const u16* KX = (const u16*)(ws + OFF_KX); const u16* VTX = (const u16*)(ws + OFF_VTX);
  u16* XO = (u16*)(ws + OFF_XO);
  u16* Kl = (u16*)lds; u16* Vl = Kl + 2 * 32 * 264;
  const int pi = perm23(l31);
  const int kr0 = tid >> 5, kc = (tid & 31) * 8, vr = tid >> 2, vc = (tid & 3) * 8;
  for (int item = blockIdx.x; item < 1024; item += gridDim.x) {
    const int b = item >> 7, h = (item >> 5) & 3, qblk = item & 31;
    const size_t q0 = (size_t)b * SEQ + qblk * 256 + wave * 32;
    bf16x8 Qf[16];
#pragma unroll
    for (int kk = 0; kk < 16; ++kk) Qf[kk] = ldfrag(XQ + (q0 + l31) * 1024 + h * 256 + kk * 16 + 8 * hh);
    const u16* kg = KX + ((size_t)b * 256) * 1024 + h * 256;
    const u16* vg = VTX + ((size_t)((b * 4 + h) * 256)) * 256;
    {
      const uint4 k0 = *(const uint4*)(kg + (size_t)kr0 * 1024 + kc), k1 = *(const uint4*)(kg + (size_t)(kr0 + 16) * 1024 + kc);
      const uint4 v0 = *(const uint4*)(vg + (size_t)vr * 256 + vc);
      *(uint4*)(Kl + kr0 * 264 + kc) = k0; *(uint4*)(Kl + (kr0 + 16) * 264 + kc) = k1; *(uint4*)(Vl + vr * 40 + vc) = v0;
    }
    __syncthreads();
    f32x16 O[4]; for (int i = 0; i < 4; ++i) O[i] = zero16();
    float mrun = -INFINITY, lrun = 0.f;
#pragma unroll 1
    for (int st = 0; st < 16; ++st) {
      const int dh = st >> 3, kt = st & 7, cur = st & 1;
      uint4 nk0, nk1, nv0;
      if (st < 15) {
        const int ndh = (st + 1) >> 3, nkt = (st + 1) & 7;
        nk0 = *(const uint4*)(kg + (size_t)(nkt * 32 + kr0) * 1024 + kc); nk1 = *(const uint4*)(kg + (size_t)(nkt * 32 + kr0 + 16) * 1024 + kc);
        nv0 = *(const uint4*)(vg + (size_t)(ndh * 128 + vr) * 256 + nkt * 32 + vc);
      }
      const u16* kl = Kl + cur * 32 * 264 + pi * 264 + 8 * hh;
      const u16* vl = Vl + cur * 128 * 40 + l31 * 40 + 8 * hh;
      f32x16 S = zero16();
#pragma unroll
      for (int kk = 0; kk < 16; ++kk) S = MFMA(ldfrag(kl + kk * 16), Qf[kk], S);
      float mx = -INFINITY;
#pragma unroll
      for (int r = 0; r < 16; ++r) { S[r] *= 0.09016844005556021f; mx = fmaxf(mx, S[r]); }
      mx = fmaxf(mx, __shfl_xor(mx, 32));
      const float mnew = fmaxf(mrun, mx), alpha = __builtin_amdgcn_exp2f(mrun - mnew);
      mrun = mnew;
      float ps = 0.f;
#pragma unroll
      for (int r = 0; r < 16; ++r) { const float e = __builtin_amdgcn_exp2f(S[r] - mnew); S[r] = e; ps += e; }
      lrun = lrun * alpha + ps;
      bf16x8 Pf[2];
#pragma unroll
      for (int ks = 0; ks < 2; ++ks) {
        union { bf16x8 v; unsigned u[4]; } cv;
        for (int j2 = 0; j2 < 4; ++j2) cv.u[j2] = pack2(S[8 * ks + 2 * j2], S[8 * ks + 2 * j2 + 1]);
        Pf[ks] = cv.v;
      }
#pragma unroll
      for (int dt = 0; dt < 4; ++dt) {
#pragma unroll
        for (int r = 0; r < 16; ++r) O[dt][r] *= alpha;
#pragma unroll
        for (int ks = 0; ks < 2; ++ks) O[dt] = MFMA(ldfrag(vl + dt * 32 * 40 + 16 * ks), Pf[ks], O[dt]);
      }
      if (kt == 7) {
        const float inv = __builtin_amdgcn_rcpf(lrun + __shfl_xor(lrun, 32));
#pragma unroll
        for (int dt = 0; dt < 4; ++dt) {
#pragma unroll
          for (int g = 0; g < 4; ++g) {
            uint2 o; o.x = pack2(O[dt][4 * g] * inv, O[dt][4 * g + 1] * inv); o.y = pack2(O[dt][4 * g + 2] * inv, O[dt][4 * g + 3] * inv);
            *(uint2*)(XO + (q0 + l31) * 1024 + h * 256 + dh * 128 + dt * 32 + 8 * g + 4 * hh) = o;
          }
          O[dt] = zero16();
        }
        mrun = -INFINITY; lrun = 0.f;
      }
      if (st < 15) {
        const int nx = cur ^ 1;
        *(uint4*)(Kl + nx * 32 * 264 + kr0 * 264 + kc) = nk0; *(uint4*)(Kl + nx * 32 * 264 + (kr0 + 16) * 264 + kc) = nk1; *(uint4*)(Vl + nx * 128 * 40 + vr * 40 + vc) = nv0;
      }
      __syncthreads();
    }
  }
}

DI void phase_peer_query(const Params& p, char* lds) {
  char* ws = p.ws;
  const int tid = otid(), lane = tid & 63, wave = tid >> 6, wm = wave >> 1, wn = wave & 1, l31 = lane & 31, hh = lane >> 5;
  const u16* SK = (const u16*)(ws + OFF_SK);
  float* TOPV = (float*)(ws + OFF_TOPV);
  u16* Ct = (u16*)lds;
  float* Sc = (float*)lds;
  float* Ll = (float*)lds;
  for (int it = 0;; ++it) {
    int mt, hq; if (!tile_of(it, 256, 8, mt, hq)) break;
    const int m0 = mt * 256, n0 = hq * 256;
    {
      f32x4 acc[2][2][4][2];
      const u16* Aq = (const u16*)(ws + OFF_H) + (size_t)m0 * 1024; const u16* Bq = (const u16*)(ws + OFF_WPQ) + (size_t)n0 * 1024;
      gemm8p<1>(Aq, Bq, acc, lds);
      stage8<1>(acc, Ct);
    }
    __syncthreads();
    f32x16 sacc[2][2][2];
#pragma unroll
    for (int pp = 0; pp < 2; ++pp) {
#pragma unroll
      for (int i = 0; i < 2; ++i) for (int j = 0; j < 2; ++j) sacc[pp][i][j] = zero16();
#pragma unroll
      for (int kk = 0; kk < 8; ++kk) {
        const bf16x8 a0 = ldfrag(Ct + (wm * 64 + l31) * CT_LD + pp * 128 + kk * 16 + 8 * hh), a1 = ldfrag(Ct + (wm * 64 + 32 + l31) * CT_LD + pp * 128 + kk * 16 + 8 * hh);
        const bf16x8 b0 = ldfrag(SK + (size_t)(pp * 128 + wn * 64 + l31) * 128 + kk * 16 + 8 * hh), b1 = ldfrag(SK + (size_t)(pp * 128 + wn * 64 + 32 + l31) * 128 + kk * 16 + 8 * hh);
        sacc[pp][0][0] = MFMA(a0, b0, sacc[pp][0][0]); sacc[pp][0][1] = MFMA(a0, b1, sacc[pp][0][1]);
        sacc[pp][1][0] = MFMA(a1, b0, sacc[pp][1][0]); sacc[pp][1][1] = MFMA(a1, b1, sacc[pp][1][1]);
      }
    }
    __syncthreads();
#pragma unroll
    for (int pp = 0; pp < 2; ++pp) {
      const int hp = hq * 2 + pp;
#pragma unroll
      for (int i = 0; i < 2; ++i)
#pragma unroll
        for (int j = 0; j < 2; ++j)
#pragma unroll
          for (int r = 0; r < 16; ++r)
            Sc[(wm * 64 + i * 32 + (r & 3) + 8 * (r >> 2) + 4 * hh) * 132 + wn * 64 + j * 32 + l31] = sacc[pp][i][j][r];
      __syncthreads();
      {
        const int row = tid >> 1, half = tid & 1;
        const float* srow = Sc + row * 132 + half * 64;
        float v[16];
        {
          float kq[4][16];
#pragma unroll
          for (int gq = 0; gq < 4; ++gq) {
#pragma unroll
            for (int e4 = 0; e4 < 4; ++e4) {
              const float4 s4 = *(const float4*)(srow + 16 * gq + 4 * e4);
              const float sv[4] = {s4.x, s4.y, s4.z, s4.w};
#pragma unroll
              for (int u = 0; u < 4; ++u)
                kq[gq][4 * e4 + u] = __uint_as_float((__float_as_uint(sv[u]) & 0xFFFFFF80u) | (unsigned)(127 - (half * 64 + 16 * gq + 4 * e4 + u)));
            }
#pragma unroll
            for (int kk2 = 2; kk2 <= 16; kk2 <<= 1)
#pragma unroll
              for (int j = kk2 >> 1; j > 0; j >>= 1)
#pragma unroll
                for (int i = 0; i < 16; ++i) {
                  const int l = i ^ j;
                  if (l > i) {
                    const float hi = fmaxf(kq[gq][i], kq[gq][l]), lo = fminf(kq[gq][i], kq[gq][l]);
                    const bool desc = (i & kk2) == 0;
                    kq[gq][i] = desc ? hi : lo; kq[gq][l] = desc ? lo : hi;
                  }
                }
          }
#pragma unroll
          for (int pr = 0; pr < 2; ++pr) {
#pragma unroll
            for (int i = 0; i < 16; ++i) kq[2 * pr][i] = fmaxf(kq[2 * pr][i], kq[2 * pr + 1][15 - i]);
#pragma unroll
            for (int d = 8; d >= 1; d >>= 1)
#pragma unroll
              for (int i = 0; i < 16; ++i)
                if ((i & d) == 0) { const float hi = fmaxf(kq[2 * pr][i], kq[2 * pr][i + d]), lo = fminf(kq[2 * pr][i], kq[2 * pr][i + d]); kq[2 * pr][i] = hi; kq[2 * pr][i + d] = lo; }
          }
#pragma unroll
          for (int i = 0; i < 16; ++i) v[i] = fmaxf(kq[0][i], kq[2][15 - i]);
#pragma unroll
          for (int d = 8; d >= 1; d >>= 1)
#pragma unroll
            for (int i = 0; i < 16; ++i)
              if ((i & d) == 0) { const float hi = fmaxf(v[i], v[i + d]), lo = fminf(v[i], v[i + d]); v[i] = hi; v[i + d] = lo; }
        }
        float c[16];
#pragma unroll
        for (int i = 0; i < 16; ++i) c[i] = __shfl_xor(v[15 - i], 1);
#pragma unroll
        for (int i = 0; i < 16; ++i) c[i] = fmaxf(c[i], v[i]);
#pragma unroll
        for (int d = 8; d >= 1; d >>= 1)
#pragma unroll
          for (int i = 0; i < 16; ++i)
            if ((i & d) == 0) { const float hi = fmaxf(c[i], c[i + d]), lo = fminf(c[i], c[i + d]); c[i] = hi; c[i + d] = lo; }
        if (half == 0) {
          float* tv = TOPV + (size_t)(m0 + row) * 256 + hp * 16;
#pragma unroll
          for (int i = 0; i < 4; ++i) *(float4*)(tv + 4 * i) = make_float4(c[4 * i], c[4 * i + 1], c[4 * i + 2], c[4 * i + 3]);
        }
      }
      __syncthreads();
    }
  }
}

template <int C> struct CandFlat { static constexpr int calc() { int i = 0, rem = C; while (rem >= 16 / (i + 1)) { rem -= 16 / (i + 1); ++i; } return i * 16 + rem; } static constexpr int value = calc(); };
template <int C> DI void rank_step(const unsigned key, const int, int& rank) {
  const unsigned o = (unsigned)__builtin_amdgcn_readlane((int)key, C);
  rank += (o > key) ? 1 : 0;
}
template <int C0> DI void rank_steps10(const unsigned val, const int flat, int& rank) {
  rank_step<C0>(val, flat, rank); rank_step<C0 + 1>(val, flat, rank); rank_step<C0 + 2>(val, flat, rank); rank_step<C0 + 3>(val, flat, rank); rank_step<C0 + 4>(val, flat, rank);
  rank_step<C0 + 5>(val, flat, rank); rank_step<C0 + 6>(val, flat, rank); rank_step<C0 + 7>(val, flat, rank); rank_step<C0 + 8>(val, flat, rank); rank_step<C0 + 9>(val, flat, rank);
}
DI float dot16q(const uint4& q, const f32x2* x) {
  f32x2 a = __builtin_amdgcn_cvt_pk_f32_fp8((int)q.x, false) * x[0];
  a = __builtin_amdgcn_cvt_pk_f32_fp8((int)q.x, true) * x[1] + a;
  a = __builtin_amdgcn_cvt_pk_f32_fp8((int)q.y, false) * x[2] + a;
  a = __builtin_amdgcn_cvt_pk_f32_fp8((int)q.y, true) * x[3] + a;
  a = __builtin_amdgcn_cvt_pk_f32_fp8((int)q.z, false) * x[4] + a;
  a = __builtin_amdgcn_cvt_pk_f32_fp8((int)q.z, true) * x[5] + a;
  a = __builtin_amdgcn_cvt_pk_f32_fp8((int)q.w, false) * x[6] + a;
  a = __builtin_amdgcn_cvt_pk_f32_fp8((int)q.w, true) * x[7] + a;
  return a.x + a.y;
}
DI void axpy16q(float c, const uint4& q, f32x2* o) {
  const f32x2 c2 = {c, c};
  o[0] = __builtin_amdgcn_cvt_pk_f32_fp8((int)q.x, false) * c2 + o[0];
  o[1] = __builtin_amdgcn_cvt_pk_f32_fp8((int)q.x, true) * c2 + o[1];
  o[2] = __builtin_amdgcn_cvt_pk_f32_fp8((int)q.y, false) * c2 + o[2];
  o[3] = __builtin_amdgcn_cvt_pk_f32_fp8((int)q.y, true) * c2 + o[3];
  o[4] = __builtin_amdgcn_cvt_pk_f32_fp8((int)q.z, false) * c2 + o[4];
  o[5] = __builtin_amdgcn_cvt_pk_f32_fp8((int)q.z, true) * c2 + o[5];
  o[6] = __builtin_amdgcn_cvt_pk_f32_fp8((int)q.w, false) * c2 + o[6];
  o[7] = __builtin_amdgcn_cvt_pk_f32_fp8((int)q.w, true) * c2 + o[7];
}
struct __attribute__((packed, aligned(8))) U4a8 { unsigned a, b, c, d; };
DI v6u load6(const unsigned char* p) { const U4a8 a = *(const U4a8*)p; const uint2 c = *(const uint2*)(p + 16); v6u q; q[0] = a.a; q[1] = a.b; q[2] = a.c; q[3] = a.d; q[4] = c.x; q[5] = c.y; return q; }
DI void phase_peer_out(const Params& p, char* lds) {
  char* ws = p.ws;
  const int tid = otid(), lane = tid & 63, wave = tid >> 6, hb = lane >> 5, l5 = lane & 31;
  int* sidx = (int*)lds + wave * 384; float* sw = (float*)(sidx + 128);
  const u16* H = (const u16*)(ws + OFF_H); const unsigned* TV = (const unsigned*)(ws + OFF_TOPV);
  const unsigned char* U6 = (const unsigned char*)(ws + OFF_U8) + 24 * l5; const unsigned char* V6 = (const unsigned char*)(ws + OFF_V8) + 24 * l5;
  const float* USC = (const float*)(ws + OFF_USC); const float* VSC = (const float*)(ws + OFF_VSC);
  const float* g3 = p.in[23]; const float* b3 = p.in[24];
  int ci = 0, cj = 0; const bool cval = lane < 50;
  if (cval) { int rem = lane, i = 0; while (true) { const int cnt = 16 / (i + 1); if (rem < cnt) break; rem -= cnt; ++i; } ci = i; cj = rem; }
  const int flat = ci * 16 + cj;
  for (int t = blockIdx.x * 8 + wave; t < T_TOK; t += gridDim.x * 8) {
    f32x2 x2[16];
#pragma unroll
    for (int i = 0; i < 4; ++i) {
      const uint4 hv = *(const uint4*)(H + (size_t)t * 1024 + 32 * l5 + 8 * i);
      x2[4 * i] = f32x2{bflo(hv.x), bfhi(hv.x)}; x2[4 * i + 1] = f32x2{bflo(hv.y), bfhi(hv.y)}; x2[4 * i + 2] = f32x2{bflo(hv.z), bfhi(hv.z)}; x2[4 * i + 3] = f32x2{bflo(hv.w), bfhi(hv.w)};
    }
    float hval[8]; int hidx[8];
#pragma unroll
    for (int hq = 0; hq < 8; ++hq) {
      const unsigned ka = TV[(size_t)t * 256 + (2 * hq) * 16 + ci], kb = TV[(size_t)t * 256 + (2 * hq + 1) * 16 + cj];
      const float va = __uint_as_float(ka & 0xFFFFFF80u), vb = __uint_as_float(kb & 0xFFFFFF80u);
      const int ia = 127 - (int)(ka & 127u), ib = 127 - (int)(kb & 127u);
      hval[hq] = cval ? va + vb : -INFINITY; hidx[hq] = ia * 128 + ib;
    }
#pragma unroll
    for (int hq = 0; hq < 8; ++hq) {
      const float val = hval[hq];
      const unsigned vb32 = __float_as_uint(val);
      const unsigned ukey = cval ? (((vb32 ^ ((vb32 >> 31) ? 0xFFFFFFFFu : 0x80000000u)) & 0xFFFFFF00u) | (unsigned)(255 - flat)) : 0u;
      int rank = 0;
      rank_steps10<0>(ukey, flat, rank); rank_steps10<10>(ukey, flat, rank); rank_steps10<20>(ukey, flat, rank); rank_steps10<30>(ukey, flat, rank); rank_steps10<40>(ukey, flat, rank);
      if (cval && rank < 16) { sidx[hq * 16 + rank] = hidx[hq]; sw[hq * 16 + rank] = val; }
    }
    int el[2]; float gl[2];
#pragma unroll
    for (int grp = 0; grp < 2; ++grp) {
      el[grp] = sidx[grp * 64 + lane];
      const float sc = sw[grp * 64 + lane];
      float mx = sc; for (int o = 8; o; o >>= 1) mx = fmaxf(mx, __shfl_xor(mx, o));
      const float e = __expf(sc - mx);
      float sm = e; for (int o = 8; o; o >>= 1) sm += __shfl_xor(sm, o);
      gl[grp] = e * __builtin_amdgcn_rcpf(sm);
    }
#pragma unroll
    for (int hf = 0; hf < 2; ++hf) {
      float pd[32];
#pragma unroll
      for (int kb = 0; kb < 4; ++kb) {
        v6u qb[8];
#pragma unroll
        for (int k = 0; k < 8; ++k) {
          const int e0 = __builtin_amdgcn_readlane(el[0], hf * 32 + kb * 8 + k), e1 = __builtin_amdgcn_readlane(el[1], hf * 32 + kb * 8 + k);
          qb[k] = load6(U6 + (size_t)(hb ? e1 : e0) * 768);
        }
#pragma unroll
        for (int k = 0; k < 8; ++k) {
          const v32f f = __builtin_amdgcn_cvt_scalef32_pk32_f32_fp6(qb[k], 1.0f);
          f32x2 a = f32x2{f[0], f[1]} * x2[0];
#pragma unroll
          for (int i = 1; i < 16; ++i) a = f32x2{f[2 * i], f[2 * i + 1]} * x2[i] + a;
          pd[kb * 8 + k] = a.x + a.y;
        }
      }
#pragma unroll
      for (int off = 16; off >= 1; off >>= 1) {
        const bool up = (lane & off) != 0;
#pragma unroll
        for (int i = 0; i < off; ++i) {
          const float send = up ? pd[i] : pd[i + off];
          const float keep = up ? pd[i + off] : pd[i];
          pd[i] = keep + __shfl_xor(send, off);
        }
      }
      sw[hb * 64 + hf * 32 + l5] = pd[0];
    }
    float coefv[2];
#pragma unroll
    for (int grp = 0; grp < 2; ++grp) {
      const float dt = sw[grp * 64 + lane] * USC[el[grp]];
      const float ge = 0.5f * dt * (1.f + erff(dt * 0.7071067811865476f));
      coefv[grp] = gl[grp] * ge * VSC[el[grp]];
    }
    f32x2 o2[16];
#pragma unroll
    for (int i = 0; i < 16; ++i) o2[i] = f32x2{0.f, 0.f};
#pragma unroll
    for (int kb = 0; kb < 8; ++kb) {
      v6u qb[8];
#pragma unroll
      for (int k = 0; k < 8; ++k) {
        const int e0 = __builtin_amdgcn_readlane(el[0], kb * 8 + k), e1 = __builtin_amdgcn_readlane(el[1], kb * 8 + k);
        qb[k] = load6(V6 + (size_t)(hb ? e1 : e0) * 768);
      }
#pragma unroll
      for (int k = 0; k < 8; ++k) {
        const float c0 = __uint_as_float(__builtin_amdgcn_readlane(__float_as_uint(coefv[0]), kb * 8 + k)), c1 = __uint_as_float(__builtin_amdgcn_readlane(__float_as_uint(coefv[1]), kb * 8 + k));
        const float cf = hb ? c1 : c0;
        const f32x2 c2 = {cf, cf};
        const v32f f = __builtin_amdgcn_cvt_scalef32_pk32_f32_fp6(qb[k], 1.0f);
#pragma unroll
        for (int i = 0; i < 16; ++i) o2[i] = f32x2{f[2 * i], f[2 * i + 1]} * c2 + o2[i];
      }
    }
    float s = 0.f;
#pragma unroll
    for (int i = 0; i < 16; ++i) {
      o2[i].x += __shfl_xor(o2[i].x, 32); o2[i].y += __shfl_xor(o2[i].y, 32);
      o2[i] = x2[i] * f32x2{ALPHA, ALPHA} + o2[i]; s += o2[i].x + o2[i].y;
    }
    for (int o = 16; o; o >>= 1) s += __shfl_xor(s, o);
    const float mu = s * (1.f / 1024.f);
    float q = 0.f;
#pragma unroll
    for (int i = 0; i < 16; ++i) { const float a = o2[i].x - mu, bq = o2[i].y - mu; q += a * a + bq * bq; }
    for (int o = 16; o; o >>= 1) q += __shfl_xor(q, o);
    const float rstd = rsqrtf(q * (1.f / 1024.f) + LN_EPS);
    float* orow = p.out + (size_t)t * 1024 + 32 * l5 + 16 * hb;
#pragma unroll
    for (int q4 = 0; q4 < 4; ++q4) {
      const float4 gg = *(const float4*)(g3 + 32 * l5 + 16 * hb + 4 * q4), bb = *(const float4*)(b3 + 32 * l5 + 16 * hb + 4 * q4);
      const f32x2 a0 = hb ? o2[8 + 2 * q4] : o2[2 * q4], a1 = hb ? o2[8 + 2 * q4 + 1] : o2[2 * q4 + 1];
      float4 o;
      o.x = (a0.x - mu) * rstd * gg.x + bb.x; o.y = (a0.y - mu) * rstd * gg.y + bb.y;
      o.z = (a1.x - mu) * rstd * gg.z + bb.z; o.w = (a1.y - mu) * rstd * gg.w + bb.w;
      *(float4*)(orow + 4 * q4) = o;
    }
  }
}

#define XB_TMO      128
#define XB_XCNT(j)  (256  + 64 * (j))
#define XB_XSUB(j)  (1280 + 64 * (j))
#define XB_XGEN(j)  (2304 + 64 * (j))
#define XB_TOP      3328
#define XB_TOPGEN   3392
#define XCD_BAR_WORDS 3456
#define XB_SPIN_CAP (1u << 18)
#define LAS __attribute__((address_space(3)))
DI unsigned xb_ld(unsigned* p)              { return __hip_atomic_load(p, __ATOMIC_RELAXED, __HIP_MEMORY_SCOPE_AGENT); }
DI unsigned xb_add(unsigned* p, unsigned v) { return __hip_atomic_fetch_add(p, v, __ATOMIC_RELAXED, __HIP_MEMORY_SCOPE_AGENT); }
DI unsigned xb_xcc_id() { return (unsigned)__builtin_amdgcn_s_getreg((3 << 11) | 20) & 0xFu; }
#define XB_SPIN(cond, bar) do { unsigned _sp = 0; while (cond) { __builtin_amdgcn_s_sleep(1); \
    if ((++_sp & 255u) == 0u) { if (xb_ld(&(bar)[XB_TMO])) break; if (_sp > XB_SPIN_CAP) { atomicAdd(&(bar)[XB_TMO], 1u); break; } } } } while (0)
struct XcdBarrier { unsigned* bar; unsigned x; volatile LAS unsigned* st; };
DI XcdBarrier xcd_barrier_post(unsigned* bar, volatile LAS unsigned* st) {
  XcdBarrier b; b.bar = bar; b.x = xb_xcc_id(); b.st = st;
  if (threadIdx.x == 0) (void)xb_add(&bar[XB_XCNT(b.x)], 1u);
  return b;
}
DI void xcd_barrier_complete(unsigned* bar, unsigned x, unsigned& nloc, unsigned& nx) {
  const unsigned G = gridDim.x * gridDim.y * gridDim.z;
  unsigned sum, cnt, mine, sp = 0u;
  for (;;) {
    sum = 0u; cnt = 0u; mine = 0u;
#pragma unroll
    for (unsigned j = 0; j < 16; ++j) { const unsigned c = xb_ld(&bar[XB_XCNT(j)]); sum += c; cnt += (c > 0u) ? 1u : 0u; mine = (j == x) ? c : mine; }
    if (sum == G) break;
    __builtin_amdgcn_s_sleep(1);
    if ((++sp & 255u) == 0u) { if (xb_ld(&bar[XB_TMO])) break; if (sp > XB_SPIN_CAP) { atomicAdd(&bar[XB_TMO], 1u); break; } }
  }
  nloc = mine > 0u ? mine : 1u; nx = cnt > 0u ? cnt : 1u;
}
DI void xcd_barrier(const XcdBarrier& b) {
  asm volatile("s_waitcnt vmcnt(0)" ::: "memory");
  __syncthreads();
  if (threadIdx.x == 0) {
    unsigned* bar = b.bar;
    __builtin_amdgcn_s_waitcnt(0);
    unsigned nloc = b.st[0], nx = b.st[1];
    if (nloc == 0u) { xcd_barrier_complete(bar, b.x, nloc, nx); b.st[0] = nloc; b.st[1] = nx; }
    const unsigned old = xb_add(&bar[XB_XSUB(b.x)], 1u);
    const unsigned gen = old / nloc;
    if (old + 1u == (gen + 1u) * nloc) {
      __builtin_amdgcn_fence(__ATOMIC_RELEASE, "agent");
      asm volatile("s_waitcnt vmcnt(0)" ::: "memory");
      const unsigned og = xb_add(&bar[XB_TOP], 1u);
      const unsigned tg = og / nx;
      if (og + 1u == (tg + 1u) * nx) xb_add(&bar[XB_TOPGEN], 1u);
      else XB_SPIN(xb_ld(&bar[XB_TOPGEN]) == tg, bar);
      __builtin_amdgcn_fence(__ATOMIC_ACQUIRE, "agent");
      xb_add(&bar[XB_XGEN(b.x)], 1u);
      asm volatile("s_waitcnt vmcnt(0)" ::: "memory");
    } else {
      XB_SPIN(xb_ld(&bar[XB_XGEN(b.x)]) == gen, bar);
      __builtin_amdgcn_fence(__ATOMIC_ACQUIRE, "agent");
      asm volatile("s_waitcnt vmcnt(0)" ::: "memory");
    }
  }
  __syncthreads();
}

__global__ void __launch_bounds__(512) mega(Params p) {
  extern __shared__ __attribute__((aligned(16))) char lds[];
  cg::grid_group grid = cg::this_grid();
  char* ws = p.ws;
  u16* H = (u16*)(ws + OFF_H);
  u16* Zb = (u16*)(ws + OFF_Z);
  unsigned* barw = (unsigned*)(ws + OFF_BAR);
  volatile LAS unsigned* xst = (volatile LAS unsigned*)(LAS unsigned*)(lds + LDS_BYTES - 16);
  if (blockIdx.x == 0) for (int i = threadIdx.x; i < XCD_BAR_WORDS; i += 512) barw[i] = 0u;
  if (threadIdx.x == 0) { xst[0] = 0u; xst[1] = 0u; }
  for (int rep = 0; rep < 1 + ((PROBE_MASK >> 0) & 1); ++rep) {
    transpose_w(p.in[4], (u16*)(ws + OFF_WIN), 3592, 3584, (float*)lds);
    transpose_w(p.in[11], (u16*)(ws + OFF_WOUT), 1024, 1024, (float*)lds);
    transpose_w(p.in[14], (u16*)(ws + OFF_WQ), 1024, 1024, (float*)lds);
    transpose_w(p.in[15], (u16*)(ws + OFF_WKV), 2048, 2048, (float*)lds);
    transpose_w(p.in[16], (u16*)(ws + OFF_WO), 1024, 1024, (float*)lds);
    transpose_w(p.in[19], (u16*)(ws + OFF_WPQ), 2048, 2048, (float*)lds);
    convert_fp6_rows(p.in[21], (unsigned char*)(ws + OFF_U8), (float*)(ws + OFF_USC));
    convert_fp6_rows(p.in[22], (unsigned char*)(ws + OFF_V8), (float*)(ws + OFF_VSC));
    convert_bf16(p.in[20], (u16*)(ws + OFF_SK), (size_t)2 * 128 * 128 / 4);
    convert_bf16(p.in[1], (u16*)(ws + OFF_MEMB), (size_t)2048 * 1024 / 4);
    ln_in_rows(p.in[0], p.in[2], p.in[3], p.in[4], H, (float*)(ws + OFF_G), (float*)lds);
  }
  grid.sync();
  const XcdBarrier xb = xcd_barrier_post(barw, xst);
  if (PROBE_MASK & 0x10000) { for (int i = 0; i < 16; ++i) xcd_barrier(xb); }
  if ((PHASE_EN >> 1) & 1)
    { phase_inproj(p, lds); xcd_barrier(xb); }
  if ((PROBE_MASK >> 1) & 1) { phase_inproj(p, lds); xcd_barrier(xb); }
  if ((PHASE_EN >> 2) & 1)
    { phase_mixA(p, lds); xcd_barrier(xb); }
  if ((PROBE_MASK >> 2) & 1) { phase_mixA(p, lds); xcd_barrier(xb); }
  if ((PROBE_MASK >> 13) & 1) { for (int it = blockIdx.x; it < 4096; it += gridDim.x) mlstmA_item(p, lds, it); xcd_barrier(xb); }
  if ((PROBE_MASK >> 14) & 1) { for (int it = blockIdx.x; it < 2048; it += gridDim.x) attn_item(p, lds, it); xcd_barrier(xb); }
  if ((PHASE_EN >> 11) & 1)
    { phase_mlstm_scan(p); xcd_barrier(xb); }
  if ((PHASE_EN >> 12) & 1)
    { phase_mixC(p, lds); xcd_barrier(xb); }
  if ((PROBE_MASK >> 12) & 1) { phase_mixC(p, lds); xcd_barrier(xb); }
  if ((PHASE_EN >> 3) & 1)
    { phase_gemm1024<1>((const u16*)(ws + OFF_MIX), (const u16*)(ws + OFF_WOUT), Zb, H, lds); xcd_barrier(xb); }
  if ((PROBE_MASK >> 3) & 1) { phase_gemm1024<1>((const u16*)(ws + OFF_MIX), (const u16*)(ws + OFF_WOUT), Zb, H, lds); xcd_barrier(xb); }
  { ln_rows_b(Zb, p.in[12], p.in[13], H); xcd_barrier(xb); }
  if ((PROBE_MASK >> 4) & 1) { ln_rows_b(Zb, p.in[12], p.in[13], H); xcd_barrier(xb); }
  if ((PHASE_EN >> 5) & 1)
    { phase_gemm1024<0>(H, (const u16*)(ws + OFF_WQ), (u16*)(ws + OFF_XQ), nullptr, lds); xcd_barrier(xb); }
  if ((PROBE_MASK >> 5) & 1) { phase_gemm1024<0>(H, (const u16*)(ws + OFF_WQ), (u16*)(ws + OFF_XQ), nullptr, lds); xcd_barrier(xb); }
  if ((PHASE_EN >> 6) & 1)
    { phase_xattn(p, lds); xcd_barrier(xb); }
  if ((PROBE_MASK >> 6) & 1) { phase_xattn(p, lds); xcd_barrier(xb); }
  if ((PHASE_EN >> 7) & 1)
    { phase_gemm1024<1>((const u16*)(ws + OFF_XO), (const u16*)(ws + OFF_WO), Zb, H, lds); xcd_barrier(xb); }
  if ((PROBE_MASK >> 7) & 1) { phase_gemm1024<1>((const u16*)(ws + OFF_XO), (const u16*)(ws + OFF_WO), Zb, H, lds); xcd_barrier(xb); }
  { ln_rows_b(Zb, p.in[17], p.in[18], H); xcd_barrier(xb); }
  if ((PROBE_MASK >> 8) & 1) { ln_rows_b(Zb, p.in[17], p.in[18], H); xcd_barrier(xb); }
  if ((PHASE_EN >> 9) & 1)
    { phase_peer_query(p, lds); xcd_barrier(xb); }
  if ((PROBE_MASK >> 9) & 1) { phase_peer_query(p, lds); xcd_barrier(xb); }
  if ((PHASE_EN >> 10) & 1)
    { phase_peer_out(p, lds); }
  if ((PROBE_MASK >> 10) & 1) { phase_peer_out(p, lds); }
}

extern "C" void kernel_launch(void* const* d_in, const int* in_sizes, int n_in, void* d_out, int out_size, void* d_ws, size_t ws_size, hipStream_t stream) {
  static int grid_blocks = 0;
  if (grid_blocks == 0) {
    if (n_in != 25 || out_size != T_TOK * 1024 || ws_size < WS_NEED) { fprintf(stderr, "kernel_launch: unexpected shapes (n_in %d out %d ws %zu)\n", n_in, out_size, ws_size); grid_blocks = -1; return; }
    int dev = 0, cus = 0, per_cu = 0;
    hipGetDevice(&dev);
    hipDeviceGetAttribute(&cus, hipDeviceAttributeMultiprocessorCount, dev);
    if (hipFuncSetAttribute((const void*)mega, hipFuncAttributeMaxDynamicSharedMemorySize, LDS_BYTES) != hipSuccess) { fprintf(stderr, "hipFuncSetAttribute failed\n"); grid_blocks = -1; return; }
    hipOccupancyMaxActiveBlocksPerMultiprocessor(&per_cu, (const void*)mega, 512, LDS_BYTES);
    if (per_cu < 1) { fprintf(stderr, "occupancy query returned %d\n", per_cu); per_cu = 1; }
    grid_blocks = cus * per_cu;
  }
  if (grid_blocks < 0) return;
  Params p{};
  for (int i = 0; i < 25; ++i) p.in[i] = (const float*)d_in[i];
  p.out = (float*)d_out; p.ws = (char*)d_ws;
  void* args[] = {&p};
  hipError_t e = hipLaunchCooperativeKernel((const void*)mega, dim3(grid_blocks), dim3(512), args, LDS_BYTES, stream);
  if (e != hipSuccess) fprintf(stderr, "cooperative launch failed: %s (grid %d)\n", hipGetErrorString(e), grid_blocks);
}
```

```cpp
#include <hip/hip_runtime.h>
#include <hip/hip_cooperative_groups.h>
#include <cstdio>
namespace cg = cooperative_groups;

#ifndef PHASE_EN
#define PHASE_EN 0xFFFF
#endif
#ifndef PROBE_MASK
#define PROBE_MASK 0
#endif
#ifndef STAGE_MASK
#define STAGE_MASK 7
#endif

#define DI __device__ __forceinline__
typedef unsigned short u16;
typedef __attribute__((ext_vector_type(8))) short bf16x8;
typedef __attribute__((ext_vector_type(16))) float f32x16;
typedef __attribute__((ext_vector_type(2))) float f32x2;
#define MFMA(a, b, c) __builtin_amdgcn_mfma_f32_32x32x16_bf16((a), (b), (c), 0, 0, 0)

constexpr int T_TOK = 65536;
constexpr int SEQ = 8192;
constexpr float ALPHA = 1.189207115002721f;
constexpr float LN_EPS = 1e-5f;
constexpr int LDS_BYTES = 143360;
constexpr size_t MB = 1u << 20;
constexpr size_t OFF_WIN = 0, OFF_WOUT = 8 * MB, OFF_WQ = 10 * MB, OFF_WO = 12 * MB, OFF_WKV = 14 * MB, OFF_WPQ = 18 * MB,
                 OFF_SK = 22 * MB, OFF_MEMB = 23 * MB, OFF_KX = 27 * MB, OFF_VTX = 31 * MB, OFF_U8 = 35 * MB, OFF_V8 = 51 * MB, OFF_USC = 67 * MB, OFF_VSC = 68 * MB,
                 OFF_G = 99 * MB, OFF_H = 104 * MB, OFF_PA = 232 * MB, OFF_PM = 360 * MB, OFF_Z = 232 * MB, OFF_VTA = 488 * MB,
                 OFF_VTM = 552 * MB, OFF_XQ = 488 * MB, OFF_PO = 616 * MB, OFF_MIX = 680 * MB, OFF_XO = 680 * MB,
                 OFF_TOPV = 808 * MB, OFF_TOPI = 872 * MB, OFF_KVS = 808 * MB, OFF_KSUM = 936 * MB, OFF_CSC = 938 * MB, OFF_BAR = 939 * MB, WS_NEED = 940 * MB;

struct Params {
  const float* in[25];
  float* out;
  char* ws;
};

DI int otid() { int t = __builtin_amdgcn_workitem_id_x(); asm volatile("" : "+v"(t)); return t; }
typedef __bf16 bf16v2 __attribute__((ext_vector_type(2)));
DI unsigned pack2(float a, float b) { const f32x2 v = {a, b}; return __builtin_bit_cast(unsigned, __builtin_convertvector(v, bf16v2)); }
DI u16 f2bf(float x) { return (u16)(pack2(x, 0.f) & 0xffffu); }
DI float bf2f(u16 h) { return __uint_as_float(((unsigned)h) << 16); }
DI float bflo(unsigned w) { return __uint_as_float(w << 16); }
DI float bfhi(unsigned w) { return __uint_as_float(w & 0xffff0000u); }
DI float wsum(float v) { for (int o = 32; o; o >>= 1) v += __shfl_xor(v, o); return v; }
DI float wmax(float v) { for (int o = 32; o; o >>= 1) v = fmaxf(v, __shfl_xor(v, o)); return v; }
DI int perm23(int i) { return (i & 0x13) | (((i >> 3) & 1) << 2) | (((i >> 2) & 1) << 3); }
DI f32x16 zero16() { f32x16 z; for (int i = 0; i < 16; ++i) z[i] = 0.f; return z; }
DI bf16x8 ldfrag(const u16* p) { return *(const bf16x8*)p; }
DI void unpack8(const uint4& r, float* o) {
  o[0] = bflo(r.x); o[1] = bfhi(r.x); o[2] = bflo(r.y); o[3] = bfhi(r.y); o[4] = bflo(r.z); o[5] = bfhi(r.z); o[6] = bflo(r.w); o[7] = bfhi(r.w);
}

DI void transpose_w(const float* __restrict__ src, u16* __restrict__ dst, int N, int Npad, float* tl) {
  const int ntn = Npad >> 6, ntiles = 16 * ntn;
  for (int t = blockIdx.x; t < ntiles; t += gridDim.x) {
    const int kt = t / ntn, nt = t - kt * ntn, k0 = kt * 64, n0 = nt * 64;
    for (int e = otid(); e < 4096; e += 512) { int r = e >> 6, c = e & 63, n = n0 + c; tl[r * 65 + c] = (n < N) ? src[(size_t)(k0 + r) * N + n] : 0.f; }
    __syncthreads();
    for (int e = otid(); e < 4096; e += 512) { int r = e >> 6, c = e & 63; dst[(size_t)(n0 + r) * 1024 + k0 + c] = f2bf(tl[c * 65 + r]); }
    __syncthreads();
  }
}
DI void convert_bf16(const float* __restrict__ src, u16* __restrict__ dst, size_t n4) {
  const size_t stride = (size_t)gridDim.x * 512;
  for (size_t i = (size_t)blockIdx.x * 512 + otid(); i < n4; i += stride) {
    float4 v = ((const float4*)src)[i];
    uint2 o; o.x = pack2(v.x, v.y); o.y = pack2(v.z, v.w);
    ((uint2*)dst)[i] = o;
  }
}

DI void convert_fp8_rows(const float* __restrict__ src, unsigned char* __restrict__ dst, float* __restrict__ invscale) {
  const int lane = otid() & 63, wave = otid() >> 6;
  for (int row = blockIdx.x * 8 + wave; row < 16384; row += gridDim.x * 8) {
    const float* r = src + (size_t)row * 1024 + 16 * lane;
    float4 v[4];
    float am = 0.f;
    for (int i = 0; i < 4; ++i) { v[i] = *(const float4*)(r + 4 * i); am = fmaxf(am, fmaxf(fmaxf(fabsf(v[i].x), fabsf(v[i].y)), fmaxf(fabsf(v[i].z), fabsf(v[i].w)))); }
    am = wmax(am);
    const float sc = am > 0.f ? 256.f / am : 1.f;
    uint4 o; unsigned w[4];
    for (int i = 0; i < 4; ++i) { int t = 0; t = __builtin_amdgcn_cvt_pk_fp8_f32(v[i].x * sc, v[i].y * sc, t, false); t = __builtin_amdgcn_cvt_pk_fp8_f32(v[i].z * sc, v[i].w * sc, t, true); w[i] = (unsigned)t; }
    o.x = w[0]; o.y = w[1]; o.z = w[2]; o.w = w[3];
    *(uint4*)(dst + (size_t)row * 1024 + 16 * lane) = o;
    if (lane == 0) invscale[row] = am > 0.f ? am * (1.f / 256.f) : 1.f;
  }
}
typedef __attribute__((ext_vector_type(6))) unsigned v6u;
typedef __attribute__((ext_vector_type(16))) float v16f;
typedef __attribute__((ext_vector_type(32))) float v32f;
DI void convert_fp6_rows(const float* __restrict__ src, unsigned char* __restrict__ dst, float* __restrict__ invscale) {
  const int lane = otid() & 63, wave = otid() >> 6, hb = lane >> 5, l5 = lane & 31;
  for (int row = (blockIdx.x * 8 + wave) * 2 + hb; row < 16384; row += gridDim.x * 16) {
    const float* r = src + (size_t)row * 1024 + 32 * l5;
    v16f x, y;
    float am = 0.f;
#pragma unroll
    for (int i = 0; i < 4; ++i) {
      const float4 a = *(const float4*)(r + 4 * i), b = *(const float4*)(r + 16 + 4 * i);
      x[2 * i] = a.x; y[2 * i] = a.y; x[2 * i + 1] = a.z; y[2 * i + 1] = a.w; x[8 + 2 * i] = b.x; y[8 + 2 * i] = b.y; x[8 + 2 * i + 1] = b.z; y[8 + 2 * i + 1] = b.w;
      am = fmaxf(am, fmaxf(fmaxf(fabsf(a.x), fabsf(a.y)), fmaxf(fabsf(a.z), fabsf(a.w))));
      am = fmaxf(am, fmaxf(fmaxf(fabsf(b.x), fabsf(b.y)), fmaxf(fabsf(b.z), fabsf(b.w))));
    }
    for (int o = 16; o; o >>= 1) am = fmaxf(am, __shfl_xor(am, o));
    const float sc = am > 0.f ? 7.0f / am : 1.f;
#pragma unroll
    for (int i = 0; i < 16; ++i) { x[i] *= sc; y[i] *= sc; }
    const v6u q = __builtin_amdgcn_cvt_scalef32_2xpk16_fp6_f32(x, y, 1.0f);
    unsigned* d = (unsigned*)(dst + (size_t)row * 768 + 24 * l5);
    *(uint2*)d = make_uint2(q[0], q[1]); *(uint2*)(d + 2) = make_uint2(q[2], q[3]); *(uint2*)(d + 4) = make_uint2(q[4], q[5]);
    if (l5 == 0) invscale[row] = am > 0.f ? am * (1.f / 7.0f) : 1.f;
  }
}

DI void ln_rows(const float* __restrict__ src, const float* __restrict__ g, const float* __restrict__ bta, u16* __restrict__ dst) {
  const int lane = otid() & 63, wave = otid() >> 6;
  for (int row = blockIdx.x * 8 + wave; row < T_TOK; row += gridDim.x * 8) {
    float4 v[4];
    float s = 0.f;
    for (int i = 0; i < 4; ++i) { v[i] = *(const float4*)(src + (size_t)row * 1024 + i * 256 + lane * 4); s += v[i].x + v[i].y + v[i].z + v[i].w; }
    const float mu = wsum(s) * (1.f / 1024.f);
    float q = 0.f;
    for (int i = 0; i < 4; ++i) { float a = v[i].x - mu, b = v[i].y - mu, c = v[i].z - mu, d = v[i].w - mu; q += a * a + b * b + c * c + d * d; }
    const float rstd = rsqrtf(wsum(q) * (1.f / 1024.f) + LN_EPS);
    for (int i = 0; i < 4; ++i) {
      const int c0 = i * 256 + lane * 4;
      float4 gg = *(const float4*)(g + c0), bb = *(const float4*)(bta + c0);
      uint2 o;
      o.x = pack2((v[i].x - mu) * rstd * gg.x + bb.x, (v[i].y - mu) * rstd * gg.y + bb.y);
      o.y = pack2((v[i].z - mu) * rstd * gg.z + bb.z, (v[i].w - mu) * rstd * gg.w + bb.w);
      *(uint2*)(dst + (size_t)row * 1024 + c0) = o;
    }
  }
}
DI void ln_rows_b(const u16* __restrict__ Zb, const float* __restrict__ g, const float* __restrict__ bta, u16* __restrict__ H) {
  const int lane = otid() & 63, wave = otid() >> 6;
  float gg[16], bb[16];
  for (int i = 0; i < 4; ++i) {
    const float4 g4 = *(const float4*)(g + lane * 16 + 4 * i), b4 = *(const float4*)(bta + lane * 16 + 4 * i);
    gg[4*i] = g4.x; gg[4*i+1] = g4.y; gg[4*i+2] = g4.z; gg[4*i+3] = g4.w; bb[4*i] = b4.x; bb[4*i+1] = b4.y; bb[4*i+2] = b4.z; bb[4*i+3] = b4.w;
  }
  const int stride = gridDim.x * 8;
  for (int row0 = blockIdx.x * 8 + wave; row0 < T_TOK; row0 += stride * 4) {
    uint4 r[4][2];
#pragma unroll
    for (int j = 0; j < 4; ++j) {
      const int row = row0 + j * stride;
      if (row < T_TOK) { r[j][0] = *(const uint4*)(Zb + (size_t)row * 1024 + lane * 16); r[j][1] = *(const uint4*)(Zb + (size_t)row * 1024 + lane * 16 + 8); }
    }
#pragma unroll
    for (int j = 0; j < 4; ++j) {
      const int row = row0 + j * stride;
      if (row < T_TOK) {
        float v[16];
        unpack8(r[j][0], v); unpack8(r[j][1], v + 8);
        float s = 0.f;
#pragma unroll
        for (int i = 0; i < 16; ++i) s += v[i];
        const float mu = wsum(s) * (1.f / 1024.f);
        float q = 0.f;
#pragma unroll
        for (int i = 0; i < 16; ++i) { float a = v[i] - mu; q += a * a; }
        const float rstd = rsqrtf(wsum(q) * (1.f / 1024.f) + LN_EPS);
        uint4 o0, o1;
        o0.x = pack2((v[0] - mu) * rstd * gg[0] + bb[0], (v[1] - mu) * rstd * gg[1] + bb[1]); o0.y = pack2((v[2] - mu) * rstd * gg[2] + bb[2], (v[3] - mu) * rstd * gg[3] + bb[3]);
        o0.z = pack2((v[4] - mu) * rstd * gg[4] + bb[4], (v[5] - mu) * rstd * gg[5] + bb[5]); o0.w = pack2((v[6] - mu) * rstd * gg[6] + bb[6], (v[7] - mu) * rstd * gg[7] + bb[7]);
        o1.x = pack2((v[8] - mu) * rstd * gg[8] + bb[8], (v[9] - mu) * rstd * gg[9] + bb[9]); o1.y = pack2((v[10] - mu) * rstd * gg[10] + bb[10], (v[11] - mu) * rstd * gg[11] + bb[11]);
        o1.z = pack2((v[12] - mu) * rstd * gg[12] + bb[12], (v[13] - mu) * rstd * gg[13] + bb[13]); o1.w = pack2((v[14] - mu) * rstd * gg[14] + bb[14], (v[15] - mu) * rstd * gg[15] + bb[15]);
        *(uint4*)(H + (size_t)row * 1024 + lane * 16) = o0;
        *(uint4*)(H + (size_t)row * 1024 + lane * 16 + 8) = o1;
      }
    }
  }
}
DI void ln_in_rows(const float* __restrict__ src, const float* __restrict__ g, const float* __restrict__ bta, const float* __restrict__ w_in, u16* __restrict__ dst, float* __restrict__ G, float* Wg) {
  const int lane = otid() & 63, wave = otid() >> 6;
  for (int e = otid(); e < 8192; e += 512) Wg[e] = w_in[(size_t)(e >> 3) * 3592 + 3584 + (e & 7)];
  __syncthreads();
  float4 nv[4];
  { const int row = blockIdx.x * 8 + wave; for (int i = 0; i < 4; ++i) nv[i] = *(const float4*)(src + (size_t)row * 1024 + i * 256 + lane * 4); }
  for (int row = blockIdx.x * 8 + wave; row < T_TOK; row += gridDim.x * 8) {
    float4 v[4];
    float s = 0.f;
    for (int i = 0; i < 4; ++i) { v[i] = nv[i]; s += v[i].x + v[i].y + v[i].z + v[i].w; }
    { const int nrow = row + gridDim.x * 8; if (nrow < T_TOK) for (int i = 0; i < 4; ++i) nv[i] = *(const float4*)(src + (size_t)nrow * 1024 + i * 256 + lane * 4); }
    const float mu = wsum(s) * (1.f / 1024.f);
    float q = 0.f;
    for (int i = 0; i < 4; ++i) { float a = v[i].x - mu, b = v[i].y - mu, c = v[i].z - mu, d = v[i].w - mu; q += a * a + b * b + c * c + d * d; }
    const float rstd = rsqrtf(wsum(q) * (1.f / 1024.f) + LN_EPS);
    float pg[8];
#pragma unroll
    for (int j = 0; j < 8; ++j) pg[j] = 0.f;
#pragma unroll
    for (int i = 0; i < 4; ++i) {
      const int c0 = i * 256 + lane * 4;
      float4 gg = *(const float4*)(g + c0), bb = *(const float4*)(bta + c0);
      float y[4];
      y[0] = (v[i].x - mu) * rstd * gg.x + bb.x; y[1] = (v[i].y - mu) * rstd * gg.y + bb.y; y[2] = (v[i].z - mu) * rstd * gg.z + bb.z; y[3] = (v[i].w - mu) * rstd * gg.w + bb.w;
      uint2 o; o.x = pack2(y[0], y[1]); o.y = pack2(y[2], y[3]);
      *(uint2*)(dst + (size_t)row * 1024 + c0) = o;
#pragma unroll
      for (int e = 0; e < 4; ++e) {
        const float4 w0 = *(const float4*)(Wg + (c0 + e) * 8), w1 = *(const float4*)(Wg + (c0 + e) * 8 + 4);
        pg[0] += y[e] * w0.x; pg[1] += y[e] * w0.y; pg[2] += y[e] * w0.z; pg[3] += y[e] * w0.w;
        pg[4] += y[e] * w1.x; pg[5] += y[e] * w1.y; pg[6] += y[e] * w1.z; pg[7] += y[e] * w1.w;
      }
    }
#pragma unroll
    for (int off = 32; off >= 8; off >>= 1) {
      const bool up = (lane & off) != 0;
      const int nkeep = off >> 3;
#pragma unroll
      for (int i = 0; i < 4; ++i) if (i < nkeep) {
        const float send = up ? pg[i] : pg[i + nkeep];
        const float keep = up ? pg[i + nkeep] : pg[i];
        pg[i] = keep + __shfl_xor(send, off);
      }
    }
    float tot = pg[0];
    tot += __shfl_xor(tot, 4); tot += __shfl_xor(tot, 2); tot += __shfl_xor(tot, 1);
    if ((lane & 7) == 0) G[(size_t)row * 8 + (lane >> 3)] = tot;
  }
}

typedef __attribute__((ext_vector_type(4))) float f32x4;
#define MFMA16(a, b, c) __builtin_amdgcn_mfma_f32_16x16x32_bf16((a), (b), (c), 0, 0, 0)
DI uint2 pack4(const f32x16& a, int g) { uint2 o; o.x = pack2(a[4 * g], a[4 * g + 1]); o.y = pack2(a[4 * g + 2], a[4 * g + 3]); return o; }
DI void stage_rc(int b, int& R, int& C) { const int st = b >> 10, sb = b & 1023, swz = sb ^ (((sb >> 9) & 1) << 5); R = (st >> 1) * 16 + (swz >> 6); C = (st & 1) * 32 + ((swz & 63) >> 1); }
constexpr int CT_LD = 264;
template <int SWAP>
DI void gemm256(const u16* __restrict__ Ab, const u16* __restrict__ Bb, const u16* __restrict__ nAb, const u16* __restrict__ nBb, bool first, bool has_next, f32x4 (&acc)[8][4], char* lds) {
  const int tid = otid(), wid = tid >> 6, lane = tid & 63, wr = wid >> 2, wc = wid & 3, fr = lane & 15, fq = lane >> 4;
  int goff[4];
#pragma unroll
  for (int i = 0; i < 4; ++i) { int R, C; stage_rc(wid * 1024 + i * 8192 + lane * 16, R, C); goff[i] = R * 1024 + C; }
#pragma unroll
  for (int m = 0; m < 8; ++m)
#pragma unroll
    for (int n = 0; n < 4; ++n) acc[m][n] = f32x4{0.f, 0.f, 0.f, 0.f};
  const int ob = fr * 64 + fq * 16, obs = ob ^ (((ob >> 9) & 1) << 5);
  const int aoff = wr * 16384 + obs, boff = 32768 + wc * 8192 + obs;
#define GLDS_STAGE(buf, pa, pb, kt) do { _Pragma("unroll") for (int i = 0; i < 4; ++i) { \
    __builtin_amdgcn_global_load_lds((const unsigned*)((pa) + goff[i] + (kt) * 64), (__attribute__((address_space(3))) unsigned*)(lds + (buf) * 65536 + wid * 1024 + i * 8192), 16, 0, 0); \
    __builtin_amdgcn_global_load_lds((const unsigned*)((pb) + goff[i] + (kt) * 64), (__attribute__((address_space(3))) unsigned*)(lds + (buf) * 65536 + 32768 + wid * 1024 + i * 8192), 16, 0, 0); } } while (0)
  if (first) {
    GLDS_STAGE(0, Ab, Bb, 0);
    asm volatile("s_waitcnt vmcnt(0)" ::: "memory");
    __syncthreads();
  }
#pragma unroll 1
  for (int t = 0; t < 16; ++t) {
    const int cur = t & 1;
    if (t < 15) GLDS_STAGE(cur ^ 1, Ab, Bb, t + 1);
    else if (has_next) GLDS_STAGE(0, nAb, nBb, 0);
    const char* sa = lds + cur * 65536 + aoff;
    const char* sb = lds + cur * 65536 + boff;
#pragma unroll
    for (int ks = 0; ks < 2; ++ks) {
      bf16x8 At[8], Bf[4];
#pragma unroll
      for (int m = 0; m < 8; ++m) At[m] = *(const bf16x8*)(sa + m * 2048 + ks * 1024);
#pragma unroll
      for (int n = 0; n < 4; ++n) Bf[n] = *(const bf16x8*)(sb + n * 2048 + ks * 1024);
#pragma unroll
      for (int m = 0; m < 8; ++m)
#pragma unroll
        for (int n = 0; n < 4; ++n) acc[m][n] = SWAP ? MFMA16(Bf[n], At[m], acc[m][n]) : MFMA16(At[m], Bf[n], acc[m][n]);
      __builtin_amdgcn_sched_group_barrier(0x100, 12, 0);
      __builtin_amdgcn_sched_group_barrier(0x008, 32, 0);
      __builtin_amdgcn_sched_barrier(0);
    }
    asm volatile("s_waitcnt vmcnt(0)" ::: "memory");
    __syncthreads();
  }
#undef GLDS_STAGE
}
DI void stage_acc(const f32x4 (&acc)[8][4], u16* Ct) {
  const int tid = otid(), wid = tid >> 6, lane = tid & 63, wr = wid >> 2, wc = wid & 3, fr = lane & 15, fq = lane >> 4;
#pragma unroll
  for (int m = 0; m < 8; ++m)
#pragma unroll
    for (int n = 0; n < 4; ++n) {
      uint2 o; o.x = pack2(acc[m][n][0], acc[m][n][1]); o.y = pack2(acc[m][n][2], acc[m][n][3]);
      *(uint2*)(Ct + (wr * 128 + m * 16 + fr) * CT_LD + wc * 64 + n * 16 + fq * 4) = o;
    }
}
template <int SWAP>
DI void store_acc(const f32x4 (&acc)[8][4], u16* __restrict__ dst, size_t ld) {
  const int tid = otid(), wid = tid >> 6, lane = tid & 63, wr = wid >> 2, wc = wid & 3, fr = lane & 15, fq = lane >> 4;
#pragma unroll
  for (int m = 0; m < 8; ++m)
#pragma unroll
    for (int n = 0; n < 4; ++n) {
      uint2 o; o.x = pack2(acc[m][n][0], acc[m][n][1]); o.y = pack2(acc[m][n][2], acc[m][n][3]);
      if (SWAP) *(uint2*)(dst + (size_t)(wr * 128 + m * 16 + fr) * ld + wc * 64 + n * 16 + fq * 4) = o;
      else *(uint2*)(dst + (size_t)(wc * 64 + n * 16 + fr) * ld + wr * 128 + m * 16 + fq * 4) = o;
    }
}
template <int SWAP, int MODE>
DI void epilogue_staged(const f32x4 (&acc)[8][4], char* lds, u16* __restrict__ dst, size_t ld, const u16* __restrict__ Hres) {
  const int tid = otid(), wid = tid >> 6, lane = tid & 63, wr = wid >> 2, wc = wid & 3, fr = lane & 15, fq = lane >> 4;
  u16* Ct = (u16*)(lds + 65536);
#pragma unroll
  for (int h = 0; h < 2; ++h) {
    if ((SWAP ? wr : (wc >> 1)) == h) {
#pragma unroll
      for (int m = 0; m < 8; ++m)
#pragma unroll
        for (int n = 0; n < 4; ++n) {
          uint2 o; o.x = pack2(acc[m][n][0], acc[m][n][1]); o.y = pack2(acc[m][n][2], acc[m][n][3]);
          if (SWAP) *(uint2*)(Ct + (m * 16 + fr) * CT_LD + wc * 64 + n * 16 + fq * 4) = o;
          else *(uint2*)(Ct + ((wc & 1) * 64 + n * 16 + fr) * CT_LD + wr * 128 + m * 16 + fq * 4) = o;
        }
    }
    __syncthreads();
#pragma unroll 4
    for (int i = 0; i < 8; ++i) {
      const int q = tid + 512 * i, r = q >> 5, c8 = (q & 31) * 8;
      uint4 v = *(const uint4*)(Ct + r * CT_LD + c8);
      const size_t o = (size_t)(h * 128 + r) * ld + c8;
      if (MODE == 1) {
        const uint4 hv = *(const uint4*)(Hres + o);
        float y[8], hx[8]; unpack8(v, y); unpack8(hv, hx);
        v.x = pack2(ALPHA * hx[0] + y[0], ALPHA * hx[1] + y[1]); v.y = pack2(ALPHA * hx[2] + y[2], ALPHA * hx[3] + y[3]);
        v.z = pack2(ALPHA * hx[4] + y[4], ALPHA * hx[5] + y[5]); v.w = pack2(ALPHA * hx[6] + y[6], ALPHA * hx[7] + y[7]);
      }
      *(uint4*)(dst + o) = v;
    }
    __syncthreads();
  }
}
DI int lds_byte8(int r, int c) { const int st = (r >> 4) * 2 + (c >> 5), ob = (r & 15) * 64 + (c & 31) * 2; return st * 1024 + (ob ^ (((ob >> 9) & 1) << 5)); }
template <int SWAP>
DI void gemm8p(const u16* __restrict__ Ab, const u16* __restrict__ Bb, f32x4 (&acc)[2][2][4][2], char* lds) {
  constexpr int K = 1024, BK = 64, HALF = 128, HTB = 128 * 64 * 2;
  const int tid = otid(), wid = tid >> 6, lane = tid & 63, wr = wid >> 2, wc = wid & 3, fr = lane & 15, fq = lane >> 4;
  int goff0;
  { int R, C; stage_rc(tid * 16, R, C); goff0 = R * K + C; }
#define SA8(b, h) (lds + ((b) * 2 + (h)) * HTB)
#define SB8(b, h) (lds + (4 + (b) * 2 + (h)) * HTB)
#define STAGE8(P, BASE, br, kt) do { _Pragma("unroll") for (int _i = 0; _i < 2; ++_i) \
    __builtin_amdgcn_global_load_lds((const unsigned*)((BASE) + (size_t)((br) + 64 * _i) * K + (kt) * BK + goff0), (__attribute__((address_space(3))) unsigned*)((P) + wid * 1024 + _i * 8192), 16, 0, 0); } while (0)
#define LDA8(dst, b, h) _Pragma("unroll") for (int m = 0; m < 4; ++m) _Pragma("unroll") for (int k = 0; k < 2; ++k) \
    dst[m][k] = *(const bf16x8*)(SA8(b, h) + lds_byte8(wr * 64 + m * 16 + fr, k * 32 + fq * 8))
#define LDB8(dst, b, h) _Pragma("unroll") for (int n = 0; n < 2; ++n) _Pragma("unroll") for (int k = 0; k < 2; ++k) \
    dst[n][k] = *(const bf16x8*)(SB8(b, h) + lds_byte8(wc * 32 + n * 16 + fr, k * 32 + fq * 8))
#define MMA8(ai, bj, At_, Bt_) do { __builtin_amdgcn_s_setprio(1); \
    _Pragma("unroll") for (int m = 0; m < 4; ++m) _Pragma("unroll") for (int n = 0; n < 2; ++n) _Pragma("unroll") for (int k = 0; k < 2; ++k) \
      acc[ai][bj][m][n] = SWAP ? MFMA16(Bt_[n][k], At_[m][k], acc[ai][bj][m][n]) : MFMA16(At_[m][k], Bt_[n][k], acc[ai][bj][m][n]); \
    __builtin_amdgcn_s_setprio(0); } while (0)
#define WAIT_V(n) asm volatile("s_waitcnt vmcnt(" #n ")" ::: "memory")
#define WAIT_L(n) asm volatile("s_waitcnt lgkmcnt(" #n ")" ::: "memory")
#define BAR8 __builtin_amdgcn_s_barrier()
#define SCHED8 __builtin_amdgcn_sched_barrier(0)
#pragma unroll
  for (int ai = 0; ai < 2; ++ai)
#pragma unroll
    for (int bj = 0; bj < 2; ++bj)
#pragma unroll
      for (int m = 0; m < 4; ++m)
#pragma unroll
        for (int n = 0; n < 2; ++n) acc[ai][bj][m][n] = f32x4{0.f, 0.f, 0.f, 0.f};
  bf16x8 At[4][2], B0[2][2], B1[2][2];
  constexpr int nt = K / BK;
  STAGE8(SB8(0, 0), Bb, 0, 0); STAGE8(SA8(0, 0), Ab, 0, 0);
  STAGE8(SB8(0, 1), Bb, HALF, 0); STAGE8(SA8(0, 1), Ab, HALF, 0);
  if (wr == 1) BAR8;
  WAIT_V(4); BAR8;
  STAGE8(SB8(1, 0), Bb, 0, 1); STAGE8(SA8(1, 0), Ab, 0, 1); STAGE8(SB8(1, 1), Bb, HALF, 1);
  WAIT_V(6); BAR8;
#pragma unroll 1
  for (int t = 0; t < nt - 2; t += 2) {
    LDB8(B0, 0, 0); SCHED8; LDA8(At, 0, 0); STAGE8(SA8(1, 1), Ab, HALF, t + 1);
    WAIT_L(8); BAR8; WAIT_L(0); MMA8(0, 0, At, B0); BAR8; SCHED8;
    LDB8(B1, 0, 1); STAGE8(SB8(0, 0), Bb, 0, t + 2);
    BAR8; WAIT_L(0); MMA8(0, 1, At, B1); BAR8;
    LDA8(At, 0, 1); STAGE8(SA8(0, 0), Ab, 0, t + 2);
    BAR8; WAIT_L(0); MMA8(1, 0, At, B0); BAR8; SCHED8;
    STAGE8(SB8(0, 1), Bb, HALF, t + 2);
    WAIT_V(6); BAR8; MMA8(1, 1, At, B1); BAR8;
    LDB8(B0, 1, 0); SCHED8; LDA8(At, 1, 0); STAGE8(SA8(0, 1), Ab, HALF, t + 2);
    WAIT_L(8); BAR8; WAIT_L(0); MMA8(0, 0, At, B0); BAR8; SCHED8;
    LDB8(B1, 1, 1); STAGE8(SB8(1, 0), Bb, 0, t + 3);
    BAR8; WAIT_L(0); MMA8(0, 1, At, B1); BAR8;
    LDA8(At, 1, 1); STAGE8(SA8(1, 0), Ab, 0, t + 3);
    BAR8; WAIT_L(0); MMA8(1, 0, At, B0); BAR8; SCHED8;
    STAGE8(SB8(1, 1), Bb, HALF, t + 3);
    WAIT_V(6); BAR8; MMA8(1, 1, At, B1); BAR8;
  }
  { LDB8(B0, 0, 0); LDA8(At, 0, 0); STAGE8(SA8(1, 1), Ab, HALF, nt - 1);
    BAR8; WAIT_L(0); MMA8(0, 0, At, B0); BAR8;
    LDB8(B1, 0, 1); BAR8; WAIT_L(0); MMA8(0, 1, At, B1); BAR8;
    LDA8(At, 0, 1); WAIT_V(4); BAR8; WAIT_L(0); MMA8(1, 0, At, B0); MMA8(1, 1, At, B1); BAR8; }
  { LDB8(B0, 1, 0); LDA8(At, 1, 0); WAIT_V(2); BAR8; WAIT_L(0); MMA8(0, 0, At, B0); BAR8;
    LDB8(B1, 1, 1); WAIT_V(0); BAR8; WAIT_L(0); MMA8(0, 1, At, B1); BAR8;
    LDA8(At, 1, 1); BAR8; WAIT_L(0); MMA8(1, 0, At, B0); MMA8(1, 1, At, B1); BAR8; }
  if (wr == 0) BAR8;
  __syncthreads();
#undef SA8
#undef SB8
#undef STAGE8
#undef LDA8
#undef LDB8
#undef MMA8
#undef WAIT_V
#undef WAIT_L
#undef BAR8
#undef SCHED8
}
template <int SWAP>
DI void stage8(const f32x4 (&acc)[2][2][4][2], u16* Ct) {
  const int tid = otid(), wid = tid >> 6, lane = tid & 63, wr = wid >> 2, wc = wid & 3, fr = lane & 15, fq = lane >> 4;
#pragma unroll
  for (int ai = 0; ai < 2; ++ai)
#pragma unroll
    for (int bj = 0; bj < 2; ++bj)
#pragma unroll
      for (int m = 0; m < 4; ++m)
#pragma unroll
        for (int n = 0; n < 2; ++n) {
          uint2 o; o.x = pack2(acc[ai][bj][m][n][0], acc[ai][bj][m][n][1]); o.y = pack2(acc[ai][bj][m][n][2], acc[ai][bj][m][n][3]);
          if (SWAP) *(uint2*)(Ct + (ai * 128 + wr * 64 + m * 16 + fr) * CT_LD + bj * 128 + wc * 32 + n * 16 + fq * 4) = o;
          else *(uint2*)(Ct + (bj * 128 + wc * 32 + n * 16 + fr) * CT_LD + ai * 128 + wr * 64 + m * 16 + fq * 4) = o;
        }
}
template <int SWAP, int MODE>
DI void epilogue8(const f32x4 (&acc)[2][2][4][2], char* lds, u16* __restrict__ dst, size_t ld, const u16* __restrict__ Hres) {
  const int tid = otid();
  u16* Ct = (u16*)lds;
  stage8<SWAP>(acc, Ct);
  __syncthreads();
#pragma unroll 4
  for (int i = 0; i < 16; ++i) {
    const int q = tid + 512 * i, r = q >> 5, c8 = (q & 31) * 8;
    uint4 v = *(const uint4*)(Ct + r * CT_LD + c8);
    const size_t o = (size_t)r * ld + c8;
    if (MODE == 1) {
      const uint4 hv = *(const uint4*)(Hres + o);
      float y[8], hx[8]; unpack8(v, y); unpack8(hv, hx);
      v.x = pack2(ALPHA * hx[0] + y[0], ALPHA * hx[1] + y[1]); v.y = pack2(ALPHA * hx[2] + y[2], ALPHA * hx[3] + y[3]);
      v.z = pack2(ALPHA * hx[4] + y[4], ALPHA * hx[5] + y[5]); v.w = pack2(ALPHA * hx[6] + y[6], ALPHA * hx[7] + y[7]);
    }
    *(uint4*)(dst + o) = v;
  }
  __syncthreads();
}

DI bool tile_of(int it, int MT, int NT, int& mt, int& nt) {
  const int nb = gridDim.x;
  if ((nb & 7) == 0 && (MT & 7) == 0) {
    const int x = blockIdx.x & 7, slot = blockIdx.x >> 3, nx = nb >> 3, j = slot + it * nx, per = (MT >> 3) * NT;
    if (j >= per) return false;
    if (NT == 14 && (MT >> 3) == 32) {
      const int r = j / 28, w = j - r * 28, nh = r >> 3, mg = r & 7;
      mt = x * 32 + mg * 4 + w / 7; nt = nh * 7 + w % 7; return true;
    }
    mt = x * (MT >> 3) + j / NT; nt = j % NT; return true;
  }
  const int j = blockIdx.x + it * nb;
  if (j >= MT * NT) return false;
  mt = j / NT; nt = j % NT; return true;
}

DI void phase_inproj(const Params& p, char* lds) {
  char* ws = p.ws;
  const u16* A = (const u16*)(ws + OFF_H); const u16* W = (const u16*)(ws + OFF_WIN);
  int mt, nt; bool have = tile_of(0, 256, 14, mt, nt);
  for (int it = 0; have; ++it) {
    const int m0 = mt * 256, n0 = nt * 256;
    int mtn, ntn; const bool hn = tile_of(it + 1, 256, 14, mtn, ntn);
    const u16* nA = A + (size_t)(hn ? mtn : 0) * 256 * 1024; const u16* nB = W + (size_t)(hn ? ntn : 0) * 256 * 1024;
    const bool tr = (n0 >= 1024 && n0 < 1536) || (n0 >= 2560 && n0 < 3072);
    f32x4 acc[2][2][4][2];
    if (tr) {
      gemm8p<0>(A + (size_t)m0 * 1024, W + (size_t)n0 * 1024, acc, lds);
      u16* dst = (n0 < 1536) ? (u16*)(ws + OFF_VTA) + ((size_t)((m0 >> 13) * 512 + (n0 - 1024))) * SEQ + (m0 & 8191)
                             : (u16*)(ws + OFF_VTM) + ((size_t)((m0 >> 13) * 512 + (n0 - 2560))) * SEQ + (m0 & 8191);
      epilogue8<0, 0>(acc, lds, dst, SEQ, nullptr);
    } else {
      gemm8p<1>(A + (size_t)m0 * 1024, W + (size_t)n0 * 1024, acc, lds);
      u16* dst; size_t ld;
      if (n0 < 1024) { dst = (u16*)(ws + OFF_PA) + (size_t)m0 * 1024 + n0; ld = 1024; }
      else if (n0 < 2560) { dst = (u16*)(ws + OFF_PM) + (size_t)m0 * 1024 + (n0 - 1536); ld = 1024; }
      else { dst = (u16*)(ws + OFF_PO) + (size_t)m0 * 512 + (n0 - 3072); ld = 512; }
      epilogue8<1, 0>(acc, lds, dst, ld, nullptr);
    }
    mt = mtn; nt = ntn; have = hn;
  }
  for (int it = 0;; ++it) {
    if (!tile_of(it, 8, 8, mt, nt)) break;
    const int m0 = mt * 256, n0 = nt * 256;
    const u16* Am = (const u16*)(ws + OFF_MEMB) + (size_t)m0 * 1024; const u16* Bm = (const u16*)(ws + OFF_WKV) + (size_t)n0 * 1024;
    f32x4 acc[2][2][4][2];
    if (n0 >= 1024) { gemm8p<0>(Am, Bm, acc, lds); epilogue8<0, 0>(acc, lds, (u16*)(ws + OFF_VTX) + ((size_t)((m0 >> 8) * 1024 + (n0 - 1024))) * 256, 256, nullptr); }
    else { gemm8p<1>(Am, Bm, acc, lds); epilogue8<1, 0>(acc, lds, (u16*)(ws + OFF_KX) + (size_t)m0 * 1024 + n0, 1024, nullptr); }
  }
}

template <int MODE>
DI void phase_gemm1024(const u16* __restrict__ A, const u16* __restrict__ Wt, u16* __restrict__ dstb, const u16* __restrict__ Hres, char* lds) {
  const int tid = otid(), wid = tid >> 6, lane = tid & 63, wr = wid >> 2, wc = wid & 3, fr = lane & 15, fq = lane >> 4;
  int mt, nt; bool have = tile_of(0, 256, 4, mt, nt);
  for (int it = 0; have; ++it) {
    const int m0 = mt * 256, n0 = nt * 256;
    int mtn, ntn; const bool hn = tile_of(it + 1, 256, 4, mtn, ntn);
    f32x4 acc[2][2][4][2];
    gemm8p<1>(A + (size_t)m0 * 1024, Wt + (size_t)n0 * 1024, acc, lds);
    epilogue8<1, MODE>(acc, lds, dstb + (size_t)m0 * 1024 + n0, 1024, (MODE == 1) ? Hres + (size_t)m0 * 1024 + n0 : nullptr);
    mt = mtn; nt = ntn; have = hn;
  }
}

DI void attn_item(const Params& p, char* lds, int item) {
  char* ws = p.ws;
  const int tid = otid(), lane = tid & 63, wave = tid >> 6, l31 = lane & 31, hh = lane >> 5;
  const int b = item >> 8, h = (item >> 5) & 7, c0 = (item & 31) * 4;
  const int qc = c0 + (wave >> 1), qt = wave & 1;
  const u16* PA = (const u16*)(ws + OFF_PA); const u16* VTa = (const u16*)(ws + OFF_VTA); u16* MIX = (u16*)(ws + OFF_MIX);
  u16* Kl = (u16*)lds;
  u16* Vl = Kl + 2 * 64 * 72;
  float* biasl = (float*)(Vl + 2 * 64 * 72);
  const int pi = perm23(l31);
  const int sr = tid >> 3, sc8 = (tid & 7) * 8;
  const u16* kg = PA + ((size_t)b * SEQ + sr) * 1024 + 512 + h * 64 + sc8;
  const u16* vg = VTa + ((size_t)((b * 8 + h) * 64 + sr)) * SEQ + sc8;
  for (int i = tid; i < 257; i += 512) biasl[i] = p.in[10][h * 257 + i] * 1.4426950408889634f;
  const size_t q0 = (size_t)b * SEQ + qc * 64 + qt * 32;
  bf16x8 Qf[4];
#pragma unroll
  for (int kk = 0; kk < 4; ++kk) Qf[kk] = ldfrag(PA + (q0 + l31) * 1024 + h * 64 + kk * 16 + 8 * hh);
  const int kcs = (c0 >= 8) ? c0 - 8 : 0, kce = c0 + 3;
  *(uint4*)(Kl + sr * 72 + sc8) = *(const uint4*)(kg + (size_t)(kcs * 64) * 1024);
  *(uint4*)(Vl + sr * 72 + sc8) = *(const uint4*)(vg + kcs * 64);
  __syncthreads();
  f32x16 O[2]; O[0] = zero16(); O[1] = zero16();
  float mrun = -INFINITY, lrun = 0.f;
#pragma unroll 1
  for (int kc = kcs; kc <= kce; ++kc) {
    const int cur = (kc - kcs) & 1;
    uint4 nk, nv;
    if (kc < kce) { nk = *(const uint4*)(kg + (size_t)((kc + 1) * 64) * 1024); nv = *(const uint4*)(vg + (kc + 1) * 64); }
    if (kc >= qc - 8 && kc <= qc) {
      f32x16 S[2];
      float mx = -INFINITY;
#pragma unroll
      for (int sub = 0; sub < 2; ++sub) {
        const u16* kl = Kl + cur * 64 * 72 + (sub * 32 + pi) * 72 + 8 * hh;
        S[sub] = zero16();
#pragma unroll
        for (int kk = 0; kk < 4; ++kk) S[sub] = MFMA(ldfrag(kl + kk * 16), Qf[kk], S[sub]);
        const int relbase = (kc * 64 + sub * 32 + 8 * hh) - (qc * 64 + qt * 32 + l31);
        if ((kc * 64 + sub * 32 + 31) - (qc * 64 + qt * 32) <= -128) {
          const float b0 = biasl[0];
#pragma unroll
          for (int r = 0; r < 16; ++r) { const float sv = S[sub][r] * 0.18033688011112042f + b0; S[sub][r] = sv; mx = fmaxf(mx, sv); }
        } else {
#pragma unroll
          for (int r = 0; r < 16; ++r) {
            int rel = relbase + 16 * (r >> 3) + (r & 7);
            rel = rel < -128 ? -128 : (rel > 128 ? 128 : rel);
            const float sv = S[sub][r] * 0.18033688011112042f + biasl[rel + 128];
            S[sub][r] = sv; mx = fmaxf(mx, sv);
          }
        }
      }
      mx = fmaxf(mx, __shfl_xor(mx, 32));
      const float mnew = fmaxf(mrun, mx);
      const float alpha = __builtin_amdgcn_exp2f(mrun - mnew);
      mrun = mnew;
      float ps = 0.f;
#pragma unroll
      for (int sub = 0; sub < 2; ++sub)
#pragma unroll
        for (int r = 0; r < 16; ++r) { const float e = __builtin_amdgcn_exp2f(S[sub][r] - mnew); S[sub][r] = e; ps += e; }
      lrun = lrun * alpha + ps;
#pragma unroll
      for (int r = 0; r < 16; ++r) { O[0][r] *= alpha; O[1][r] *= alpha; }
#pragma unroll
      for (int sub = 0; sub < 2; ++sub) {
        bf16x8 Pf[2];
#pragma unroll
        for (int ks = 0; ks < 2; ++ks) {
          union { bf16x8 v; unsigned u[4]; } cv;
          for (int j2 = 0; j2 < 4; ++j2) cv.u[j2] = pack2(S[sub][8 * ks + 2 * j2], S[sub][8 * ks + 2 * j2 + 1]);
          Pf[ks] = cv.v;
        }
        const u16* vl = Vl + cur * 64 * 72 + l31 * 72 + sub * 32 + 8 * hh;
#pragma unroll
        for (int dt = 0; dt < 2; ++dt)
#pragma unroll
          for (int ks = 0; ks < 2; ++ks) O[dt] = MFMA(ldfrag(vl + dt * 32 * 72 + 16 * ks), Pf[ks], O[dt]);
      }
    }
    if (kc < kce) { const int nx = cur ^ 1; *(uint4*)(Kl + nx * 64 * 72 + sr * 72 + sc8) = nk; *(uint4*)(Vl + nx * 64 * 72 + sr * 72 + sc8) = nv; }
    __syncthreads();
  }
  const float inv = __builtin_amdgcn_rcpf(lrun + __shfl_xor(lrun, 32));
#pragma unroll
  for (int dt = 0; dt < 2; ++dt)
#pragma unroll
    for (int g = 0; g < 4; ++g) {
      uint2 o; o.x = pack2(O[dt][4 * g] * inv, O[dt][4 * g + 1] * inv); o.y = pack2(O[dt][4 * g + 2] * inv, O[dt][4 * g + 3] * inv);
      *(uint2*)(MIX + (q0 + l31) * 1024 + h * 64 + dt * 32 + 8 * g + 4 * hh) = o;
    }
}

DI float log_sigmoid(float f) { return fminf(f, 0.f) - log1pf(expf(-fabsf(f))); }
DI float scan_sum(float v, int lane) { for (int o = 1; o < 64; o <<= 1) { float tv = __shfl_up(v, o); if (lane >= o) v += tv; } return v; }
DI float scan_max(float v, int lane) { for (int o = 1; o < 64; o <<= 1) { float tv = __shfl_up(v, o); if (lane >= o) v = fmaxf(v, tv); } return v; }

DI void conv_unit(const u16* __restrict__ PM, const float* __restrict__ conv_w, const float* __restrict__ conv_b, int b, int sl0, int ch, float scale, float* a8) {
  { const float4 b0 = *(const float4*)(conv_b + ch), b1 = *(const float4*)(conv_b + ch + 4); a8[0] = b0.x; a8[1] = b0.y; a8[2] = b0.z; a8[3] = b0.w; a8[4] = b1.x; a8[5] = b1.y; a8[6] = b1.z; a8[7] = b1.w; }
#pragma unroll
  for (int j = 0; j < 4; ++j) {
    const int sl = sl0 - 3 + j;
    if (sl >= 0) {
      const uint4 raw = *(const uint4*)(PM + ((size_t)b * SEQ + sl) * 1024 + ch);
      float x8[8]; unpack8(raw, x8);
      const float4 w0 = *(const float4*)(conv_w + j * 1024 + ch), w1 = *(const float4*)(conv_w + j * 1024 + ch + 4);
      a8[0] += w0.x * x8[0]; a8[1] += w0.y * x8[1]; a8[2] += w0.z * x8[2]; a8[3] += w0.w * x8[3];
      a8[4] += w1.x * x8[4]; a8[5] += w1.y * x8[5]; a8[6] += w1.z * x8[6]; a8[7] += w1.w * x8[7];
    }
  }
#pragma unroll
  for (int e = 0; e < 8; ++e) { const float v = a8[e]; a8[e] = scale * v * __builtin_amdgcn_rcpf(1.f + __expf(-v)); }
}

DI void mlstmA_item(const Params& p, char* lds, int item) {
  char* ws = p.ws;
  const int bh = item >> 7, c = item & 127, b = bh >> 2, hd = bh & 3;
  const int tid = otid(), lane = tid & 63, wave = tid >> 6, hh = lane >> 5, l31 = lane & 31;
  u16* KTs = (u16*)lds;
  u16* VTs = KTs + 128 * 72;
  float* win = (float*)(VTs + 128 * 72);
  const u16* PM = (const u16*)(ws + OFF_PM); const u16* VTm = (const u16*)(ws + OFF_VTM);
  const float* G = (const float*)(ws + OFF_G);
  u16* KVS = (u16*)(ws + OFF_KVS) + (size_t)item * 16384; float* KSUM = (float*)(ws + OFF_KSUM) + (size_t)item * 128; float* CSC = (float*)(ws + OFF_CSC) + (size_t)item * 4;
  if (wave == 0) {
    const size_t row = (size_t)b * SEQ + c * 64 + lane;
    const float ig = G[row * 8 + hd] + p.in[7][hd], fg = G[row * 8 + 4 + hd] + p.in[8][hd];
    const float bc = scan_sum(log_sigmoid(fg), lane);
    const float as = ig - bc;
    const float gmax = wmax(as);
    const float B = __shfl(bc, 63);
    win[lane] = expf(as - gmax);
    if (lane == 0) { CSC[0] = B; CSC[1] = B + gmax; }
  }
  for (int i = 0; i < 2; ++i) {
    const int q = tid + 512 * i, e = q >> 3, s8 = (q & 7) * 8;
    *(uint4*)(VTs + e * 72 + s8) = *(const uint4*)(VTm + ((size_t)(bh * 128 + e)) * SEQ + c * 64 + s8);
  }
  __syncthreads();
#pragma unroll 1
  for (int i = 0; i < 2; ++i) {
    const int cgk = tid & 15, t = (tid >> 4) + 32 * i;
    float a8[8];
    conv_unit(PM, p.in[5], p.in[6], b, c * 64 + t, 512 + hd * 128 + cgk * 8, 0.08838834764831845f, a8);
    const float w = win[t];
#pragma unroll
    for (int e = 0; e < 8; ++e) KTs[(cgk * 8 + e) * 72 + t] = f2bf(a8[e] * w);
  }
  __syncthreads();
  {
    const int dt = wave >> 1;
#pragma unroll
    for (int x = 0; x < 2; ++x) {
      const int e2 = (wave & 1) * 2 + x;
      f32x16 acc = zero16();
#pragma unroll
      for (int ks = 0; ks < 4; ++ks) acc = MFMA(ldfrag(KTs + (dt * 32 + l31) * 72 + ks * 16 + 8 * hh), ldfrag(VTs + (e2 * 32 + l31) * 72 + ks * 16 + 8 * hh), acc);
#pragma unroll
      for (int g = 0; g < 4; ++g) *(uint2*)(KVS + (e2 * 32 + l31) * 128 + dt * 32 + 8 * g + 4 * hh) = pack4(acc, g);
    }
    if (tid < 128) {
      float sacc = 0.f;
      for (int s8 = 0; s8 < 8; ++s8) { const uint4 raw = *(const uint4*)(KTs + tid * 72 + s8 * 8); float x8[8]; unpack8(raw, x8); for (int e = 0; e < 8; ++e) sacc += x8[e]; }
      KSUM[tid] = sacc;
    }
  }
  __syncthreads();
}

DI void phase_mlstm_scan(const Params& p) {
  char* ws = p.ws;
  const int tid = otid();
  for (int unit = blockIdx.x; unit < 256; unit += gridDim.x) {
    const int bh = unit >> 3, part = unit & 7;
    u16* kv = (u16*)(ws + OFF_KVS) + (size_t)bh * 128 * 16384 + part * 2048 + tid * 4;
    float* ks = (float*)(ws + OFF_KSUM) + (size_t)bh * 128 * 128 + tid;
    float* csc = (float*)(ws + OFF_CSC) + (size_t)bh * 128 * 4;
    const bool don = (part == 0) && (tid < 128);
    float m = 0.f, c0 = 0.f, c1 = 0.f, c2 = 0.f, c3 = 0.f, n = 0.f;
#pragma unroll 1
    for (int cb = 0; cb < 128; cb += 8) {
      uint2 raw[8]; float kr[8];
#pragma unroll
      for (int j = 0; j < 8; ++j) { raw[j] = *(const uint2*)(kv + (size_t)(cb + j) * 16384); kr[j] = don ? ks[(cb + j) * 128] : 0.f; }
#pragma unroll
      for (int j = 0; j < 8; ++j) {
        const float B = csc[(cb + j) * 4], A = csc[(cb + j) * 4 + 1];
        const float mnew = fmaxf(B + m, A);
        const float wp = __expf(B + m - mnew), wl = __expf(A - mnew);
        m = mnew;
        c0 = wp * c0 + wl * bflo(raw[j].x); c1 = wp * c1 + wl * bfhi(raw[j].x); c2 = wp * c2 + wl * bflo(raw[j].y); c3 = wp * c3 + wl * bfhi(raw[j].y);
        uint2 o; o.x = pack2(c0, c1); o.y = pack2(c2, c3);
        *(uint2*)(kv + (size_t)(cb + j) * 16384) = o;
        if (don) { n = wp * n + wl * kr[j]; ks[(cb + j) * 128] = n; }
        if (part == 0 && tid == 0) csc[(cb + j) * 4 + 2] = mnew;
      }
    }
  }
}

DI void mlstmC_pair(const Params& p, char* lds_all, int pair) {
  char* ws = p.ws;
  const int tid = otid(), hb = tid >> 8, ltid = tid & 255, lane = tid & 63, lwave = ltid >> 6, hh = lane >> 5, l31 = lane & 31;
  const int item = pair * 2 + hb;
  const int bh = item >> 7, c = item & 127, b = bh >> 2, hd = bh & 3;
  char* lds = lds_all + hb * 69632;
  u16* Qs = (u16*)lds;
  u16* Ks = Qs + 64 * 136;
  u16* VTs = Ks + 64 * 136;
  u16* Ps = VTs + 128 * 72;
  float* fs = (float*)(Ps + 64 * 72);
  float* a_s = fs; float* c_t = fs + 64; float* wint = fs + 128; float* emt = fs + 192; float* qnp = fs + 256; float* qks = fs + 512; float* red = fs + 640;
  const u16* PM = (const u16*)(ws + OFF_PM); const u16* VTm = (const u16*)(ws + OFF_VTM); const u16* PO = (const u16*)(ws + OFF_PO);
  const float* G = (const float*)(ws + OFF_G); u16* MIX = (u16*)(ws + OFF_MIX);
  const u16* CT = (const u16*)(ws + OFF_KVS) + (size_t)(item - 1) * 16384;
  const float* NP = (const float*)(ws + OFF_KSUM) + (size_t)(item - 1) * 128;
  const float* ng = p.in[9] + hd * 128;
  const float mprev = (c > 0) ? ((const float*)(ws + OFF_CSC))[(size_t)(item - 1) * 4 + 2] : 0.f;
#pragma unroll 1
  for (int i = 0; i < 8; ++i) {
    const int cg8 = ltid & 31, isK = cg8 >> 4, chl = (cg8 & 15) * 8, t = (ltid >> 5) + 8 * i;
    float a8[8];
    conv_unit(PM, p.in[5], p.in[6], b, c * 64 + t, (isK ? 512 : 0) + hd * 128 + chl, isK ? 0.08838834764831845f : 1.f, a8);
    uint4 o; o.x = pack2(a8[0], a8[1]); o.y = pack2(a8[2], a8[3]); o.z = pack2(a8[4], a8[5]); o.w = pack2(a8[6], a8[7]);
    *(uint4*)((isK ? Ks : Qs) + t * 136 + chl) = o;
  }
  for (int i = 0; i < 4; ++i) {
    const int q = ltid + 256 * i, e = q >> 3, s8 = (q & 7) * 8;
    *(uint4*)(VTs + e * 72 + s8) = *(const uint4*)(VTm + ((size_t)(bh * 128 + e)) * SEQ + c * 64 + s8);
  }
  if (lwave == 0) {
    const size_t row = (size_t)b * SEQ + c * 64 + lane;
    const float ig = G[row * 8 + hd] + p.in[7][hd], fg = G[row * 8 + 4 + hd] + p.in[8][hd];
    const float bc = scan_sum(log_sigmoid(fg), lane);
    const float as = ig - bc;
    const float gm = scan_max(as, lane);
    const float mt = bc + fmaxf(mprev, gm);
    a_s[lane] = as; c_t[lane] = bc - mt; wint[lane] = expf(bc + mprev - mt); emt[lane] = expf(-mt);
  }
  __syncthreads();
  {
    const int t = ltid & 63, part = ltid >> 6;
    float acc = 0.f;
    if (c > 0) for (int dd = 0; dd < 32; ++dd) acc += bf2f(Qs[t * 136 + part * 32 + dd]) * NP[part * 32 + dd];
    qnp[part * 64 + t] = acc;
  }
  {
    const int si = lwave >> 1, ti = lwave & 1;
    f32x16 S = zero16();
#pragma unroll
    for (int kk = 0; kk < 8; ++kk) S = MFMA(ldfrag(Ks + (si * 32 + l31) * 136 + kk * 16 + 8 * hh), ldfrag(Qs + (ti * 32 + l31) * 136 + kk * 16 + 8 * hh), S);
    const int t = ti * 32 + l31;
    const float ct = c_t[t];
    float rs = 0.f;
#pragma unroll
    for (int g = 0; g < 4; ++g) {
      float v4[4];
#pragma unroll
      for (int q = 0; q < 4; ++q) {
        const int sidx2 = si * 32 + 8 * g + 4 * hh + q;
        const float dv = (sidx2 <= t) ? S[4 * g + q] * __expf(ct + a_s[sidx2]) : 0.f;
        v4[q] = dv; rs += dv;
      }
      uint2 o; o.x = pack2(v4[0], v4[1]); o.y = pack2(v4[2], v4[3]);
      *(uint2*)(Ps + t * 72 + si * 32 + 8 * g + 4 * hh) = o;
    }
    rs += __shfl_xor(rs, 32);
    if (hh == 0) qks[si * 64 + t] = rs;
  }
  __syncthreads();
  const int et = lwave;
  f32x16 Hn[2];
#pragma unroll
  for (int tt = 0; tt < 2; ++tt) {
    const int tq = tt * 32 + l31;
    Hn[tt] = zero16();
    if (c > 0) {
#pragma unroll
      for (int kk = 0; kk < 8; ++kk) Hn[tt] = MFMA(ldfrag(CT + (et * 32 + l31) * 128 + kk * 16 + 8 * hh), ldfrag(Qs + tq * 136 + kk * 16 + 8 * hh), Hn[tt]);
    }
    const float wi = wint[tq];
#pragma unroll
    for (int r = 0; r < 16; ++r) Hn[tt][r] *= wi;
#pragma unroll
    for (int ks = 0; ks < 4; ++ks) Hn[tt] = MFMA(ldfrag(VTs + (et * 32 + l31) * 72 + ks * 16 + 8 * hh), ldfrag(Ps + tq * 72 + ks * 16 + 8 * hh), Hn[tt]);
    const float qn = qnp[tq] + qnp[64 + tq] + qnp[128 + tq] + qnp[192 + tq];
    const float den = wi * qn + qks[tq] + qks[64 + tq];
    const float inv = __builtin_amdgcn_rcpf(fmaxf(fabsf(den), emt[tq]));
    float s1 = 0.f, s2 = 0.f;
#pragma unroll
    for (int r = 0; r < 16; ++r) { Hn[tt][r] *= inv; s1 += Hn[tt][r]; s2 += Hn[tt][r] * Hn[tt][r]; }
    s1 += __shfl_xor(s1, 32); s2 += __shfl_xor(s2, 32);
    if (hh == 0) { red[(et * 64 + tq) * 2] = s1; red[(et * 64 + tq) * 2 + 1] = s2; }
  }
  __syncthreads();
#pragma unroll
  for (int tt = 0; tt < 2; ++tt) {
    const int tq = tt * 32 + l31;
    float t1 = 0.f, t2 = 0.f;
    for (int e4 = 0; e4 < 4; ++e4) { t1 += red[(e4 * 64 + tq) * 2]; t2 += red[(e4 * 64 + tq) * 2 + 1]; }
    const float mu = t1 * (1.f / 128.f);
    const float var = fmaxf(t2 * (1.f / 128.f) - mu * mu, 0.f);
    const float rstd = rsqrtf(var + LN_EPS);
    const size_t row = (size_t)b * SEQ + c * 64 + tq;
#pragma unroll
    for (int g = 0; g < 4; ++g) {
      const int e0 = et * 32 + 8 * g + 4 * hh;
      const uint2 og = *(const uint2*)(PO + row * 512 + hd * 128 + e0);
      const float4 gg = *(const float4*)(ng + e0);
      const float o0 = __builtin_amdgcn_rcpf(1.f + __expf(-bflo(og.x))), o1 = __builtin_amdgcn_rcpf(1.f + __expf(-bfhi(og.x))), o2 = __builtin_amdgcn_rcpf(1.f + __expf(-bflo(og.y))), o3 = __builtin_amdgcn_rcpf(1.f + __expf(-bfhi(og.y)));
      uint2 o;
      o.x = pack2(o0 * (Hn[tt][4 * g] - mu) * rstd * gg.x, o1 * (Hn[tt][4 * g + 1] - mu) * rstd * gg.y);
      o.y = pack2(o2 * (Hn[tt][4 * g + 2] - mu) * rstd * gg.z, o3 * (Hn[tt][4 * g + 3] - mu) * rstd * gg.w);
      *(uint2*)(MIX + row * 1024 + 512 + hd * 128 + e0) = o;
    }
  }
  __syncthreads();
}

DI void phase_mixA(const Params& p, char* lds) {
  for (int it = blockIdx.x; it < 4096; it += gridDim.x) mlstmA_item(p, lds, it);
  if ((gridDim.x & 7) == 0 && gridDim.x <= 256) {
    const int x = blockIdx.x & 7, slot = blockIdx.x >> 3, nx = gridDim.x >> 3;
    for (int j = slot; j < 256; j += nx) attn_item(p, lds, x * 256 + j);
  } else {
    for (int it = blockIdx.x; it < 2048; it += gridDim.x) attn_item(p, lds, it);
  }
}
DI void phase_mixC(const Params& p, char* lds) {
  for (int it = blockIdx.x; it < 2048; it += gridDim.x) mlstmC_pair(p, lds, it);
}

DI void phase_xattn(const Params& p, char* lds) {
  char* ws = p.ws;
  const int tid = otid(), lane = tid & 63, wave = tid >> 6, l31 = lane & 31, hh = lane >> 5;
  const u16* XQ = (const u16*)(ws + OFF_XQ); const u16* KX = (const u16*)(ws + OFF_KX); const u16* VTX = (const u16*)(ws + OFF_VTX);
  u16* XO = (u16*)(ws + OFF_XO);
  u16* Kl = (u16*)lds; u16* Vl = Kl + 2 * 32 * 264;
  const int pi = perm23(l31);
  const int kr0 = tid >> 5, kc = (tid & 31) * 8, vr = tid >> 2, vc = (tid & 3) * 8;
  for (int item = blockIdx.x; item < 1024; item += gridDim.x) {
    const int b = item >> 7, h = (item >> 5) & 3, qblk = item & 31;
    const size_t q0 = (size_t)b * SEQ + qblk * 256 + wave * 32;
    bf16x8 Qf[16];
#pragma unroll
    for (int kk = 0; kk < 16; ++kk) Qf[kk] = ldfrag(XQ + (q0 + l31) * 1024 + h * 256 + kk * 16 + 8 * hh);
    const u16* kg = KX + ((size_t)b * 256) * 1024 + h * 256;
    const u16* vg = VTX + ((size_t)((b * 4 + h) * 256)) * 256;
    {
      const uint4 k0 = *(const uint4*)(kg + (size_t)kr0 * 1024 + kc), k1 = *(const uint4*)(kg + (size_t)(kr0 + 16) * 1024 + kc);
      const uint4 v0 = *(const uint4*)(vg + (size_t)vr * 256 + vc);
      *(uint4*)(Kl + kr0 * 264 + kc) = k0; *(uint4*)(Kl + (kr0 + 16) * 264 + kc) = k1; *(uint4*)(Vl + vr * 40 + vc) = v0;
    }
    __syncthreads();
    f32x16 O[4]; for (int i = 0; i < 4; ++i) O[i] = zero16();
    float mrun = -INFINITY, lrun = 0.f;
#pragma unroll 1
    for (int st = 0; st < 16; ++st) {
      const int dh = st >> 3, kt = st & 7, cur = st & 1;
      uint4 nk0, nk1, nv0;
      if (st < 15) {
        const int ndh = (st + 1) >> 3, nkt = (st + 1) & 7;
        nk0 = *(const uint4*)(kg + (size_t)(nkt * 32 + kr0) * 1024 + kc); nk1 = *(const uint4*)(kg + (size_t)(nkt * 32 + kr0 + 16) * 1024 + kc);
        nv0 = *(const uint4*)(vg + (size_t)(ndh * 128 + vr) * 256 + nkt * 32 + vc);
      }
      const u16* kl = Kl + cur * 32 * 264 + pi * 264 + 8 * hh;
      const u16* vl = Vl + cur * 128 * 40 + l31 * 40 + 8 * hh;
      f32x16 S = zero16();
#pragma unroll
      for (int kk = 0; kk < 16; ++kk) S = MFMA(ldfrag(kl + kk * 16), Qf[kk], S);
      float mx = -INFINITY;
#pragma unroll
      for (int r = 0; r < 16; ++r) { S[r] *= 0.09016844005556021f; mx = fmaxf(mx, S[r]); }
      mx = fmaxf(mx, __shfl_xor(mx, 32));
      const float mnew = fmaxf(mrun, mx), alpha = __builtin_amdgcn_exp2f(mrun - mnew);
      mrun = mnew;
      float ps = 0.f;
#pragma unroll
      for (int r = 0; r < 16; ++r) { const float e = __builtin_amdgcn_exp2f(S[r] - mnew); S[r] = e; ps += e; }
      lrun = lrun * alpha + ps;
      bf16x8 Pf[2];
#pragma unroll
      for (int ks = 0; ks < 2; ++ks) {
        union { bf16x8 v; unsigned u[4]; } cv;
        for (int j2 = 0; j2 < 4; ++j2) cv.u[j2] = pack2(S[8 * ks + 2 * j2], S[8 * ks + 2 * j2 + 1]);
        Pf[ks] = cv.v;
      }
#pragma unroll
      for (int dt = 0; dt < 4; ++dt) {
#pragma unroll
        for (int r = 0; r < 16; ++r) O[dt][r] *= alpha;
#pragma unroll
        for (int ks = 0; ks < 2; ++ks) O[dt] = MFMA(ldfrag(vl + dt * 32 * 40 + 16 * ks), Pf[ks], O[dt]);
      }
      if (kt == 7) {
        const float inv = __builtin_amdgcn_rcpf(lrun + __shfl_xor(lrun, 32));
#pragma unroll
        for (int dt = 0; dt < 4; ++dt) {
#pragma unroll
          for (int g = 0; g < 4; ++g) {
            uint2 o; o.x = pack2(O[dt][4 * g] * inv, O[dt][4 * g + 1] * inv); o.y = pack2(O[dt][4 * g + 2] * inv, O[dt][4 * g + 3] * inv);
            *(uint2*)(XO + (q0 + l31) * 1024 + h * 256 + dh * 128 + dt * 32 + 8 * g + 4 * hh) = o;
          }
          O[dt] = zero16();
        }
        mrun = -INFINITY; lrun = 0.f;
      }
      if (st < 15) {
        const int nx = cur ^ 1;
        *(uint4*)(Kl + nx * 32 * 264 + kr0 * 264 + kc) = nk0; *(uint4*)(Kl + nx * 32 * 264 + (kr0 + 16) * 264 + kc) = nk1; *(uint4*)(Vl + nx * 128 * 40 + vr * 40 + vc) = nv0;
      }
      __syncthreads();
    }
  }
}

DI void phase_peer_query(const Params& p, char* lds) {
  char* ws = p.ws;
  const int tid = otid(), lane = tid & 63, wave = tid >> 6, wm = wave >> 1, wn = wave & 1, l31 = lane & 31, hh = lane >> 5;
  const u16* SK = (const u16*)(ws + OFF_SK);
  float* TOPV = (float*)(ws + OFF_TOPV);
  u16* Ct = (u16*)lds;
  float* Sc = (float*)lds;
  float* Ll = (float*)lds;
  for (int it = 0;; ++it) {
    int mt, hq; if (!tile_of(it, 256, 8, mt, hq)) break;
    const int m0 = mt * 256, n0 = hq * 256;
    {
      f32x4 acc[2][2][4][2];
      const u16* Aq = (const u16*)(ws + OFF_H) + (size_t)m0 * 1024; const u16* Bq = (const u16*)(ws + OFF_WPQ) + (size_t)n0 * 1024;
      gemm8p<1>(Aq, Bq, acc, lds);
      stage8<1>(acc, Ct);
    }
    __syncthreads();
    f32x16 sacc[2][2][2];
#pragma unroll
    for (int pp = 0; pp < 2; ++pp) {
#pragma unroll
      for (int i = 0; i < 2; ++i) for (int j = 0; j < 2; ++j) sacc[pp][i][j] = zero16();
#pragma unroll
      for (int kk = 0; kk < 8; ++kk) {
        const bf16x8 a0 = ldfrag(Ct + (wm * 64 + l31) * CT_LD + pp * 128 + kk * 16 + 8 * hh), a1 = ldfrag(Ct + (wm * 64 + 32 + l31) * CT_LD + pp * 128 + kk * 16 + 8 * hh);
        const bf16x8 b0 = ldfrag(SK + (size_t)(pp * 128 + wn * 64 + l31) * 128 + kk * 16 + 8 * hh), b1 = ldfrag(SK + (size_t)(pp * 128 + wn * 64 + 32 + l31) * 128 + kk * 16 + 8 * hh);
        sacc[pp][0][0] = MFMA(a0, b0, sacc[pp][0][0]); sacc[pp][0][1] = MFMA(a0, b1, sacc[pp][0][1]);
        sacc[pp][1][0] = MFMA(a1, b0, sacc[pp][1][0]); sacc[pp][1][1] = MFMA(a1, b1, sacc[pp][1][1]);
      }
    }
    __syncthreads();
#pragma unroll
    for (int pp = 0; pp < 2; ++pp) {
      const int hp = hq * 2 + pp;
#pragma unroll
      for (int i = 0; i < 2; ++i)
#pragma unroll
        for (int j = 0; j < 2; ++j)
#pragma unroll
          for (int r = 0; r < 16; ++r)
            Sc[(wm * 64 + i * 32 + (r & 3) + 8 * (r >> 2) + 4 * hh) * 132 + wn * 64 + j * 32 + l31] = sacc[pp][i][j][r];
      __syncthreads();
      {
        const int row = tid >> 1, half = tid & 1;
        const float* srow = Sc + row * 132 + half * 64;
        float v[16];
        {
          float kq[4][16];
#pragma unroll
          for (int gq = 0; gq < 4; ++gq) {
#pragma unroll
            for (int e4 = 0; e4 < 4; ++e4) {
              const float4 s4 = *(const float4*)(srow + 16 * gq + 4 * e4);
              const float sv[4] = {s4.x, s4.y, s4.z, s4.w};
#pragma unroll
              for (int u = 0; u < 4; ++u)
                kq[gq][4 * e4 + u] = __uint_as_float((__float_as_uint(sv[u]) & 0xFFFFFF80u) | (unsigned)(127 - (half * 64 + 16 * gq + 4 * e4 + u)));
            }
#pragma unroll
            for (int kk2 = 2; kk2 <= 16; kk2 <<= 1)
#pragma unroll
              for (int j = kk2 >> 1; j > 0; j >>= 1)
#pragma unroll
                for (int i = 0; i < 16; ++i) {
                  const int l = i ^ j;
                  if (l > i) {
                    const float hi = fmaxf(kq[gq][i], kq[gq][l]), lo = fminf(kq[gq][i], kq[gq][l]);
                    const bool desc = (i & kk2) == 0;
                    kq[gq][i] = desc ? hi : lo; kq[gq][l] = desc ? lo : hi;
                  }
                }
          }
#pragma unroll
          for (int pr = 0; pr < 2; ++pr) {
#pragma unroll
            for (int i = 0; i < 16; ++i) kq[2 * pr][i] = fmaxf(kq[2 * pr][i], kq[2 * pr + 1][15 - i]);
#pragma unroll
            for (int d = 8; d >= 1; d >>= 1)
#pragma unroll
              for (int i = 0; i < 16; ++i)
                if ((i & d) == 0) { const float hi = fmaxf(kq[2 * pr][i], kq[2 * pr][i + d]), lo = fminf(kq[2 * pr][i], kq[2 * pr][i + d]); kq[2 * pr][i] = hi; kq[2 * pr][i + d] = lo; }
          }
#pragma unroll
          for (int i = 0; i < 16; ++i) v[i] = fmaxf(kq[0][i], kq[2][15 - i]);
#pragma unroll
          for (int d = 8; d >= 1; d >>= 1)
#pragma unroll
            for (int i = 0; i < 16; ++i)
              if ((i & d) == 0) { const float hi = fmaxf(v[i], v[i + d]), lo = fminf(v[i], v[i + d]); v[i] = hi; v[i + d] = lo; }
        }
        float c[16];
#pragma unroll
        for (int i = 0; i < 16; ++i) c[i] = __shfl_xor(v[15 - i], 1);
#pragma unroll
        for (int i = 0; i < 16; ++i) c[i] = fmaxf(c[i], v[i]);
#pragma unroll
        for (int d = 8; d >= 1; d >>= 1)
#pragma unroll
          for (int i = 0; i < 16; ++i)
            if ((i & d) == 0) { const float hi = fmaxf(c[i], c[i + d]), lo = fminf(c[i], c[i + d]); c[i] = hi; c[i + d] = lo; }
        if (half == 0) {
          float* tv = TOPV + (size_t)(m0 + row) * 256 + hp * 16;
#pragma unroll
          for (int i = 0; i < 4; ++i) *(float4*)(tv + 4 * i) = make_float4(c[4 * i], c[4 * i + 1], c[4 * i + 2], c[4 * i + 3]);
        }
      }
      __syncthreads();
    }
  }
}

template <int C> struct CandFlat { static constexpr int calc() { int i = 0, rem = C; while (rem >= 16 / (i + 1)) { rem -= 16 / (i + 1); ++i; } return i * 16 + rem; } static constexpr int value = calc(); };
template <int C> DI void rank_step(const unsigned key, const int, int& rank) {
  const unsigned o = (unsigned)__builtin_amdgcn_readlane((int)key, C);
  rank += (o > key) ? 1 : 0;
}
template <int C0> DI void rank_steps10(const unsigned val, const int flat, int& rank) {
  rank_step<C0>(val, flat, rank); rank_step<C0 + 1>(val, flat, rank); rank_step<C0 + 2>(val, flat, rank); rank_step<C0 + 3>(val, flat, rank); rank_step<C0 + 4>(val, flat, rank);
  rank_step<C0 + 5>(val, flat, rank); rank_step<C0 + 6>(val, flat, rank); rank_step<C0 + 7>(val, flat, rank); rank_step<C0 + 8>(val, flat, rank); rank_step<C0 + 9>(val, flat, rank);
}
DI float dot16q(const uint4& q, const f32x2* x) {
  f32x2 a = __builtin_amdgcn_cvt_pk_f32_fp8((int)q.x, false) * x[0];
  a = __builtin_amdgcn_cvt_pk_f32_fp8((int)q.x, true) * x[1] + a;
  a = __builtin_amdgcn_cvt_pk_f32_fp8((int)q.y, false) * x[2] + a;
  a = __builtin_amdgcn_cvt_pk_f32_fp8((int)q.y, true) * x[3] + a;
  a = __builtin_amdgcn_cvt_pk_f32_fp8((int)q.z, false) * x[4] + a;
  a = __builtin_amdgcn_cvt_pk_f32_fp8((int)q.z, true) * x[5] + a;
  a = __builtin_amdgcn_cvt_pk_f32_fp8((int)q.w, false) * x[6] + a;
  a = __builtin_amdgcn_cvt_pk_f32_fp8((int)q.w, true) * x[7] + a;
  return a.x + a.y;
}
DI void axpy16q(float c, const uint4& q, f32x2* o) {
  const f32x2 c2 = {c, c};
  o[0] = __builtin_amdgcn_cvt_pk_f32_fp8((int)q.x, false) * c2 + o[0];
  o[1] = __builtin_amdgcn_cvt_pk_f32_fp8((int)q.x, true) * c2 + o[1];
  o[2] = __builtin_amdgcn_cvt_pk_f32_fp8((int)q.y, false) * c2 + o[2];
  o[3] = __builtin_amdgcn_cvt_pk_f32_fp8((int)q.y, true) * c2 + o[3];
  o[4] = __builtin_amdgcn_cvt_pk_f32_fp8((int)q.z, false) * c2 + o[4];
  o[5] = __builtin_amdgcn_cvt_pk_f32_fp8((int)q.z, true) * c2 + o[5];
  o[6] = __builtin_amdgcn_cvt_pk_f32_fp8((int)q.w, false) * c2 + o[6];
  o[7] = __builtin_amdgcn_cvt_pk_f32_fp8((int)q.w, true) * c2 + o[7];
}
struct __attribute__((packed, aligned(8))) U4a8 { unsigned a, b, c, d; };
DI v6u load6(const unsigned char* p) { const U4a8 a = *(const U4a8*)p; const uint2 c = *(const uint2*)(p + 16); v6u q; q[0] = a.a; q[1] = a.b; q[2] = a.c; q[3] = a.d; q[4] = c.x; q[5] = c.y; return q; }
DI void phase_peer_out(const Params& p, char* lds) {
  char* ws = p.ws;
  const int tid = otid(), lane = tid & 63, wave = tid >> 6, hb = lane >> 5, l5 = lane & 31;
  int* sidx = (int*)lds + wave * 384; float* sw = (float*)(sidx + 128);
  const u16* H = (const u16*)(ws + OFF_H); const unsigned* TV = (const unsigned*)(ws + OFF_TOPV);
  const unsigned char* U6 = (const unsigned char*)(ws + OFF_U8) + 24 * l5; const unsigned char* V6 = (const unsigned char*)(ws + OFF_V8) + 24 * l5;
  const float* USC = (const float*)(ws + OFF_USC); const float* VSC = (const float*)(ws + OFF_VSC);
  const float* g3 = p.in[23]; const float* b3 = p.in[24];
  int ci = 0, cj = 0; const bool cval = lane < 50;
  if (cval) { int rem = lane, i = 0; while (true) { const int cnt = 16 / (i + 1); if (rem < cnt) break; rem -= cnt; ++i; } ci = i; cj = rem; }
  const int flat = ci * 16 + cj;
  float hval[8]; int hidx[8];
  {
    const int t = blockIdx.x * 8 + wave;
#pragma unroll
    for (int hq = 0; hq < 8; ++hq) {
      const unsigned ka = TV[(size_t)t * 256 + (2 * hq) * 16 + ci], kb = TV[(size_t)t * 256 + (2 * hq + 1) * 16 + cj];
      const float va = __uint_as_float(ka & 0xFFFFFF80u), vb = __uint_as_float(kb & 0xFFFFFF80u);
      const int ia = 127 - (int)(ka & 127u), ib = 127 - (int)(kb & 127u);
      hval[hq] = cval ? va + vb : -INFINITY; hidx[hq] = ia * 128 + ib;
    }
  }
  for (int t = blockIdx.x * 8 + wave; t < T_TOK; t += gridDim.x * 8) {
    f32x2 x2[16];
#pragma unroll
    for (int i = 0; i < 4; ++i) {
      const uint4 hv = *(const uint4*)(H + (size_t)t * 1024 + 32 * l5 + 8 * i);
      x2[4 * i] = f32x2{bflo(hv.x), bfhi(hv.x)}; x2[4 * i + 1] = f32x2{bflo(hv.y), bfhi(hv.y)}; x2[4 * i + 2] = f32x2{bflo(hv.z), bfhi(hv.z)}; x2[4 * i + 3] = f32x2{bflo(hv.w), bfhi(hv.w)};
    }
#pragma unroll
    for (int hq = 0; hq < 8; ++hq) {
      const float val = hval[hq];
      const unsigned vb32 = __float_as_uint(val);
      const unsigned ukey = cval ? (((vb32 ^ ((vb32 >> 31) ? 0xFFFFFFFFu : 0x80000000u)) & 0xFFFFFF00u) | (unsigned)(255 - flat)) : 0u;
      int rank = 0;
      rank_steps10<0>(ukey, flat, rank); rank_steps10<10>(ukey, flat, rank); rank_steps10<20>(ukey, flat, rank); rank_steps10<30>(ukey, flat, rank); rank_steps10<40>(ukey, flat, rank);
      if (cval && rank < 16) { sidx[hq * 16 + rank] = hidx[hq]; sw[hq * 16 + rank] = val; }
    }
    int el[2]; float gl[2];
#pragma unroll
    for (int grp = 0; grp < 2; ++grp) {
      el[grp] = sidx[grp * 64 + lane];
      const float sc = sw[grp * 64 + lane];
      float mx = sc; for (int o = 8; o; o >>= 1) mx = fmaxf(mx, __shfl_xor(mx, o));
      const float e = __expf(sc - mx);
      float sm = e; for (int o = 8; o; o >>= 1) sm += __shfl_xor(sm, o);
      gl[grp] = e * __builtin_amdgcn_rcpf(sm);
    }
#pragma unroll
    for (int hf = 0; hf < 2; ++hf) {
      float pd[32];
#pragma unroll
      for (int kb = 0; kb < 4; ++kb) {
        v6u qb[8];
#pragma unroll
        for (int k = 0; k < 8; ++k) {
          const int e0 = __builtin_amdgcn_readlane(el[0], hf * 32 + kb * 8 + k), e1 = __builtin_amdgcn_readlane(el[1], hf * 32 + kb * 8 + k);
          qb[k] = load6(U6 + (size_t)(hb ? e1 : e0) * 768);
        }
#pragma unroll
        for (int k = 0; k < 8; ++k) {
          const v32f f = __builtin_amdgcn_cvt_scalef32_pk32_f32_fp6(qb[k], 1.0f);
          f32x2 a = f32x2{f[0], f[1]} * x2[0];
#pragma unroll
          for (int i = 1; i < 16; ++i) a = f32x2{f[2 * i], f[2 * i + 1]} * x2[i] + a;
          pd[kb * 8 + k] = a.x + a.y;
        }
      }
#pragma unroll
      for (int off = 16; off >= 1; off >>= 1) {
        const bool up = (lane & off) != 0;
#pragma unroll
        for (int i = 0; i < off; ++i) {
          const float send = up ? pd[i] : pd[i + off];
          const float keep = up ? pd[i + off] : pd[i];
          pd[i] = keep + __shfl_xor(send, off);
        }
      }
      sw[hb * 64 + hf * 32 + l5] = pd[0];
    }
    float coefv[2];
#pragma unroll
    for (int grp = 0; grp < 2; ++grp) {
      const float dt = sw[grp * 64 + lane] * USC[el[grp]];
      const float ge = 0.5f * dt * (1.f + erff(dt * 0.7071067811865476f));
      coefv[grp] = gl[grp] * ge * VSC[el[grp]];
    }
    {
      const int tn = t + gridDim.x * 8;
      if (tn < T_TOK) {
#pragma unroll
    for (int hq = 0; hq < 8; ++hq) {
      const unsigned ka = TV[(size_t)tn * 256 + (2 * hq) * 16 + ci], kb = TV[(size_t)tn * 256 + (2 * hq + 1) * 16 + cj];
      const float va = __uint_as_float(ka & 0xFFFFFF80u), vb = __uint_as_float(kb & 0xFFFFFF80u);
      const int ia = 127 - (int)(ka & 127u), ib = 127 - (int)(kb & 127u);
      hval[hq] = cval ? va + vb : -INFINITY; hidx[hq] = ia * 128 + ib;
    }
      }
    }
    f32x2 o2[16];
#pragma unroll
    for (int i = 0; i < 16; ++i) o2[i] = f32x2{0.f, 0.f};
#pragma unroll
    for (int kb = 0; kb < 8; ++kb) {
      v6u qb[8];
#pragma unroll
      for (int k = 0; k < 8; ++k) {
        const int e0 = __builtin_amdgcn_readlane(el[0], kb * 8 + k), e1 = __builtin_amdgcn_readlane(el[1], kb * 8 + k);
        qb[k] = load6(V6 + (size_t)(hb ? e1 : e0) * 768);
      }
#pragma unroll
      for (int k = 0; k < 8; ++k) {
        const float c0 = __uint_as_float(__builtin_amdgcn_readlane(__float_as_uint(coefv[0]), kb * 8 + k)), c1 = __uint_as_float(__builtin_amdgcn_readlane(__float_as_uint(coefv[1]), kb * 8 + k));
        const float cf = hb ? c1 : c0;
        const f32x2 c2 = {cf, cf};
        const v32f f = __builtin_amdgcn_cvt_scalef32_pk32_f32_fp6(qb[k], 1.0f);
#pragma unroll
        for (int i = 0; i < 16; ++i) o2[i] = f32x2{f[2 * i], f[2 * i + 1]} * c2 + o2[i];
      }
    }
    float s = 0.f;
#pragma unroll
    for (int i = 0; i < 16; ++i) {
      o2[i].x += __shfl_xor(o2[i].x, 32); o2[i].y += __shfl_xor(o2[i].y, 32);
      o2[i] = x2[i] * f32x2{ALPHA, ALPHA} + o2[i]; s += o2[i].x + o2[i].y;
    }
    for (int o = 16; o; o >>= 1) s += __shfl_xor(s, o);
    const float mu = s * (1.f / 1024.f);
    float q = 0.f;
#pragma unroll
    for (int i = 0; i < 16; ++i) { const float a = o2[i].x - mu, bq = o2[i].y - mu; q += a * a + bq * bq; }
    for (int o = 16; o; o >>= 1) q += __shfl_xor(q, o);
    const float rstd = rsqrtf(q * (1.f / 1024.f) + LN_EPS);
    float* orow = p.out + (size_t)t * 1024 + 32 * l5 + 16 * hb;
#pragma unroll
    for (int q4 = 0; q4 < 4; ++q4) {
      const float4 gg = *(const float4*)(g3 + 32 * l5 + 16 * hb + 4 * q4), bb = *(const float4*)(b3 + 32 * l5 + 16 * hb + 4 * q4);
      const f32x2 a0 = hb ? o2[8 + 2 * q4] : o2[2 * q4], a1 = hb ? o2[8 + 2 * q4 + 1] : o2[2 * q4 + 1];
      float4 o;
      o.x = (a0.x - mu) * rstd * gg.x + bb.x; o.y = (a0.y - mu) * rstd * gg.y + bb.y;
      o.z = (a1.x - mu) * rstd * gg.z + bb.z; o.w = (a1.y - mu) * rstd * gg.w + bb.w;
      *(float4*)(orow + 4 * q4) = o;
    }
  }
}

#define XB_TMO      128
#define XB_XCNT(j)  (256  + 64 * (j))
#define XB_XSUB(j)  (1280 + 64 * (j))
#define XB_XGEN(j)  (2304 + 64 * (j))
#define XB_TOP      3328
#define XB_TOPGEN   3392
#define XCD_BAR_WORDS 3456
#define XB_SPIN_CAP (1u << 18)
#define LAS __attribute__((address_space(3)))
DI unsigned xb_ld(unsigned* p)              { return __hip_atomic_load(p, __ATOMIC_RELAXED, __HIP_MEMORY_SCOPE_AGENT); }
DI unsigned xb_add(unsigned* p, unsigned v) { return __hip_atomic_fetch_add(p, v, __ATOMIC_RELAXED, __HIP_MEMORY_SCOPE_AGENT); }
DI unsigned xb_xcc_id() { return (unsigned)__builtin_amdgcn_s_getreg((3 << 11) | 20) & 0xFu; }
#define XB_SPIN(cond, bar) do { unsigned _sp = 0; while (cond) { __builtin_amdgcn_s_sleep(1); \
    if ((++_sp & 255u) == 0u) { if (xb_ld(&(bar)[XB_TMO])) break; if (_sp > XB_SPIN_CAP) { atomicAdd(&(bar)[XB_TMO], 1u); break; } } } } while (0)
struct XcdBarrier { unsigned* bar; unsigned x; volatile LAS unsigned* st; };
DI XcdBarrier xcd_barrier_post(unsigned* bar, volatile LAS unsigned* st) {
  XcdBarrier b; b.bar = bar; b.x = xb_xcc_id(); b.st = st;
  if (threadIdx.x == 0) (void)xb_add(&bar[XB_XCNT(b.x)], 1u);
  return b;
}
DI void xcd_barrier_complete(unsigned* bar, unsigned x, unsigned& nloc, unsigned& nx) {
  const unsigned G = gridDim.x * gridDim.y * gridDim.z;
  unsigned sum, cnt, mine, sp = 0u;
  for (;;) {
    sum = 0u; cnt = 0u; mine = 0u;
#pragma unroll
    for (unsigned j = 0; j < 16; ++j) { const unsigned c = xb_ld(&bar[XB_XCNT(j)]); sum += c; cnt += (c > 0u) ? 1u : 0u; mine = (j == x) ? c : mine; }
    if (sum == G) break;
    __builtin_amdgcn_s_sleep(1);
    if ((++sp & 255u) == 0u) { if (xb_ld(&bar[XB_TMO])) break; if (sp > XB_SPIN_CAP) { atomicAdd(&bar[XB_TMO], 1u); break; } }
  }
  nloc = mine > 0u ? mine : 1u; nx = cnt > 0u ? cnt : 1u;
}
DI void xcd_barrier(const XcdBarrier& b) {
  asm volatile("s_waitcnt vmcnt(0)" ::: "memory");
  __syncthreads();
  if (threadIdx.x == 0) {
    unsigned* bar = b.bar;
    __builtin_amdgcn_s_waitcnt(0);
    unsigned nloc = b.st[0], nx = b.st[1];
    if (nloc == 0u) { xcd_barrier_complete(bar, b.x, nloc, nx); b.st[0] = nloc; b.st[1] = nx; }
    const unsigned old = xb_add(&bar[XB_XSUB(b.x)], 1u);
    const unsigned gen = old / nloc;
    if (old + 1u == (gen + 1u) * nloc) {
      __builtin_amdgcn_fence(__ATOMIC_RELEASE, "agent");
      asm volatile("s_waitcnt vmcnt(0)" ::: "memory");
      const unsigned og = xb_add(&bar[XB_TOP], 1u);
      const unsigned tg = og / nx;
      if (og + 1u == (tg + 1u) * nx) xb_add(&bar[XB_TOPGEN], 1u);
      else XB_SPIN(xb_ld(&bar[XB_TOPGEN]) == tg, bar);
      __builtin_amdgcn_fence(__ATOMIC_ACQUIRE, "agent");
      xb_add(&bar[XB_XGEN(b.x)], 1u);
      asm volatile("s_waitcnt vmcnt(0)" ::: "memory");
    } else {
      XB_SPIN(xb_ld(&bar[XB_XGEN(b.x)]) == gen, bar);
      __builtin_amdgcn_fence(__ATOMIC_ACQUIRE, "agent");
      asm volatile("s_waitcnt vmcnt(0)" ::: "memory");
    }
  }
  __syncthreads();
}

__global__ void __launch_bounds__(512) mega(Params p) {
  extern __shared__ __attribute__((aligned(16))) char lds[];
  cg::grid_group grid = cg::this_grid();
  char* ws = p.ws;
  u16* H = (u16*)(ws + OFF_H);
  u16* Zb = (u16*)(ws + OFF_Z);
  unsigned* barw = (unsigned*)(ws + OFF_BAR);
  volatile LAS unsigned* xst = (volatile LAS unsigned*)(LAS unsigned*)(lds + LDS_BYTES - 16);
  if (blockIdx.x == 0) for (int i = threadIdx.x; i < XCD_BAR_WORDS; i += 512) barw[i] = 0u;
  if (threadIdx.x == 0) { xst[0] = 0u; xst[1] = 0u; }
  for (int rep = 0; rep < 1 + ((PROBE_MASK >> 0) & 1); ++rep) {
    transpose_w(p.in[4], (u16*)(ws + OFF_WIN), 3592, 3584, (float*)lds);
    transpose_w(p.in[11], (u16*)(ws + OFF_WOUT), 1024, 1024, (float*)lds);
    transpose_w(p.in[14], (u16*)(ws + OFF_WQ), 1024, 1024, (float*)lds);
    transpose_w(p.in[15], (u16*)(ws + OFF_WKV), 2048, 2048, (float*)lds);
    transpose_w(p.in[16], (u16*)(ws + OFF_WO), 1024, 1024, (float*)lds);
    transpose_w(p.in[19], (u16*)(ws + OFF_WPQ), 2048, 2048, (float*)lds);
    convert_fp6_rows(p.in[21], (unsigned char*)(ws + OFF_U8), (float*)(ws + OFF_USC));
    convert_fp6_rows(p.in[22], (unsigned char*)(ws + OFF_V8), (float*)(ws + OFF_VSC));
    convert_bf16(p.in[20], (u16*)(ws + OFF_SK), (size_t)2 * 128 * 128 / 4);
    convert_bf16(p.in[1], (u16*)(ws + OFF_MEMB), (size_t)2048 * 1024 / 4);
    ln_in_rows(p.in[0], p.in[2], p.in[3], p.in[4], H, (float*)(ws + OFF_G), (float*)lds);
  }
  grid.sync();
  const XcdBarrier xb = xcd_barrier_post(barw, xst);
  if (PROBE_MASK & 0x10000) { for (int i = 0; i < 16; ++i) xcd_barrier(xb); }
  if ((PHASE_EN >> 1) & 1)
    { phase_inproj(p, lds); xcd_barrier(xb); }
  if ((PROBE_MASK >> 1) & 1) { phase_inproj(p, lds); xcd_barrier(xb); }
  if ((PHASE_EN >> 2) & 1)
    { phase_mixA(p, lds); xcd_barrier(xb); }
  if ((PROBE_MASK >> 2) & 1) { phase_mixA(p, lds); xcd_barrier(xb); }
  if ((PROBE_MASK >> 13) & 1) { for (int it = blockIdx.x; it < 4096; it += gridDim.x) mlstmA_item(p, lds, it); xcd_barrier(xb); }
  if ((PROBE_MASK >> 14) & 1) { for (int it = blockIdx.x; it < 2048; it += gridDim.x) attn_item(p, lds, it); xcd_barrier(xb); }
  if ((PHASE_EN >> 11) & 1)
    { phase_mlstm_scan(p); xcd_barrier(xb); }
  if ((PHASE_EN >> 12) & 1)
    { phase_mixC(p, lds); xcd_barrier(xb); }
  if ((PROBE_MASK >> 12) & 1) { phase_mixC(p, lds); xcd_barrier(xb); }
  if ((PHASE_EN >> 3) & 1)
    { phase_gemm1024<1>((const u16*)(ws + OFF_MIX), (const u16*)(ws + OFF_WOUT), Zb, H, lds); xcd_barrier(xb); }
  if ((PROBE_MASK >> 3) & 1) { phase_gemm1024<1>((const u16*)(ws + OFF_MIX), (const u16*)(ws + OFF_WOUT), Zb, H, lds); xcd_barrier(xb); }
  { ln_rows_b(Zb, p.in[12], p.in[13], H); xcd_barrier(xb); }
  if ((PROBE_MASK >> 4) & 1) { ln_rows_b(Zb, p.in[12], p.in[13], H); xcd_barrier(xb); }
  if ((PHASE_EN >> 5) & 1)
    { phase_gemm1024<0>(H, (const u16*)(ws + OFF_WQ), (u16*)(ws + OFF_XQ), nullptr, lds); xcd_barrier(xb); }
  if ((PROBE_MASK >> 5) & 1) { phase_gemm1024<0>(H, (const u16*)(ws + OFF_WQ), (u16*)(ws + OFF_XQ), nullptr, lds); xcd_barrier(xb); }
  if ((PHASE_EN >> 6) & 1)
    { phase_xattn(p, lds); xcd_barrier(xb); }
  if ((PROBE_MASK >> 6) & 1) { phase_xattn(p, lds); xcd_barrier(xb); }
  if ((PHASE_EN >> 7) & 1)
    { phase_gemm1024<1>((const u16*)(ws + OFF_XO), (const u16*)(ws + OFF_WO), Zb, H, lds); xcd_barrier(xb); }
  if ((PROBE_MASK >> 7) & 1) { phase_gemm1024<1>((const u16*)(ws + OFF_XO), (const u16*)(ws + OFF_WO), Zb, H, lds); xcd_barrier(xb); }
  { ln_rows_b(Zb, p.in[17], p.in[18], H); xcd_barrier(xb); }
  if ((PROBE_MASK >> 8) & 1) { ln_rows_b(Zb, p.in[17], p.in[18], H); xcd_barrier(xb); }
  if ((PHASE_EN >> 9) & 1)
    { phase_peer_query(p, lds); xcd_barrier(xb); }
  if ((PROBE_MASK >> 9) & 1) { phase_peer_query(p, lds); xcd_barrier(xb); }
  if ((PHASE_EN >> 10) & 1)
    { phase_peer_out(p, lds); }
  if ((PROBE_MASK >> 10) & 1) { phase_peer_out(p, lds); }
}

extern "C" void kernel_launch(void* const* d_in, const int* in_sizes, int n_in, void* d_out, int out_size, void* d_ws, size_t ws_size, hipStream_t stream) {
  static int grid_blocks = 0;
  if (grid_blocks == 0) {
    if (n_in != 25 || out_size != T_TOK * 1024 || ws_size < WS_NEED) { fprintf(stderr, "kernel_launch: unexpected shapes (n_in %d out %d ws %zu)\n", n_in, out_size, ws_size); grid_blocks = -1; return; }
    int dev = 0, cus = 0, per_cu = 0;
    hipGetDevice(&dev);
    hipDeviceGetAttribute(&cus, hipDeviceAttributeMultiprocessorCount, dev);
    if (hipFuncSetAttribute((const void*)mega, hipFuncAttributeMaxDynamicSharedMemorySize, LDS_BYTES) != hipSuccess) { fprintf(stderr, "hipFuncSetAttribute failed\n"); grid_blocks = -1; return; }
    hipOccupancyMaxActiveBlocksPerMultiprocessor(&per_cu, (const void*)mega, 512, LDS_BYTES);
    if (per_cu < 1) { fprintf(stderr, "occupancy query returned %d\n", per_cu); per_cu = 1; }
    grid_blocks = cus * per_cu;
  }
  if (grid_blocks < 0) return;
  Params p{};
  for (int i = 0; i < 25; ++i) p.in[i] = (const float*)d_in[i];
  p.out = (float*)d_out; p.ws = (char*)d_ws;
  void* args[] = {&p};
  hipError_t e = hipLaunchCooperativeKernel((const void*)mega, dim3(grid_blocks), dim3(512), args, LDS_BYTES, stream);
  if (e != hipSuccess) fprintf(stderr, "cooperative launch failed: %s (grid %d)\n", hipGetErrorString(e), grid_blocks);
}
```
